# Optimizing an MI355X kernel written in HIP

```python
import math
import jax, jax.numpy as jnp
from jax import lax
import numpy as np

D_MODEL = 1024
BATCH = 4
SEQ = 8192
DEPTH = 2

CHUNK = 64
HEAD_DIM = 64
RWKV_HEADS = 8
SB_HEADS = 8
RWKV_W = RWKV_HEADS * HEAD_DIM
SB_W = SB_HEADS * HEAD_DIM
D_MIX = RWKV_W + SB_W
DECAY_RANK = 32
ICLR_RANK = 32
VRES_RANK = 32
GATE_RANK = 96
D_FF = 3584
N_EXPERTS = 8
TOP_K = 2
SB_BLOCK = 128
NORM_EPS = 1e-6
LNX_EPS = 64e-5
DECAY_SCALE = math.exp(-0.5)

kernel_name = 'hybrid_rwkv7_stickbreaking_moe_block'


def _rwkv_cols(has_vres):
    return 3 * RWKV_W + DECAY_RANK + ICLR_RANK + GATE_RANK + (VRES_RANK if has_vres else 0)


def _rmsnorm(x, g):
    xf = x.astype(jnp.float32)
    y = xf * lax.rsqrt(jnp.mean(xf * xf, axis=-1, keepdims=True) + NORM_EPS)
    return (y * g.astype(jnp.float32)).astype(x.dtype)


def _heads(t, n_heads):
    return t.reshape(t.shape[:-1] + (n_heads, t.shape[-1] // n_heads))


def _token_shift(p, mu):
    prev = jnp.pad(p, ((0, 0), (1, 0), (0, 0)))[:, :-1]
    return p + mu * (prev - p)


def _rwkv7_scan(r, w, k, v, z, b):
    def step(S, inp):
        r_t, w_t, k_t, v_t, z_t, b_t = inp
        Sz = jnp.einsum('bhvk,bhk->bhv', S, z_t)
        S = S * w_t[:, :, None, :] + Sz[..., None] * b_t[:, :, None, :] + v_t[..., None] * k_t[:, :, None, :]
        return S, jnp.einsum('bhvk,bhk->bhv', S, r_t)
    B, T, H, N = r.shape
    xs = (jnp.moveaxis(r, 1, 0), jnp.moveaxis(w, 1, 0), jnp.moveaxis(k, 1, 0),
          jnp.moveaxis(v, 1, 0), jnp.moveaxis(z, 1, 0), jnp.moveaxis(b, 1, 0))
    _, ys = lax.scan(step, jnp.zeros((B, H, N, N), jnp.float32), xs)
    return jnp.moveaxis(ys, 0, 1)


def _rwkv7_group(proj, p, v_first):
    f32 = jnp.float32
    has_vres = v_first is not None
    sizes = [RWKV_W] * 3 + [DECAY_RANK, ICLR_RANK, GATE_RANK] + ([VRES_RANK] if has_vres else [])
    parts = jnp.split(_token_shift(proj, p['mu']), [int(o) for o in np.cumsum(sizes)[:-1]], axis=-1)
    r, k, v, w_dn, a_dn, g_dn = parts[:6]
    decay = jnp.exp(-DECAY_SCALE * jax.nn.sigmoid((p['decay0'] + jnp.tanh(w_dn) @ p['decay_up']).astype(f32)))
    iclr = jax.nn.sigmoid((p['iclr0'] + a_dn @ p['iclr_up']).astype(f32))
    gate = (jax.nn.sigmoid(g_dn) @ p['gate_up']).astype(f32)
    if has_vres:
        v = v + (v_first - v) * jax.nn.sigmoid(p['vres0'] + parts[6] @ p['vres_up'])
    else:
        v_first = v
    r, k, v = r.astype(f32), k.astype(f32), v.astype(f32)
    kk = _heads(k * p['k_k'], RWKV_HEADS)
    kk = kk * lax.rsqrt(jnp.maximum(jnp.sum(kk * kk, axis=-1, keepdims=True), 1e-12))
    k = k * (1.0 + (iclr - 1.0) * p['k_a'])
    rh, kh, vh = _heads(r, RWKV_HEADS), _heads(k, RWKV_HEADS), _heads(v, RWKV_HEADS)
    wh, ah = _heads(decay, RWKV_HEADS), _heads(iclr, RWKV_HEADS)
    y = _rwkv7_scan(rh, wh, kh, vh, -kk, kk * ah)
    mean = jnp.mean(y, axis=-1, keepdims=True)
    var = jnp.mean(jnp.square(y - mean), axis=-1, keepdims=True)
    y = ((y - mean) * lax.rsqrt(var + LNX_EPS)).reshape(r.shape) * p['lnx_g'] + p['lnx_b']
    bonus = (jnp.sum(rh * kh * p['r_k'], axis=-1, keepdims=True) * vh).reshape(r.shape)
    return (y + bonus) * gate, v_first


def _stick_breaking(q, k, v):
    B, T, H, N = q.shape
    f32 = jnp.float32
    qh = jnp.transpose(q, (0, 2, 1, 3)).astype(f32) * (N ** -0.5)
    kh = jnp.transpose(k, (0, 2, 1, 3)).astype(f32)
    vh = jnp.transpose(v, (0, 2, 1, 3)).astype(f32)
    nb = T // SB_BLOCK
    q_blocks = jnp.transpose(qh.reshape(B, H, nb, SB_BLOCK, N), (2, 0, 1, 3, 4))
    kpos = jnp.arange(T)

    def block(args):
        qb, i = args
        qpos = i * SB_BLOCK + jnp.arange(SB_BLOCK)
        z = jnp.einsum('bhqd,bhkd->bhqk', qb, kh)
        mask = kpos[None, :] < qpos[:, None]
        log_keep = jnp.where(mask, jax.nn.log_sigmoid(-z), 0.0)
        between = lax.cumsum(log_keep, axis=3, reverse=True) - log_keep
        att = jnp.where(mask, jnp.exp(jax.nn.log_sigmoid(z) + between), 0.0)
        return jnp.einsum('bhqk,bhkd->bhqd', att, vh)

    o = lax.map(block, (q_blocks, jnp.arange(nb)))
    return jnp.transpose(o, (1, 0, 3, 2, 4)).reshape(B, T, H, N)


def _mixer(h, p, v_first):
    proj = h @ p['w_in']
    n_rwkv = p['mu'].shape[0]
    y_a, v_first = _rwkv7_group(proj[..., :n_rwkv], p, v_first)
    q, k, v = jnp.split(proj[..., n_rwkv:], 3, axis=-1)
    o = _stick_breaking(_heads(q, SB_HEADS), _heads(k, SB_HEADS), _heads(v, SB_HEADS))
    o = o * lax.rsqrt(jnp.mean(o * o, axis=-1, keepdims=True) + NORM_EPS)
    y_b = o.reshape(h.shape[:-1] + (SB_W,)) * p['sb_g']
    y = jnp.concatenate([y_a, y_b], axis=-1).astype(h.dtype) @ p['w_out']
    return y, v_first


def _swiglu(h, w_gate, w_up, w_down):
    return (jax.nn.silu(h @ w_gate) * (h @ w_up)) @ w_down


def _moe(h, router, w_gate, w_up, w_down):
    B, T, D = h.shape
    hf = h.reshape(B * T, D)
    logits = (hf @ router).astype(jnp.float32)
    top_v, top_i = lax.top_k(logits, TOP_K)
    gates = jax.nn.softmax(top_v, axis=-1)
    dense_gate = jnp.sum(jax.nn.one_hot(top_i, N_EXPERTS, dtype=jnp.float32) * gates[..., None], axis=1)
    dense_gate = dense_gate.astype(h.dtype)
    out = jnp.zeros_like(hf)
    for e in range(N_EXPERTS):
        out = out + dense_gate[:, e:e + 1] * _swiglu(hf, w_gate[e], w_up[e], w_down[e])
    return out.reshape(B, T, D)


def _gain(key, n):
    return 1.0 + 0.05 * jax.random.normal(key, (n,), jnp.float32)


def _normal(key, shape, scale):
    return scale * jax.random.normal(key, shape, jnp.float32)


def _init_layer(key, l):
    ks = jax.random.split(key, 24)
    has_vres = l > 0
    n_rwkv = _rwkv_cols(has_vres)
    s = '_' + str(l)
    p = {}
    p['mix_pre' + s] = _gain(ks[0], D_MODEL)
    p['w_in' + s] = _normal(ks[1], (D_MODEL, n_rwkv + 3 * SB_W), D_MODEL ** -0.5)
    p['mu' + s] = jax.random.uniform(ks[2], (n_rwkv,), jnp.float32)
    p['decay0' + s] = _normal(ks[3], (RWKV_W,), 1.0)
    p['decay_up' + s] = _normal(ks[4], (DECAY_RANK, RWKV_W), DECAY_RANK ** -0.5)
    p['iclr0' + s] = _normal(ks[5], (RWKV_W,), 0.5)
    p['iclr_up' + s] = _normal(ks[6], (ICLR_RANK, RWKV_W), ICLR_RANK ** -0.5)
    p['gate_up' + s] = _normal(ks[7], (GATE_RANK, RWKV_W), GATE_RANK ** -0.5)
    if has_vres:
        p['vres0' + s] = _normal(ks[8], (RWKV_W,), 0.5)
        p['vres_up' + s] = _normal(ks[9], (VRES_RANK, RWKV_W), VRES_RANK ** -0.5)
    p['k_k' + s] = 0.85 + _normal(ks[10], (RWKV_W,), 0.05)
    p['k_a' + s] = 1.0 + _normal(ks[11], (RWKV_W,), 0.05)
    p['r_k' + s] = _normal(ks[12], (RWKV_HEADS, HEAD_DIM), 0.1)
    p['lnx_g' + s] = _gain(ks[13], RWKV_W)
    p['lnx_b' + s] = _normal(ks[14], (RWKV_W,), 0.02)
    p['sb_g' + s] = _gain(ks[15], SB_W)
    p['w_out' + s] = _normal(ks[16], (D_MIX, D_MODEL), D_MIX ** -0.5)
    p['mix_post' + s] = _gain(ks[17], D_MODEL)
    p['ffn_pre' + s] = _gain(ks[18], D_MODEL)
    if l % 2 == 0:
        p['ff_gate' + s] = _normal(ks[19], (D_MODEL, D_FF), D_MODEL ** -0.5)
        p['ff_up' + s] = _normal(ks[20], (D_MODEL, D_FF), D_MODEL ** -0.5)
        p['ff_down' + s] = _normal(ks[21], (D_FF, D_MODEL), D_FF ** -0.5)
    else:
        p['router' + s] = _normal(ks[19], (D_MODEL, N_EXPERTS), D_MODEL ** -0.5)
        p['moe_gate' + s] = _normal(ks[20], (N_EXPERTS, D_MODEL, D_FF), D_MODEL ** -0.5)
        p['moe_up' + s] = _normal(ks[21], (N_EXPERTS, D_MODEL, D_FF), D_MODEL ** -0.5)
        p['moe_down' + s] = _normal(ks[22], (N_EXPERTS, D_FF, D_MODEL), D_FF ** -0.5)
    p['ffn_post' + s] = _gain(ks[23], D_MODEL)
    return p


def setup_inputs(seed: int = 0) -> dict:
    key = jax.random.key(seed)
    ks = jax.random.split(key, DEPTH + 1)
    params = {'x': jax.random.normal(ks[0], (BATCH, SEQ, D_MODEL), jnp.float32)}
    for l in range(DEPTH):
        params.update(_init_layer(ks[l + 1], l))
    return params


def reference(x,
              mix_pre_0, w_in_0, mu_0, decay0_0, decay_up_0, iclr0_0, iclr_up_0, gate_up_0,
              k_k_0, k_a_0, r_k_0, lnx_g_0, lnx_b_0, sb_g_0, w_out_0, mix_post_0,
              ffn_pre_0, ff_gate_0, ff_up_0, ff_down_0, ffn_post_0,
              mix_pre_1, w_in_1, mu_1, decay0_1, decay_up_1, iclr0_1, iclr_up_1, gate_up_1,
              vres0_1, vres_up_1,
              k_k_1, k_a_1, r_k_1, lnx_g_1, lnx_b_1, sb_g_1, w_out_1, mix_post_1,
              ffn_pre_1, router_1, moe_gate_1, moe_up_1, moe_down_1, ffn_post_1):
    layers = [
        dict(mix_pre=mix_pre_0, w_in=w_in_0, mu=mu_0, decay0=decay0_0, decay_up=decay_up_0,
             iclr0=iclr0_0, iclr_up=iclr_up_0, gate_up=gate_up_0, k_k=k_k_0, k_a=k_a_0,
             r_k=r_k_0, lnx_g=lnx_g_0, lnx_b=lnx_b_0, sb_g=sb_g_0, w_out=w_out_0,
             mix_post=mix_post_0, ffn_pre=ffn_pre_0, ffn=(ff_gate_0, ff_up_0, ff_down_0),
             ffn_post=ffn_post_0),
        dict(mix_pre=mix_pre_1, w_in=w_in_1, mu=mu_1, decay0=decay0_1, decay_up=decay_up_1,
             iclr0=iclr0_1, iclr_up=iclr_up_1, gate_up=gate_up_1, vres0=vres0_1, vres_up=vres_up_1,
             k_k=k_k_1, k_a=k_a_1, r_k=r_k_1, lnx_g=lnx_g_1, lnx_b=lnx_b_1, sb_g=sb_g_1,
             w_out=w_out_1, mix_post=mix_post_1, ffn_pre=ffn_pre_1,
             ffn=(router_1, moe_gate_1, moe_up_1, moe_down_1), ffn_post=ffn_post_1),
    ]
    v_first = None
    for l in range(DEPTH):
        p = layers[l]
        y, v_first = _mixer(_rmsnorm(x, p['mix_pre']), p, v_first)
        x = x + _rmsnorm(y, p['mix_post'])
        hn = _rmsnorm(x, p['ffn_pre'])
        f = _swiglu(hn, *p['ffn']) if l % 2 == 0 else _moe(hn, *p['ffn'])
        x = x + _rmsnorm(f, p['ffn_post'])
    return x
```

```cpp
#include <hip/hip_runtime.h>
#include <cstdio>
#include <cstdint>
namespace pg8 {
#define PG8_LAS __attribute__((address_space(3)))
typedef unsigned short bf16_t;
typedef short bf16x8 __attribute__((ext_vector_type(8)));
typedef float f32x4 __attribute__((ext_vector_type(4)));
typedef unsigned u32x4 __attribute__((ext_vector_type(4)));
constexpr int BM = 256, BK = 64, HALF = 128, HTB = HALF * BK * 2  , STAGE_BYTES = 8 * HTB, NXCD = 8, WGM = 8;

__host__ __device__ __forceinline__ int lds_byte(int r, int c) { const int st = (r >> 4) * 2 + (c >> 5), rr = r & 15, cc = c & 31, ob = rr * 64 + cc * 2; return st * 1024 + (ob ^ (((ob >> 9) & 1) << 5)); }
__host__ __device__ __forceinline__ void stage_rc(int b, int& R, int& C) { const int st = b / 1024, sb = b % 1024, swz = sb ^ (((sb >> 9) & 1) << 5); R = (st >> 1) * 16 + swz / 64; C = (st & 1) * 32 + (swz % 64) / 2; }
__host__ __device__ __forceinline__ int perm32(int rho) { const int n = rho >> 4, i = rho & 15; return 8 * (i >> 2) + 4 * n + (i & 3); }

struct Unit { int pm, pa, pn, po; };
struct Gemm { const bf16_t* A; const bf16_t* Bt; int M, N, K; };

struct StaticOrder {
    int nM, nN, nwg, G, c;
    __host__ __device__ void init(int M, int N, int G_, int c_) { nM = M / BM; nN = N / BM; nwg = nM * nN; G = G_; c = c_; }
    __host__ __device__ bool next(int i, Unit& u) const {
        const long L = (long)i * G + c; if (L >= nwg) return false;
        int wgid = (int)L; { const int q = nwg / NXCD, r = nwg % NXCD, xcd = wgid % NXCD, off = wgid / NXCD; wgid = (xcd < r ? xcd * (q + 1) : r * (q + 1) + (xcd - r) * q) + off; }
        const int nig = WGM * nN, gid = wgid / nig, fm = gid * WGM, gsz = (nM - fm) < WGM ? (nM - fm) : WGM;
        u.pm = fm + ((wgid % nig) % gsz); u.pn = (wgid % nig) / gsz; u.pa = u.pm; u.po = u.pn; return true;
    }
    __device__ __forceinline__ void a_ready(const Unit&) const {}
    __device__ __forceinline__ void done(const Unit&) const {}
};

__device__ __forceinline__ unsigned cvt_pk_bf16(float lo, float hi) { unsigned r; asm volatile("v_cvt_pk_bf16_f32 %0, %1, %2" : "=v"(r) : "v"(lo), "v"(hi)); return r; }
typedef float f32x2 __attribute__((ext_vector_type(2)));

template <class Epi, class Sched, bool ALIGN_EPI = false, bool SP2 = false>
__device__ __forceinline__ void gemm_phase(PG8_LAS unsigned char* lds, const Gemm g, const Sched& S, const Epi& E) {
    int tid_ = threadIdx.x; asm volatile("" : "+v"(tid_));
    const int tid = tid_, wid = __builtin_amdgcn_readfirstlane(tid >> 6), lane = tid & 63, wr = wid >> 2, wc = wid & 3, fr = lane & 15, fq = lane >> 4;
    const int K = g.K, nt = K / BK;
    unsigned voffA[2], voffB[2];
#pragma unroll
    for (int i = 0; i < 2; ++i) { int R, C; stage_rc(tid * 16 + i * 8192, R, C); const int Rb = Epi::PERM ? ((R & ~31) + perm32(R & 31)) : R;
        voffA[i] = (unsigned)(R * K + C) * 2u; voffB[i] = (unsigned)(Rb * K + C) * 2u; }
    const size_t kstep = (size_t)(BK * 2);
    const size_t hstep = (size_t)HALF * K * 2;
    const size_t tstep = 2 * hstep;
    const unsigned ldsw = (unsigned)wid * 1024u;
    const int aoff = lds_byte(wr * 64 + fr, fq * 8), boff = lds_byte(wc * 32 + fr, fq * 8);
#define PG8_SA(b, h) (((b) * 2 + (h)) * HTB)
#define PG8_SB(b, h) ((4 + (b) * 2 + (h)) * HTB)
#define PG8_STAGE(bufoff, gbase, voff) do { _Pragma("unroll") for (int _i = 0; _i < 2; ++_i) \
        __builtin_amdgcn_global_load_lds((const unsigned*)((const char*)(gbase) + (voff)[_i]), (PG8_LAS unsigned*)(lds + (bufoff) + ldsw + _i * 8192), 16, 0, 0); } while (0)
#define PG8_LDA(dst, b, h) do { _Pragma("unroll") for (int m = 0; m < 4; ++m) _Pragma("unroll") for (int k = 0; k < 2; ++k) dst[m][k] = *(const PG8_LAS bf16x8*)(lds + PG8_SA(b, h) + aoff + m * 2048 + k * 1024); } while (0)
#define PG8_LDB(dst, b, h) do { _Pragma("unroll") for (int n = 0; n < 2; ++n) _Pragma("unroll") for (int k = 0; k < 2; ++k) dst[n][k] = *(const PG8_LAS bf16x8*)(lds + PG8_SB(b, h) + boff + n * 2048 + k * 1024); } while (0)
#define PG8_MMA(ai, bj, At, Bt) do { __builtin_amdgcn_s_setprio(1); _Pragma("unroll") for (int m = 0; m < 4; ++m) _Pragma("unroll") for (int n = 0; n < 2; ++n) _Pragma("unroll") for (int k = 0; k < 2; ++k) \
        acc[ai][bj][m][n] = __builtin_amdgcn_mfma_f32_16x16x32_bf16(Bt[n][k], At[m][k], acc[ai][bj][m][n], 0, 0, 0); __builtin_amdgcn_s_setprio(0); } while (0)
#define PG8_WAIT_V(n) asm volatile("s_waitcnt vmcnt(" #n ")" ::: "memory")
#define PG8_WAIT_L(n) asm volatile("s_waitcnt lgkmcnt(" #n ")" ::: "memory")
#define PG8_BAR __builtin_amdgcn_s_barrier()
#define PG8_SCHED __builtin_amdgcn_sched_barrier(0)
    Unit cur, nxt; int ui = 0;
    if (!S.next(0, cur)) return;
    f32x4 acc[2][2][4][2];
#pragma unroll
    for (int a = 0; a < 2; ++a)
#pragma unroll
        for (int b = 0; b < 2; ++b)
#pragma unroll
            for (int m = 0; m < 4; ++m)
#pragma unroll
                for (int n = 0; n < 2; ++n) acc[a][b][m][n] = (f32x4){0.f, 0.f, 0.f, 0.f};
    bf16x8 At[4][2], B0[2][2], B1[2][2];
    const char* cA = (const char*)g.A + (size_t)cur.pa * tstep; const char* cB = (const char*)g.Bt + (size_t)cur.pn * tstep;
    S.a_ready(cur);
    if constexpr (SP2) {
        PG8_STAGE(PG8_SB(0, 0), cB, voffB); PG8_STAGE(PG8_SB(0, 1), cB + hstep, voffB); PG8_STAGE(PG8_SA(0, 0), cA, voffA); PG8_STAGE(PG8_SA(0, 1), cA + hstep, voffA);
        if (wr == 1) PG8_BAR;
        PG8_WAIT_V(2); PG8_BAR;
        PG8_STAGE(PG8_SB(1, 0), cB + kstep, voffB); PG8_STAGE(PG8_SA(1, 0), cA + kstep, voffA); PG8_STAGE(PG8_SB(1, 1), cB + hstep + kstep, voffB);
        PG8_WAIT_V(6); PG8_BAR;
    } else {
        PG8_STAGE(PG8_SB(0, 0), cB, voffB); PG8_STAGE(PG8_SA(0, 0), cA, voffA); PG8_STAGE(PG8_SB(0, 1), cB + hstep, voffB); PG8_STAGE(PG8_SA(0, 1), cA + hstep, voffA);
        if (wr == 1) PG8_BAR;
        PG8_WAIT_V(4); PG8_BAR;
        PG8_STAGE(PG8_SB(1, 0), cB + kstep, voffB); PG8_STAGE(PG8_SA(1, 0), cA + kstep, voffA); PG8_STAGE(PG8_SB(1, 1), cB + hstep + kstep, voffB);
        PG8_WAIT_V(6); PG8_BAR;
    }
    for (;;) {
        const bool has_next = S.next(ui + 1, nxt);
        const char* nA = has_next ? (const char*)g.A + (size_t)nxt.pa * tstep : cA; const char* nB = has_next ? (const char*)g.Bt + (size_t)nxt.pn * tstep : cB;
        for (int t = 0; t < nt; t += 2) {
            const bool last = (t == nt - 2);
            const char* a1 = cA + (size_t)(t + 1) * kstep;
            const char* a2 = last ? nA : cA + (size_t)(t + 2) * kstep; const char* b2 = last ? nB : cB + (size_t)(t + 2) * kstep;
            const char* a3 = a2 + kstep; const char* b3 = b2 + kstep;
            if (last && has_next) S.a_ready(nxt);
            if constexpr (SP2) {
            PG8_LDB(B0, 0, 0); PG8_LDB(B1, 0, 1); PG8_SCHED; PG8_LDA(At, 0, 0); PG8_STAGE(PG8_SA(1, 1), a1 + hstep, voffA);
            PG8_WAIT_V(8); PG8_WAIT_L(0); PG8_BAR; PG8_MMA(0, 0, At, B0); PG8_MMA(0, 1, At, B1); PG8_BAR; PG8_SCHED;
            PG8_LDA(At, 0, 1); PG8_STAGE(PG8_SB(0, 0), b2, voffB); PG8_STAGE(PG8_SB(0, 1), b2 + hstep, voffB); PG8_STAGE(PG8_SA(0, 0), a2, voffA);
            PG8_WAIT_V(8); PG8_WAIT_L(0); PG8_BAR; PG8_MMA(1, 0, At, B0); PG8_MMA(1, 1, At, B1); PG8_BAR; PG8_SCHED;
            PG8_LDB(B0, 1, 0); PG8_LDB(B1, 1, 1); PG8_SCHED; PG8_LDA(At, 1, 0); PG8_STAGE(PG8_SA(0, 1), a2 + hstep, voffA);
            PG8_WAIT_V(8); PG8_WAIT_L(0); PG8_BAR; PG8_MMA(0, 0, At, B0); PG8_MMA(0, 1, At, B1); PG8_BAR; PG8_SCHED;
            PG8_LDA(At, 1, 1); PG8_STAGE(PG8_SB(1, 0), b3, voffB); PG8_STAGE(PG8_SB(1, 1), b3 + hstep, voffB); PG8_STAGE(PG8_SA(1, 0), a3, voffA);
            PG8_WAIT_V(8); PG8_WAIT_L(0); PG8_BAR; PG8_MMA(1, 0, At, B0); PG8_MMA(1, 1, At, B1); PG8_BAR; PG8_SCHED;
            } else {
            PG8_LDB(B0, 0, 0); PG8_SCHED; PG8_LDA(At, 0, 0); PG8_STAGE(PG8_SA(1, 1), a1 + hstep, voffA);
            PG8_WAIT_L(8); PG8_BAR; PG8_WAIT_L(0); PG8_MMA(0, 0, At, B0); PG8_BAR; PG8_SCHED;
            PG8_LDB(B1, 0, 1); PG8_STAGE(PG8_SB(0, 0), b2, voffB);
            PG8_BAR; PG8_WAIT_L(0); PG8_MMA(0, 1, At, B1); PG8_BAR;
            PG8_LDA(At, 0, 1); PG8_STAGE(PG8_SA(0, 0), a2, voffA);
            PG8_BAR; PG8_WAIT_L(0); PG8_MMA(1, 0, At, B0); PG8_BAR; PG8_SCHED;
            PG8_STAGE(PG8_SB(0, 1), b2 + hstep, voffB);
            PG8_WAIT_V(6); PG8_BAR; PG8_MMA(1, 1, At, B1); PG8_BAR;
            PG8_LDB(B0, 1, 0); PG8_SCHED; PG8_LDA(At, 1, 0); PG8_STAGE(PG8_SA(0, 1), a2 + hstep, voffA);
            PG8_WAIT_L(8); PG8_BAR; PG8_WAIT_L(0); PG8_MMA(0, 0, At, B0); PG8_BAR; PG8_SCHED;
            PG8_LDB(B1, 1, 1); PG8_STAGE(PG8_SB(1, 0), b3, voffB);
            PG8_BAR; PG8_WAIT_L(0); PG8_MMA(0, 1, At, B1); PG8_BAR;
            PG8_LDA(At, 1, 1); PG8_STAGE(PG8_SA(1, 0), a3, voffA);
            PG8_BAR; PG8_WAIT_L(0); PG8_MMA(1, 0, At, B0); PG8_BAR; PG8_SCHED;
            PG8_STAGE(PG8_SB(1, 1), b3 + hstep, voffB);
            PG8_WAIT_V(6); PG8_BAR; PG8_MMA(1, 1, At, B1); PG8_BAR;
            }
        }
        if constexpr (ALIGN_EPI) { if (wr == 0) PG8_BAR; }
        if constexpr (!Epi::AFTER_DRAIN) { E(acc, cur, wr, wc, fr, fq); S.done(cur); }
        if (!has_next) break;
#pragma unroll
        for (int a = 0; a < 2; ++a)
#pragma unroll
            for (int b = 0; b < 2; ++b)
#pragma unroll
                for (int m = 0; m < 4; ++m)
#pragma unroll
                    for (int n = 0; n < 2; ++n) acc[a][b][m][n] = (f32x4){0.f, 0.f, 0.f, 0.f};
        cur = nxt; cA = nA; cB = nB; ++ui;
        if constexpr (ALIGN_EPI) { if (wr == 1) PG8_BAR; }
    }
    PG8_WAIT_V(0);
    if constexpr (!ALIGN_EPI) { if (wr == 0) PG8_BAR; }
    PG8_BAR;
    if constexpr (Epi::AFTER_DRAIN) { E.fused(acc, cur, wr, wc, fr, fq, lds, wid, lane); S.done(cur); }
#undef PG8_SA
#undef PG8_SB
#undef PG8_STAGE
#undef PG8_LDA
#undef PG8_LDB
#undef PG8_MMA
#undef PG8_WAIT_V
#undef PG8_WAIT_L
#undef PG8_BAR
#undef PG8_SCHED
}
}
namespace pg8 {
struct EpiProj {
    static constexpr bool PERM = true, AFTER_DRAIN = false;
    bf16_t* PA; bf16_t* PB;
    __device__ __forceinline__ void operator()(const f32x4 (&acc)[2][2][4][2], const Unit& u, int wr, int wc, int fr, int fq) const {
        const int row0 = u.pm * BM + wr * 64 + fr;
        bf16_t* base; int ldc, colt;
        if (u.po < 7) { base = PA; ldc = 1792; colt = u.po * BM; } else { base = PB; ldc = 1536; colt = (u.po - 7) * BM; }
        const int col0 = colt + wc * 32 + 8 * fq;
#pragma unroll
        for (int ai = 0; ai < 2; ++ai)
#pragma unroll
            for (int m = 0; m < 4; ++m) { bf16_t* rowp = base + (size_t)(row0 + ai * HALF + m * 16) * ldc + col0;
#pragma unroll
                for (int bj = 0; bj < 2; ++bj) { const f32x4 v0 = acc[ai][bj][m][0], v1 = acc[ai][bj][m][1];
                    u32x4 w; w.x = cvt_pk_bf16(v0[0], v0[1]); w.y = cvt_pk_bf16(v0[2], v0[3]); w.z = cvt_pk_bf16(v1[0], v1[1]); w.w = cvt_pk_bf16(v1[2], v1[3]);
                    *(u32x4*)(rowp + bj * HALF) = w; } }
    }
};
struct EpiBf16Plain {
    static constexpr bool PERM = true, AFTER_DRAIN = false;
    bf16_t* O; int ldc;
    __device__ __forceinline__ void operator()(const f32x4 (&acc)[2][2][4][2], const Unit& u, int wr, int wc, int fr, int fq) const {
        const int row0 = u.pm * BM + wr * 64 + fr;
        const int col0 = u.po * BM + wc * 32 + 8 * fq;
#pragma unroll
        for (int ai = 0; ai < 2; ++ai)
#pragma unroll
            for (int m = 0; m < 4; ++m) { bf16_t* rowp = O + (size_t)(row0 + ai * HALF + m * 16) * ldc + col0;
#pragma unroll
                for (int bj = 0; bj < 2; ++bj) { const f32x4 v0 = acc[ai][bj][m][0], v1 = acc[ai][bj][m][1];
                    u32x4 w; w.x = cvt_pk_bf16(v0[0], v0[1]); w.y = cvt_pk_bf16(v0[2], v0[3]); w.z = cvt_pk_bf16(v1[0], v1[1]); w.w = cvt_pk_bf16(v1[2], v1[3]);
                    *(u32x4*)(rowp + bj * HALF) = w; } }
    }
};
struct EpiSwiglu {
    static constexpr bool PERM = true, AFTER_DRAIN = false;
    bf16_t* H; int ldc; long rowoff;
    __device__ __forceinline__ void operator()(const f32x4 (&acc)[2][2][4][2], const Unit& u, int wr, int wc, int fr, int fq) const {
        const long row0 = (long)u.pm * BM + wr * 64 + fr + rowoff;
        const int col0 = u.po * HALF + wc * 32 + 8 * fq;
#pragma unroll
        for (int ai = 0; ai < 2; ++ai)
#pragma unroll
            for (int m = 0; m < 4; ++m) { bf16_t* rowp = H + (size_t)(row0 + ai * HALF + m * 16) * ldc + col0;
                float o[8];
#pragma unroll
                for (int n = 0; n < 2; ++n)
#pragma unroll
                    for (int j = 0; j < 4; ++j) { const float g = acc[ai][0][m][n][j], up = acc[ai][1][m][n][j];
                        const float s = g * __builtin_amdgcn_rcpf(1.0f + __builtin_amdgcn_exp2f(-1.4426950408889634f * g)); o[n * 4 + j] = s * up; }
                u32x4 w; w.x = cvt_pk_bf16(o[0], o[1]); w.y = cvt_pk_bf16(o[2], o[3]); w.z = cvt_pk_bf16(o[4], o[5]); w.w = cvt_pk_bf16(o[6], o[7]);
                *(u32x4*)rowp = w; }
    }
};
struct EpiMoeDown {
    static constexpr bool PERM = true, AFTER_DRAIN = false;
    bf16_t* O; int ldc; const float* gs;
    __device__ __forceinline__ void operator()(const f32x4 (&acc)[2][2][4][2], const Unit& u, int wr, int wc, int fr, int fq) const {
        const int row0 = u.pm * BM + wr * 64 + fr;
        const int col0 = u.po * BM + wc * 32 + 8 * fq;
#pragma unroll
        for (int ai = 0; ai < 2; ++ai)
#pragma unroll
            for (int m = 0; m < 4; ++m) { const int row = row0 + ai * HALF + m * 16; const float gt = gs[row]; bf16_t* rowp = O + (size_t)row * ldc + col0;
#pragma unroll
                for (int bj = 0; bj < 2; ++bj) { const f32x4 v0 = acc[ai][bj][m][0] * gt, v1 = acc[ai][bj][m][1] * gt;
                    u32x4 w; w.x = cvt_pk_bf16(v0[0], v0[1]); w.y = cvt_pk_bf16(v0[2], v0[3]); w.z = cvt_pk_bf16(v1[0], v1[1]); w.w = cvt_pk_bf16(v1[2], v1[3]);
                    *(u32x4*)(rowp + bj * HALF) = w; } }
    }
};
struct MoeOrder {
    int t0, nT, nN, nwg, G, c, nNe, arel;
    int ts1, ts2, ts3, ts4, ts5, ts6, ts7;
    __device__ bool next(int i, Unit& u) const {
        const long L = (long)i * G + c; if (L >= nwg) return false;
        int wgid = (int)L; { const int q = nwg / NXCD, r = nwg % NXCD, xcd = wgid % NXCD, off = wgid / NXCD; wgid = (xcd < r ? xcd * (q + 1) : r * (q + 1) + (xcd - r) * q) + off; }
        const int nig = WGM * nN, gid = wgid / nig, fm = gid * WGM, gsz = (nT - fm) < WGM ? (nT - fm) : WGM;
        const int pml = fm + ((wgid % nig) % gsz), pnl = (wgid % nig) / gsz;
        u.pm = t0 + pml; u.pa = arel ? pml : u.pm; u.po = pnl;
        const int e = (u.pm >= ts1) + (u.pm >= ts2) + (u.pm >= ts3) + (u.pm >= ts4) + (u.pm >= ts5) + (u.pm >= ts6) + (u.pm >= ts7);
        u.pn = e * nNe + pnl; return true;
    }
    __device__ __forceinline__ void a_ready(const Unit&) const {}
    __device__ __forceinline__ void done(const Unit&) const {}
};
}
constexpr int NWAVES = 8;
constexpr int NBATCH = 4, SEQ = 8192, M = NBATCH * SEQ, D = 1024, NH = 8, HD = 64;
constexpr int NA = 1792, NPB = 1536, NPROJ = NA + NPB, FF = 3584, NE = 8;
constexpr int MOE_PART_TILES = 64, MOE_PARTS = 5;
constexpr float NORM_EPS = 1e-6f, LNX_EPS = 64e-5f, DECAY_SCALE = 0.6065306597126334f;
constexpr float SB_EXIT = -104.0f;

constexpr size_t MiB = 1u << 20;
constexpr size_t WS_CTL = 0, CTL_ZERO_BYTES = 1 * MiB;
constexpr size_t WS_WIN0 = 1 * MiB, WS_WIN1 = 8 * MiB, WS_WOUT0 = 15 * MiB, WS_WOUT1 = 17 * MiB, WS_WGU0 = 19 * MiB, WS_WDN0 = 33 * MiB;
constexpr size_t WS_SEL = 40 * MiB, WS_GTS = WS_SEL + 128 * 1024, WS_POS = WS_GTS + 256 * 1024, WS_GSORT = WS_POS + 256 * 1024;
constexpr size_t WS_HN = 41 * MiB, WS_YMIX = 105 * MiB, WS_VF = 169 * MiB, WS_PA = 201 * MiB, WS_PB = 313 * MiB, WS_Y = 409 * MiB;
constexpr size_t WS_H0 = 201 * MiB;
constexpr size_t WS_F = WS_YMIX;
constexpr size_t WS_WMGU = 105 * MiB, WS_WMDN = 217 * MiB, WS_HS = 273 * MiB, WS_HP = 405 * MiB, WS_END = 517 * MiB;
static_assert(WS_WIN0 + (size_t)NPROJ * D * 2 <= WS_WIN1 && WS_WIN1 + (size_t)NPROJ * D * 2 <= WS_WOUT0 && WS_WGU0 + (size_t)2 * FF * D * 2 <= WS_WDN0 && WS_WDN0 + (size_t)D * FF * 2 <= WS_SEL, "weights map");
static_assert(WS_GSORT + (size_t)(2 * M + 2048) * 4 <= WS_HN, "routing tables");
static_assert(WS_PA + (size_t)M * NA * 2 <= WS_PB && WS_PB + (size_t)M * NPB * 2 <= WS_Y && WS_H0 + (size_t)M * FF * 2 <= WS_END, "act map");
static_assert(WS_WMGU + (size_t)NE * 2 * FF * D * 2 <= WS_WMDN && WS_WMDN + (size_t)NE * D * FF * 2 <= WS_HS && WS_HS + (size_t)(2 * M + 2048) * D * 2 <= WS_HP && WS_HP + (size_t)MOE_PART_TILES * 256 * FF * 2 <= WS_END, "moe map");
constexpr int CW_BAR = 4096, CW_TOT = 16384, CW_CUR = 16384 + 1024;

constexpr int RING_BYTES = 131072, MISC_OFF = RING_BYTES + 320, LDS_BYTES = 147456;

#define GAS __attribute__((address_space(1)))
#define LAS __attribute__((address_space(3)))
typedef unsigned short bf16;
typedef unsigned v4u __attribute__((ext_vector_type(4)));
typedef unsigned v2u __attribute__((ext_vector_type(2)));
typedef float f32x4 __attribute__((ext_vector_type(4)));
typedef float f32x16 __attribute__((ext_vector_type(16)));
typedef short bf16x8 __attribute__((ext_vector_type(8)));
typedef short s16x4 __attribute__((ext_vector_type(4)));
typedef float f32x2_t __attribute__((ext_vector_type(2)));
typedef __bf16 bf16x2_t __attribute__((ext_vector_type(2)));
#define RLX_AGENT __ATOMIC_RELAXED, __HIP_MEMORY_SCOPE_AGENT
#define LDS_WAIT() asm volatile("s_waitcnt lgkmcnt(0)" ::: "memory")
#define DI __device__ __forceinline__
#define MFMA32(a, b, c) __builtin_amdgcn_mfma_f32_32x32x16_bf16((a), (b), (c), 0, 0, 0)

DI unsigned cvtpk(float lo, float hi) { f32x2_t v = {lo, hi}; bf16x2_t b = __builtin_convertvector(v, bf16x2_t); return __builtin_bit_cast(unsigned, b); }
DI unsigned short f2bf(float f) { return (unsigned short)(cvtpk(f, 0.f) & 0xffffu); }
DI float bf2f(unsigned short u) { return __uint_as_float((unsigned)u << 16); }
DI float bflo(unsigned u) { return __uint_as_float(u << 16); }
DI float bfhi(unsigned u) { return __uint_as_float(u & 0xffff0000u); }
DI float wave_sum(float v) {
#pragma unroll
    for (int o = 1; o < 64; o <<= 1) v += __shfl_xor(v, o);
    return v;
}
DI float sigmoidf_(float x) { return __builtin_amdgcn_rcpf(1.0f + __expf(-x)); }
DI int crow(int r, int hi) { return (r & 3) + 8 * (r >> 2) + 4 * hi; }

#define XB_TMO      128
#define XB_XCNT(j)  (256  + 64 * (j))
#define XB_XSUB(j)  (1280 + 64 * (j))
#define XB_XGEN(j)  (2304 + 64 * (j))
#define XB_TOP      3328
#define XB_TOPGEN   3392
#define XCD_BAR_WORDS 3456
#define XB_SPIN_CAP (1u << 22)
DI unsigned xb_ld(unsigned* p)              { return __hip_atomic_load(p, __ATOMIC_RELAXED, __HIP_MEMORY_SCOPE_AGENT); }
DI unsigned xb_add(unsigned* p, unsigned v) { return __hip_atomic_fetch_add(p, v, __ATOMIC_RELAXED, __HIP_MEMORY_SCOPE_AGENT); }
DI unsigned xb_xcc_id() { return (unsigned)__builtin_amdgcn_s_getreg((3 << 11) | 20) & 0xFu; }
#define XB_SPIN(cond, bar) do { unsigned _sp = 0; while (cond) { __builtin_amdgcn_s_sleep(1); \
    if ((++_sp & 255u) == 0u) { if (xb_ld(&(bar)[XB_TMO])) break; if (_sp > XB_SPIN_CAP) { atomicAdd(&(bar)[XB_TMO], 1u); break; } } } } while (0)
struct XcdBarrier { unsigned* bar; unsigned x; volatile LAS unsigned* st; };
DI XcdBarrier xcd_barrier_post(unsigned* bar, volatile LAS unsigned* st) {
    XcdBarrier b; b.bar = bar; b.x = xb_xcc_id(); b.st = st;
    if (threadIdx.x == 0) (void)xb_add(&bar[XB_XCNT(b.x)], 1u);
    return b;
}
DI void xcd_barrier_complete(unsigned* bar, unsigned x, unsigned& nloc, unsigned& nx) {
    const unsigned G = gridDim.x * gridDim.y * gridDim.z;
    unsigned sum, cnt, mine, sp = 0u;
    for (;;) {
        sum = 0u; cnt = 0u; mine = 0u;
#pragma unroll
        for (unsigned j = 0; j < 16; ++j) { const unsigned c = xb_ld(&bar[XB_XCNT(j)]); sum += c; cnt += (c > 0u) ? 1u : 0u; mine = (j == x) ? c : mine; }
        if (sum == G) break;
        __builtin_amdgcn_s_sleep(1);
        if ((++sp & 255u) == 0u) { if (xb_ld(&bar[XB_TMO])) break; if (sp > XB_SPIN_CAP) { atomicAdd(&bar[XB_TMO], 1u); break; } }
    }
    nloc = mine > 0u ? mine : 1u; nx = cnt > 0u ? cnt : 1u;
}
DI void xcd_barrier(const XcdBarrier& b) {
    asm volatile("s_waitcnt vmcnt(0)" ::: "memory");
    __syncthreads();
    if (threadIdx.x == 0) {
        unsigned* bar = b.bar; unsigned bx = b.x;
        asm volatile("" : "+s"(bar), "+s"(bx));
        __builtin_amdgcn_s_waitcnt(0);
        unsigned nloc = b.st[0], nx = b.st[1];
        if (nloc == 0u) { xcd_barrier_complete(bar, bx, nloc, nx); b.st[0] = nloc; b.st[1] = nx; }
        const unsigned old = xb_add(&bar[XB_XSUB(bx)], 1u);
        const unsigned gen = old / nloc;
        if (old + 1u == (gen + 1u) * nloc) {
            __builtin_amdgcn_fence(__ATOMIC_RELEASE, "agent");
            asm volatile("s_waitcnt vmcnt(0)" ::: "memory");
            const unsigned og = xb_add(&bar[XB_TOP], 1u);
            const unsigned tg = og / nx;
            if (og + 1u == (tg + 1u) * nx) xb_add(&bar[XB_TOPGEN], 1u);
            else XB_SPIN(xb_ld(&bar[XB_TOPGEN]) == tg, bar);
            __builtin_amdgcn_fence(__ATOMIC_ACQUIRE, "agent");
            xb_add(&bar[XB_XGEN(bx)], 1u);
            asm volatile("s_waitcnt vmcnt(0)" ::: "memory");
        } else {
            XB_SPIN(xb_ld(&bar[XB_XGEN(bx)]) == gen, bar);
            __builtin_amdgcn_fence(__ATOMIC_ACQUIRE, "agent");
            asm volatile("s_waitcnt vmcnt(0)" ::: "memory");
        }
    }
    __syncthreads();
}

DI void transpose_item(const float* W, int N, int k0, int n0, bf16* WT, int Kt, int drow0, LAS float* scr, int lane) {
#pragma unroll 8
    for (int i = 0; i < 32; ++i) { const int kk = 2 * i + (lane >> 5); scr[kk * 33 + (lane & 31)] = W[(size_t)(k0 + kk) * N + n0 + (lane & 31)]; }
    LDS_WAIT(); asm volatile("" ::: "memory");
    const int c = lane & 7;
#pragma unroll
    for (int j = 0; j < 4; ++j) { const int n = (lane >> 3) + 8 * j; const LAS float* s = scr + (8 * c) * 33 + n;
        v4u o; o.x = cvtpk(s[0 * 33], s[1 * 33]); o.y = cvtpk(s[2 * 33], s[3 * 33]); o.z = cvtpk(s[4 * 33], s[5 * 33]); o.w = cvtpk(s[6 * 33], s[7 * 33]);
        *(GAS v4u*)(WT + (size_t)(drow0 + n) * Kt + k0 + 8 * c) = o; }
    LDS_WAIT(); asm volatile("" ::: "memory");
}
template <int MODE>
DI void conv_matrix(const float* W, int K, int N, bf16* WT, int nrw, LAS float* scr, int gw, int NGW, int lane) {
    const int nblk = N / 32, nitems = (K / 64) * nblk;
    for (int it = gw; it < nitems; it += NGW) {
        const int kb = it / nblk, nb = it % nblk, n0 = nb * 32;
        int drow0;
        if (MODE == 0) drow0 = n0;
        else if (MODE == 1) drow0 = n0 < nrw ? n0 : NA + (n0 - nrw);
        else if (MODE == 2) drow0 = (n0 >> 7) * 256 + (n0 & 127);
        else drow0 = (n0 >> 7) * 256 + 128 + (n0 & 127);
        transpose_item(W, N, kb * 64, n0, WT, K, drow0, scr, lane);
    }
}
DI void zero_rows(bf16* WT, int Kt, int r0, int r1, int gw, int NGW, int lane) {
    const int per = Kt / 8;
    const long total = (long)(r1 - r0) * per;
    for (long i = (long)gw * 64 + lane; i < total; i += (long)NGW * 64) *(GAS v4u*)(WT + (size_t)r0 * Kt + i * 8) = (v4u){0u, 0u, 0u, 0u};
}

DI float dot4(f32x4 a) { return (a.x * a.x + a.y * a.y) + (a.z * a.z + a.w * a.w); }
DI f32x4 ld_bf16x4(const bf16* p) { const v2u u = *(const GAS v2u*)p; return (f32x4){bflo(u.x), bfhi(u.x), bflo(u.y), bfhi(u.y)}; }
DI void st_bf16x4(bf16* p, f32x4 v) { v2u u; u.x = cvtpk(v.x, v.y); u.y = cvtpk(v.z, v.w); *(GAS v2u*)p = u; }

DI void phase_norm0(const float* x, const float* g, bf16* hn, int gw, int NGW, int lane) {
    f32x4 gv[4];
#pragma unroll
    for (int j = 0; j < 4; ++j) gv[j] = *(const f32x4*)(g + 4 * lane + 256 * j);
    for (int m = gw; m < M; m += NGW) {
        f32x4 v[4]; float s = 0.f;
#pragma unroll
        for (int j = 0; j < 4; ++j) { v[j] = *(const GAS f32x4*)(x + (size_t)m * D + 4 * lane + 256 * j); s += dot4(v[j]); }
        const float rs = rsqrtf(wave_sum(s) * (1.f / D) + NORM_EPS);
#pragma unroll
        for (int j = 0; j < 4; ++j) st_bf16x4(hn + (size_t)m * D + 4 * lane + 256 * j, v[j] * rs * gv[j]);
    }
}
template <bool MOEF>
DI void phase_resnorm(const float* xin, const bf16* y, const unsigned* pos, const float* g1, const float* g2, float* xout, bf16* hn,
                      const float* rt, unsigned* sel, float* gts, unsigned* totals, int gw, int NGW, int lane) {
    f32x4 g1v[4], g2v[4];
#pragma unroll
    for (int j = 0; j < 4; ++j) { g1v[j] = *(const f32x4*)(g1 + 4 * lane + 256 * j); g2v[j] = g2 ? *(const f32x4*)(g2 + 4 * lane + 256 * j) : (f32x4){0.f, 0.f, 0.f, 0.f}; }
    unsigned mycnt = 0;
    for (int m = gw; m < M; m += NGW) {
        f32x4 v[4], yv[4]; float s = 0.f;
        if (MOEF) {
            const unsigned p0 = __hip_atomic_load(pos + 2 * m, RLX_AGENT), p1 = __hip_atomic_load(pos + 2 * m + 1, RLX_AGENT);
#pragma unroll
            for (int j = 0; j < 4; ++j) yv[j] = ld_bf16x4(y + (size_t)p0 * D + 4 * lane + 256 * j) + ld_bf16x4(y + (size_t)p1 * D + 4 * lane + 256 * j);
        } else {
#pragma unroll
            for (int j = 0; j < 4; ++j) yv[j] = ld_bf16x4(y + (size_t)m * D + 4 * lane + 256 * j);
        }
#pragma unroll
        for (int j = 0; j < 4; ++j) { v[j] = *(const GAS f32x4*)(xin + (size_t)m * D + 4 * lane + 256 * j); s += dot4(yv[j]); }
        const float rsy = rsqrtf(wave_sum(s) * (1.f / D) + NORM_EPS);
        float s2 = 0.f;
#pragma unroll
        for (int j = 0; j < 4; ++j) { v[j] = v[j] + yv[j] * rsy * g1v[j]; s2 += dot4(v[j]); *(GAS f32x4*)(xout + (size_t)m * D + 4 * lane + 256 * j) = v[j]; }
        if (g2) {
            const float rsx = rsqrtf(wave_sum(s2) * (1.f / D) + NORM_EPS);
#pragma unroll
            for (int j = 0; j < 4; ++j) { v[j] = v[j] * rsx * g2v[j]; st_bf16x4(hn + (size_t)m * D + 4 * lane + 256 * j, v[j]); }
            if (rt) {
                float pe[8];
#pragma unroll
                for (int e = 0; e < 8; ++e) pe[e] = 0.f;
#pragma unroll
                for (int j = 0; j < 4; ++j)
#pragma unroll
                    for (int i = 0; i < 4; ++i) { const float hv = v[j][i]; const float* rp = rt + (size_t)(4 * lane + 256 * j + i) * 8;
                        const f32x4 ra = *(const f32x4*)rp, rb = *(const f32x4*)(rp + 4);
                        pe[0] += hv * ra.x; pe[1] += hv * ra.y; pe[2] += hv * ra.z; pe[3] += hv * ra.w; pe[4] += hv * rb.x; pe[5] += hv * rb.y; pe[6] += hv * rb.z; pe[7] += hv * rb.w; }
                float v0 = -3.0e38f, v1 = -3.0e38f; int e0 = 0, e1 = 0;
#pragma unroll
                for (int e = 0; e < 8; ++e) { const float lg = wave_sum(pe[e]); if (lg > v0) { v1 = v0; e1 = e0; v0 = lg; e0 = e; } else if (lg > v1) { v1 = lg; e1 = e; } }
                const float ga = 1.0f / (1.0f + __expf(v1 - v0)), gb = 1.0f - ga;
                if (lane == 0) { sel[m] = (unsigned)e0 | ((unsigned)e1 << 8); gts[2 * m] = ga; gts[2 * m + 1] = gb; }
                if (lane == e0 || lane == e1) ++mycnt;
            }
        }
    }
    if (rt && lane < 8 && mycnt) __hip_atomic_fetch_add(totals + 64 * lane, mycnt, RLX_AGENT);
}

DI int moe_offsets(unsigned* totals, int lane, int& mytot) {
    int off = 0; mytot = 0;
#pragma unroll
    for (int e = 0; e < 8; ++e) { const int t = (int)__hip_atomic_load(totals + 64 * e, RLX_AGENT); if (e < lane) off += (t + 255) & ~255; if (e == lane) mytot = t; }
    return off;
}

DI void phase_moe_sort(const unsigned* sel, const float* gts, unsigned* totals, unsigned* cursor, unsigned* pos, float* gsort, const bf16* hn, bf16* hs, int gw, int NGW, int lane) {
    int mytot; const int myoff = moe_offsets(totals, lane, mytot);
    unsigned mycnt = 0;
    for (int m = gw; m < M; m += NGW) { const unsigned s = __hip_atomic_load(sel + m, RLX_AGENT); const int e0 = s & 255, e1 = (s >> 8) & 255; if (lane == e0 || lane == e1) ++mycnt; }
    unsigned mybase = 0;
    if (lane < 8 && mycnt) mybase = __hip_atomic_fetch_add(cursor + 64 * lane, mycnt, RLX_AGENT);
    unsigned mypos = (unsigned)myoff + mybase;
    for (int m = gw; m < M; m += NGW) {
        const unsigned s = __hip_atomic_load(sel + m, RLX_AGENT); const int e0 = s & 255, e1 = (s >> 8) & 255;
        const unsigned p0 = __shfl(mypos, e0), p1 = __shfl(mypos, e1);
        if (lane == e0 || lane == e1) ++mypos;
        if (lane == 0) { pos[2 * m] = p0; pos[2 * m + 1] = p1; gsort[p0] = __hip_atomic_load(gts + 2 * m, RLX_AGENT); gsort[p1] = __hip_atomic_load(gts + 2 * m + 1, RLX_AGENT); }
        const v4u a = *(const GAS v4u*)(hn + (size_t)m * D + 8 * lane), b = *(const GAS v4u*)(hn + (size_t)m * D + 512 + 8 * lane);
        *(GAS v4u*)(hs + (size_t)p0 * D + 8 * lane) = a; *(GAS v4u*)(hs + (size_t)p0 * D + 512 + 8 * lane) = b;
        *(GAS v4u*)(hs + (size_t)p1 * D + 8 * lane) = a; *(GAS v4u*)(hs + (size_t)p1 * D + 512 + 8 * lane) = b;
    }
#pragma unroll 1
    for (int e = 0; e < 8; ++e) {
        const int r0 = __shfl(myoff + mytot, e), r1 = __shfl(myoff + ((mytot + 255) & ~255), e);
        for (int r = r0 + gw; r < r1; r += NGW) { *(GAS v4u*)(hs + (size_t)r * D + 8 * lane) = (v4u){0u, 0u, 0u, 0u}; *(GAS v4u*)(hs + (size_t)r * D + 512 + 8 * lane) = (v4u){0u, 0u, 0u, 0u}; if (lane == 0) gsort[r] = 0.f; }
    }
}
struct RwkvP {
    const bf16* PA;
    const float *mu, *decay0, *decay_up, *iclr0, *iclr_up, *gate_up, *vres0, *vres_up, *k_k, *k_a, *r_k, *lnx_g, *lnx_b;
    bf16* vfirst;
    bf16* ymix;
    int has_vres;
};
DI void rwkv_seq_unit(const RwkvP& P, int b, int h, LAS unsigned char* lds, int tid) {
    const int lane = tid & 63, wave = __builtin_amdgcn_readfirstlane(tid >> 6);
    LAS float* SM = (LAS float*)lds;
    LAS float* Rl = (LAS float*)lds;            LAS float* Wl = Rl + 4096; LAS float* Kl = Rl + 8192; LAS float* Vl = Rl + 12288; LAS float* Zl = Rl + 16384; LAS float* Bl = Rl + 20480;
    LAS float* Yl = Rl + 24576;
    const int hc = h * 64 + lane;
    const float mu_r = P.mu[hc], mu_k = P.mu[512 + hc], mu_v = P.mu[1024 + hc];
    const float d0 = P.decay0[hc], i0 = P.iclr0[hc], vr0 = P.has_vres ? P.vres0[hc] : 0.f;
    const float kk_c = P.k_k[hc], ka_c = P.k_a[hc], rk_c = P.r_k[hc], lg_c = P.lnx_g[hc], lb_c = P.lnx_b[hc];
    LAS float* STl = Rl + 28672;
    for (int i = tid; i < 4096; i += NWAVES * 64) STl[i] = 0.f;
    const size_t rowb = (size_t)b * SEQ;
#pragma unroll 1
    for (int ch = 0; ch < SEQ / 64; ++ch) {
        const int t0 = ch * 64;
        for (int idx = tid; idx < 64 * 192; idx += NWAVES * 64) {
            const int t = idx / 192, c = idx % 192;
            float val = 0.f;
            if (c < 160 || P.has_vres) {
                const size_t row = rowb + t0 + t;
                const float cur = bf2f(P.PA[row * NA + 1536 + c]);
                const float prev = (t0 + t == 0) ? 0.f : bf2f(P.PA[(row - 1) * NA + 1536 + c]);
                const float xs = cur + P.mu[1536 + c] * (prev - cur);
                val = c < 32 ? tanhf(xs) : (c < 64 ? xs : (c < 160 ? sigmoidf_(xs) : xs));
            }
            SM[idx] = val;
        }
        __syncthreads();
        float dpre[8], ipre[8], gat[8], vpre[8];
#pragma unroll
        for (int i = 0; i < 8; ++i) { dpre[i] = d0; ipre[i] = i0; gat[i] = 0.f; vpre[i] = vr0; }
#pragma unroll 4
        for (int j = 0; j < 32; ++j) {
            const float wd = P.decay_up[j * 512 + hc], wi = P.iclr_up[j * 512 + hc], wv = P.has_vres ? P.vres_up[j * 512 + hc] : 0.f;
#pragma unroll
            for (int i = 0; i < 8; ++i) { const LAS float* sm = SM + (wave + 8 * i) * 192; dpre[i] += sm[j] * wd; ipre[i] += sm[32 + j] * wi; vpre[i] += sm[160 + j] * wv; }
        }
#pragma unroll 4
        for (int j = 0; j < 96; ++j) {
            const float wg = P.gate_up[j * 512 + hc];
#pragma unroll
            for (int i = 0; i < 8; ++i) gat[i] += SM[(wave + 8 * i) * 192 + 64 + j] * wg;
        }
        __syncthreads();
        float vv[8], bon[8];
#pragma unroll
        for (int i = 0; i < 8; ++i) {
            const int t = wave + 8 * i; const size_t row = rowb + t0 + t; const bool first = (t0 + t == 0);
            const bf16* pr = P.PA + row * NA; const bf16* pp = pr - NA;
            float r = bf2f(pr[hc]), k0 = bf2f(pr[512 + hc]), v = bf2f(pr[1024 + hc]);
            const float rp = first ? 0.f : bf2f(pp[hc]), kp = first ? 0.f : bf2f(pp[512 + hc]), vp = first ? 0.f : bf2f(pp[1024 + hc]);
            r = r + mu_r * (rp - r); k0 = k0 + mu_k * (kp - k0); v = v + mu_v * (vp - v);
            const float w = __expf(-DECAY_SCALE * sigmoidf_(dpre[i]));
            const float a = sigmoidf_(ipre[i]);
            if (P.has_vres) { const float vf = bf2f(P.vfirst[row * 512 + hc]); v = v + (vf - v) * sigmoidf_(vpre[i]); }
            else P.vfirst[row * 512 + hc] = f2bf(v);
            float kk = k0 * kk_c;
            const float nn = wave_sum(kk * kk);
            kk = kk * rsqrtf(fmaxf(nn, 1e-12f));
            const float k = k0 * (1.0f + (a - 1.0f) * ka_c);
            bon[i] = wave_sum(r * k * rk_c);
            vv[i] = v;
            Rl[t * 64 + lane] = r; Wl[t * 64 + lane] = w; Kl[t * 64 + lane] = k; Vl[t * 64 + lane] = v; Zl[t * 64 + lane] = -kk; Bl[t * 64 + lane] = kk * a;
        }
        __syncthreads();
        if (wave == 0) {
            float st[64];
#pragma unroll
            for (int j = 0; j < 64; ++j) st[j] = STl[j * 64 + lane];
#pragma unroll 1
            for (int t = 0; t < 64; ++t) {
                float sz = 0.f;
#pragma unroll
                for (int j = 0; j < 64; j += 4) { const f32x4 z = *(const LAS f32x4*)(Zl + t * 64 + j); sz += st[j] * z.x + st[j + 1] * z.y + st[j + 2] * z.z + st[j + 3] * z.w; if ((j & 12) == 12) asm volatile("" ::: "memory"); }
                const float vi = Vl[t * 64 + lane];
                float y = 0.f;
#pragma unroll
                for (int j = 0; j < 64; j += 4) {
                    const f32x4 w = *(const LAS f32x4*)(Wl + t * 64 + j), bb = *(const LAS f32x4*)(Bl + t * 64 + j), kq = *(const LAS f32x4*)(Kl + t * 64 + j), rr = *(const LAS f32x4*)(Rl + t * 64 + j);
                    st[j]     = st[j]     * w.x + (sz * bb.x + vi * kq.x);
                    st[j + 1] = st[j + 1] * w.y + (sz * bb.y + vi * kq.y);
                    st[j + 2] = st[j + 2] * w.z + (sz * bb.z + vi * kq.z);
                    st[j + 3] = st[j + 3] * w.w + (sz * bb.w + vi * kq.w);
                    y += st[j] * rr.x + st[j + 1] * rr.y + st[j + 2] * rr.z + st[j + 3] * rr.w;
                    if ((j & 4) == 4) asm volatile("" ::: "memory");
                }
                Yl[t * 64 + lane] = y;
            }
#pragma unroll
            for (int j = 0; j < 64; ++j) STl[j * 64 + lane] = st[j];
        }
        __syncthreads();
#pragma unroll
        for (int i = 0; i < 8; ++i) {
            const int t = wave + 8 * i; const size_t row = rowb + t0 + t;
            const float y = Yl[t * 64 + lane];
            const float mean = wave_sum(y) * (1.f / 64.f);
            const float dv = y - mean;
            const float var = wave_sum(dv * dv) * (1.f / 64.f);
            const float yn = dv * rsqrtf(var + LNX_EPS) * lg_c + lb_c;
            P.ymix[row * D + hc] = f2bf((yn + bon[i] * vv[i]) * gat[i]);
        }
        __syncthreads();
    }
}

constexpr int SB_VP = 40;
DI void sb_wave(const bf16* PB, bf16* ymix, const float* sb_g, int b, int h, int q0, LAS unsigned char* vtb, int lane) {
    const int qi = lane & 31, hh = lane >> 5;
    LAS bf16* vt = (LAS bf16*)vtb;
    const size_t rowb = (size_t)b * SEQ;
    bf16x8 qf[4];
#pragma unroll
    for (int s = 0; s < 4; ++s) qf[s] = *(const GAS bf16x8*)(PB + (rowb + q0 + qi) * NPB + h * 64 + 16 * s + 8 * hh);
    f32x16 o0, o1;
#pragma unroll
    for (int r = 0; r < 16; ++r) { o0[r] = 0.f; o1[r] = 0.f; }
    float carry = 0.f;
    const int q = q0 + qi;
#pragma unroll 1
    for (int kt = q0 / 32; kt >= 0; --kt) {
        const int kb = kt * 32;
        bf16x8 kf[4], vv[4];
#pragma unroll
        for (int s = 0; s < 4; ++s) kf[s] = *(const GAS bf16x8*)(PB + (rowb + kb + qi) * NPB + 512 + h * 64 + 16 * s + 8 * hh);
#pragma unroll
        for (int i = 0; i < 4; ++i) vv[i] = *(const GAS bf16x8*)(PB + (rowb + kb + qi) * NPB + 1024 + h * 64 + 32 * hh + 8 * i);
#pragma unroll
        for (int i = 0; i < 4; ++i)
#pragma unroll
            for (int e = 0; e < 8; ++e) vt[(32 * hh + 8 * i + e) * SB_VP + qi] = (bf16)vv[i][e];
        f32x16 sc;
#pragma unroll
        for (int r = 0; r < 16; ++r) sc[r] = 0.f;
#pragma unroll
        for (int s = 0; s < 4; ++s) sc = MFMA32(kf[s], qf[s], sc);
        float c[16], ls[16];
        const bool diag = (kb == q0);
#pragma unroll
        for (int r = 0; r < 16; ++r) {
            const float z = sc[r] * 0.125f;
            const float sp = fmaxf(z, 0.f) + __logf(1.0f + __expf(-fabsf(z)));
            const bool valid = !diag || (kb + crow(r, hh) < q);
            c[r] = valid ? -sp : 0.f;
            ls[r] = valid ? z - sp : -1.0e30f;
        }
        float G[4], PG[4];
#pragma unroll
        for (int g = 0; g < 4; ++g) { G[g] = (c[4 * g] + c[4 * g + 1]) + (c[4 * g + 2] + c[4 * g + 3]); PG[g] = __shfl_xor(G[g], 32); }
        float att[16];
        float after = carry;
#pragma unroll
        for (int g = 3; g >= 0; --g) {
            float sfx = after + (hh == 0 ? PG[g] : 0.f);
#pragma unroll
            for (int i = 3; i >= 0; --i) { att[4 * g + i] = __expf(ls[4 * g + i] + sfx); sfx += c[4 * g + i]; }
            after += G[g] + PG[g];
        }
        carry = after;
        bf16x8 pf[2];
#pragma unroll
        for (int s = 0; s < 2; ++s) { v4u p; p.x = cvtpk(att[8 * s], att[8 * s + 1]); p.y = cvtpk(att[8 * s + 2], att[8 * s + 3]); p.z = cvtpk(att[8 * s + 4], att[8 * s + 5]); p.w = cvtpk(att[8 * s + 6], att[8 * s + 7]); pf[s] = __builtin_bit_cast(bf16x8, p); }
        LDS_WAIT();
#pragma unroll
        for (int s = 0; s < 2; ++s) {
            const s16x4 a0 = *(const LAS s16x4*)(vt + qi * SB_VP + 16 * s + 4 * hh), a1 = *(const LAS s16x4*)(vt + qi * SB_VP + 16 * s + 8 + 4 * hh);
            const s16x4 b0 = *(const LAS s16x4*)(vt + (32 + qi) * SB_VP + 16 * s + 4 * hh), b1 = *(const LAS s16x4*)(vt + (32 + qi) * SB_VP + 16 * s + 8 + 4 * hh);
            const bf16x8 va = __builtin_shufflevector(a0, a1, 0, 1, 2, 3, 4, 5, 6, 7), vb = __builtin_shufflevector(b0, b1, 0, 1, 2, 3, 4, 5, 6, 7);
            o0 = MFMA32(va, pf[s], o0);
            o1 = MFMA32(vb, pf[s], o1);
        }
        LDS_WAIT();
        if (__all(carry < SB_EXIT)) break;
    }
    float ss = 0.f;
#pragma unroll
    for (int r = 0; r < 16; ++r) ss += o0[r] * o0[r] + o1[r] * o1[r];
    ss += __shfl_xor(ss, 32);
    const float scl = rsqrtf(ss * (1.f / 64.f) + NORM_EPS);
    bf16* orow = ymix + (rowb + q) * D + 512 + h * 64;
#pragma unroll
    for (int g = 0; g < 4; ++g) {
        const int d0 = 8 * g + 4 * hh;
        const f32x4 g0 = *(const f32x4*)(sb_g + h * 64 + d0), g1 = *(const f32x4*)(sb_g + h * 64 + 32 + d0);
        v2u w0, w1;
        w0.x = cvtpk(o0[4 * g] * scl * g0.x, o0[4 * g + 1] * scl * g0.y); w0.y = cvtpk(o0[4 * g + 2] * scl * g0.z, o0[4 * g + 3] * scl * g0.w);
        w1.x = cvtpk(o1[4 * g] * scl * g1.x, o1[4 * g + 1] * scl * g1.y); w1.y = cvtpk(o1[4 * g + 2] * scl * g1.z, o1[4 * g + 3] * scl * g1.w);
        *(GAS v2u*)(orow + d0) = w0; *(GAS v2u*)(orow + 32 + d0) = w1;
    }
}
constexpr int NPHASE = 24;
#ifndef MK_SINGLE
#define MK_SINGLE 0
#endif
struct Args { const float* in[46]; float* out; unsigned char* ws; int ph_lo, ph_hi; };

DI unsigned char* opq(unsigned char* p) { asm volatile("" : "+s"(p)); return p; }
DI int opqv(int v) { asm volatile("" : "+v"(v)); return v; }
DI const float* inp(int i) { const float* const* t = (const float* const*)__builtin_amdgcn_kernarg_segment_ptr(); asm volatile("" : "+s"(t)); return t[i]; }

__global__ void __launch_bounds__(NWAVES * 64, 2) fwd_kernel(Args args) {
    extern __shared__ __attribute__((aligned(16))) unsigned char lds_raw[];
    LAS unsigned char* lds = (LAS unsigned char*)lds_raw;
    volatile LAS unsigned* MISC = (volatile LAS unsigned*)(lds + MISC_OFF);
    const int tid0 = threadIdx.x, wave = __builtin_amdgcn_readfirstlane(tid0 >> 6);
    const int G = gridDim.x, blk = blockIdx.x;
    const int gw = blk * NWAVES + wave, NGW = G * NWAVES;
    unsigned char* ws0 = args.ws;
#define ws opq(ws0)
#define ctl ((unsigned*)(ws + WS_CTL))
    for (int u = tid0; u < (LDS_BYTES - RING_BYTES) / 4; u += NWAVES * 64) ((LAS unsigned*)(lds + RING_BYTES))[u] = 0u;
    __syncthreads();
    const int lo = args.ph_lo, hi = args.ph_hi;
    XcdBarrier bar; bar.bar = ctl + CW_BAR; bar.x = 0; bar.st = nullptr;
    if (hi - lo > 1) bar = xcd_barrier_post(ctl + CW_BAR, MISC + 8);
#ifndef PHMASK
#define PHMASK 0xFFFFFF
#endif
#define IN(k) (((PHMASK >> (k)) & 1) && lo <= (k) && (k) < hi)
#define SEAM(k) do { if (IN(k) && IN((k) + 1)) xcd_barrier(bar); } while (0)

#define B_HN ((bf16*)(ws + WS_HN))
#define B_YMIX ((bf16*)(ws + WS_YMIX))
#define B_VF ((bf16*)(ws + WS_VF))
#define B_PA ((bf16*)(ws + WS_PA))
#define B_PB ((bf16*)(ws + WS_PB))
#define B_Y ((bf16*)(ws + WS_Y))
    float* xo = args.out;
#define x_in inp(0)

    if (IN(0)) { const int tid = opqv(tid0), lane = tid & 63; (void)tid; (void)lane;
        LAS float* scr = (LAS float*)(lds + wave * 16384);
        conv_matrix<1>(inp(2), D, 3232, (bf16*)(ws + WS_WIN0), 1696, scr, gw, NGW, lane);
        conv_matrix<1>(inp(23), D, 3264, (bf16*)(ws + WS_WIN1), 1728, scr, gw, NGW, lane);
        zero_rows((bf16*)(ws + WS_WIN0), D, 1696, NA, gw, NGW, lane);
        zero_rows((bf16*)(ws + WS_WIN1), D, 1728, NA, gw, NGW, lane);
        conv_matrix<0>(inp(15), D, D, (bf16*)(ws + WS_WOUT0), 0, scr, gw, NGW, lane);
        conv_matrix<0>(inp(38), D, D, (bf16*)(ws + WS_WOUT1), 0, scr, gw, NGW, lane);
        conv_matrix<2>(inp(18), D, FF, (bf16*)(ws + WS_WGU0), 0, scr, gw, NGW, lane);
        conv_matrix<3>(inp(19), D, FF, (bf16*)(ws + WS_WGU0), 0, scr, gw, NGW, lane);
        conv_matrix<0>(inp(20), FF, D, (bf16*)(ws + WS_WDN0), 0, scr, gw, NGW, lane);
        phase_norm0(x_in, inp(1), B_HN, gw, NGW, lane);
    }
    SEAM(0);

#pragma unroll
    for (int l = 0; l < 2; ++l) {
        const int pb = l ? 8 : 1;
        if (IN(pb)) { const int tid = opqv(tid0), lane = tid & 63; (void)tid; (void)lane;
            pg8::Gemm g{B_HN, (const bf16*)(ws + (l ? WS_WIN1 : WS_WIN0)), M, NPROJ, D}; pg8::StaticOrder S; S.init(M, NPROJ, G, blk);
            pg8::EpiProj E{B_PA, B_PB};
            pg8::gemm_phase<pg8::EpiProj, pg8::StaticOrder, true, true>(lds, g, S, E);
        }
        SEAM(pb);
        if (IN(pb + 1)) { const int tid = opqv(tid0), lane = tid & 63; (void)tid; (void)lane;
            const int o = l ? 21 : 0;
            RwkvP P;
            P.PA = B_PA; P.mu = inp(3 + o); P.decay0 = inp(4 + o); P.decay_up = inp(5 + o); P.iclr0 = inp(6 + o); P.iclr_up = inp(7 + o); P.gate_up = inp(8 + o);
            P.vres0 = inp(30); P.vres_up = inp(31);
            const int o2 = l ? 23 : 0;
            P.k_k = inp(9 + o2); P.k_a = inp(10 + o2); P.r_k = inp(11 + o2); P.lnx_g = inp(12 + o2); P.lnx_b = inp(13 + o2);
            P.vfirst = B_VF; P.ymix = B_YMIX; P.has_vres = l;
            const float* sbg = inp(14 + o2);
            const bool split = G > 32;
#ifndef NO_RWKV
            if (!split || blk < 32) for (int ru = blk; ru < 32; ru += G) rwkv_seq_unit(P, ru >> 3, ru & 7, lds, tid);
#endif
#ifndef NO_SB
            if (!split || blk >= 32) {
                const int sbw = split ? G - 32 : G, sbi = split ? blk - 32 : blk;
                for (int u = sbi; u < NBATCH * NH * (SEQ / 256); u += sbw) {
                    const int qb = u & 31, bh = u >> 5;
                    sb_wave(B_PB, B_YMIX, sbg, bh >> 3, bh & 7, qb * 256 + wave * 32, lds + wave * 8192, lane);
                }
            }
#endif
        }
        SEAM(pb + 1);
        if (IN(pb + 2)) { const int tid = opqv(tid0), lane = tid & 63; (void)tid; (void)lane;
            pg8::Gemm g{B_YMIX, (const bf16*)(ws + (l ? WS_WOUT1 : WS_WOUT0)), M, D, D}; pg8::StaticOrder S; S.init(M, D, G, blk);
            pg8::EpiBf16Plain E{B_Y, D};
            pg8::gemm_phase<pg8::EpiBf16Plain, pg8::StaticOrder, true, true>(lds, g, S, E);
        }
        SEAM(pb + 2);
        if (IN(pb + 3)) { const int tid = opqv(tid0), lane = tid & 63; (void)tid; (void)lane;
            if (l == 0) phase_resnorm<false>(x_in, B_Y, nullptr, inp(16), inp(17), xo, B_HN, nullptr, nullptr, nullptr, nullptr, gw, NGW, lane);
            else phase_resnorm<false>(xo, B_Y, nullptr, inp(39), inp(40), xo, B_HN, inp(41), (unsigned*)(ws + WS_SEL), (float*)(ws + WS_GTS), ctl + CW_TOT, gw, NGW, lane);
        }
        SEAM(pb + 3);
    if (l == 0) {
        if (IN(5)) { const int tid = opqv(tid0), lane = tid & 63; (void)tid; (void)lane;
            pg8::Gemm g{B_HN, (const bf16*)(ws + WS_WGU0), M, 2 * FF, D}; pg8::StaticOrder S; S.init(M, 2 * FF, G, blk);
            pg8::EpiSwiglu E{(bf16*)(ws + WS_H0), FF, 0};
            pg8::gemm_phase<pg8::EpiSwiglu, pg8::StaticOrder, true, true>(lds, g, S, E);
        }
        SEAM(5);
        if (IN(6)) { const int tid = opqv(tid0), lane = tid & 63; (void)tid; (void)lane;
            pg8::Gemm g{(const bf16*)(ws + WS_H0), (const bf16*)(ws + WS_WDN0), M, D, FF}; pg8::StaticOrder S; S.init(M, D, G, blk);
            pg8::EpiBf16Plain E{(bf16*)(ws + WS_F), D};
            pg8::gemm_phase<pg8::EpiBf16Plain, pg8::StaticOrder, true, true>(lds, g, S, E);
        }
        SEAM(6);
        if (IN(7)) { const int tid = opqv(tid0), lane = tid & 63; (void)tid; phase_resnorm<false>(xo, (const bf16*)(ws + WS_F), nullptr, inp(21), inp(22), xo, B_HN, nullptr, nullptr, nullptr, nullptr, gw, NGW, lane); }
        SEAM(7);
    } else {
        if (IN(12)) { const int tid = opqv(tid0), lane = tid & 63; (void)tid; (void)lane;
            LAS float* scr = (LAS float*)(lds + wave * 16384);
#pragma unroll 1
            for (int e = 0; e < NE; ++e) {
                conv_matrix<2>(inp(42) + (size_t)e * D * FF, D, FF, (bf16*)(ws + WS_WMGU) + (size_t)e * 2 * FF * D, 0, scr, gw, NGW, lane);
                conv_matrix<3>(inp(43) + (size_t)e * D * FF, D, FF, (bf16*)(ws + WS_WMGU) + (size_t)e * 2 * FF * D, 0, scr, gw, NGW, lane);
                conv_matrix<0>(inp(44) + (size_t)e * D * FF, FF, D, (bf16*)(ws + WS_WMDN) + (size_t)e * D * FF, 0, scr, gw, NGW, lane);
            }
            phase_moe_sort((const unsigned*)(ws + WS_SEL), (const float*)(ws + WS_GTS), ctl + CW_TOT, ctl + CW_CUR, (unsigned*)(ws + WS_POS), (float*)(ws + WS_GSORT), B_HN, (bf16*)(ws + WS_HS), gw, NGW, lane);
        }
        SEAM(12);
#pragma unroll 1
        for (int p = 0; p < MOE_PARTS; ++p) {
            const int phg = 13 + 2 * p;
            if (IN(phg) || IN(phg + 1)) {
                const int lane = opqv(tid0) & 63;
                int mytot; const int myoff = moe_offsets(ctl + CW_TOT, lane, mytot);
                pg8::MoeOrder S;
                const int nTiles = __builtin_amdgcn_readfirstlane(__shfl(myoff, 8)) >> 8;
                S.ts1 = __builtin_amdgcn_readfirstlane(__shfl(myoff, 1)) >> 8; S.ts2 = __builtin_amdgcn_readfirstlane(__shfl(myoff, 2)) >> 8; S.ts3 = __builtin_amdgcn_readfirstlane(__shfl(myoff, 3)) >> 8;
                S.ts4 = __builtin_amdgcn_readfirstlane(__shfl(myoff, 4)) >> 8; S.ts5 = __builtin_amdgcn_readfirstlane(__shfl(myoff, 5)) >> 8; S.ts6 = __builtin_amdgcn_readfirstlane(__shfl(myoff, 6)) >> 8;
                S.ts7 = __builtin_amdgcn_readfirstlane(__shfl(myoff, 7)) >> 8;
                const int t0 = p * MOE_PART_TILES; int nT = nTiles - t0; nT = nT < 0 ? 0 : (nT > MOE_PART_TILES ? MOE_PART_TILES : nT);
                S.t0 = t0; S.nT = nT; S.G = G; S.c = blk;
                if (IN(phg)) { const int tid = opqv(tid0), lane = tid & 63; (void)tid; (void)lane;
                    S.nN = 2 * FF / 256; S.nwg = nT * S.nN; S.nNe = 2 * FF / 256; S.arel = 0;
                    pg8::Gemm g{(const bf16*)(ws + WS_HS), (const bf16*)(ws + WS_WMGU), 0, 0, D};
                    pg8::EpiSwiglu E{(bf16*)(ws + WS_HP), FF, -(long)t0 * 256};
                    pg8::gemm_phase<pg8::EpiSwiglu, pg8::MoeOrder, true, true>(lds, g, S, E);
                }
                SEAM(phg);
                if (IN(phg + 1)) { const int tid = opqv(tid0), lane = tid & 63; (void)tid; (void)lane;
                    S.nN = D / 256; S.nwg = nT * S.nN; S.nNe = D / 256; S.arel = 1;
                    pg8::Gemm g{(const bf16*)(ws + WS_HP), (const bf16*)(ws + WS_WMDN), 0, 0, FF};
                    pg8::EpiMoeDown E{(bf16*)(ws + WS_HS), D, (const float*)(ws + WS_GSORT)};
                    pg8::gemm_phase<pg8::EpiMoeDown, pg8::MoeOrder, true, true>(lds, g, S, E);
                }
                SEAM(phg + 1);
            }
        }
        if (IN(23)) { const int tid = opqv(tid0), lane = tid & 63; (void)tid; phase_resnorm<true>(xo, (const bf16*)(ws + WS_HS), (const unsigned*)(ws + WS_POS), inp(45), nullptr, xo, nullptr, nullptr, nullptr, nullptr, nullptr, gw, NGW, lane); }
    }
    }
#undef IN
#undef SEAM
#undef x_in
#undef ws
#undef ctl
#undef B_HN
#undef B_YMIX
#undef B_VF
#undef B_PA
#undef B_PB
#undef B_Y
}

extern "C" void kernel_launch(void* const* d_in, const int* in_sizes, int n_in, void* d_out, int out_size, void* d_ws, size_t ws_size, hipStream_t stream) {
    static int grid = 0;
    if (grid == 0) {
        if (n_in != 46 || in_sizes[0] != M * D || out_size != M * D || ws_size < WS_END) { fprintf(stderr, "kernel_launch: unexpected problem: n_in %d in0 %d out %d ws %zu (need %zu)\n", n_in, n_in > 0 ? in_sizes[0] : -1, out_size, ws_size, (size_t)WS_END); grid = -1; return; }
        int dev = 0, cus = 0, per_cu = 0;
        if (hipGetDevice(&dev) != hipSuccess || hipDeviceGetAttribute(&cus, hipDeviceAttributeMultiprocessorCount, dev) != hipSuccess) { grid = -1; return; }
        if (hipFuncSetAttribute((const void*)fwd_kernel, hipFuncAttributeMaxDynamicSharedMemorySize, LDS_BYTES) != hipSuccess) { fprintf(stderr, "kernel_launch: hipFuncSetAttribute failed\n"); grid = -1; return; }
        if (hipOccupancyMaxActiveBlocksPerMultiprocessor(&per_cu, (const void*)fwd_kernel, NWAVES * 64, LDS_BYTES) != hipSuccess || per_cu < 1) { fprintf(stderr, "kernel_launch: occupancy query says %d\n", per_cu); }
        (void)hipGetLastError();
        grid = cus;
    }
    if (grid < 0) return;
    (void)hipMemsetAsync((char*)d_ws + WS_CTL, 0, CTL_ZERO_BYTES, stream);
    Args a{};
    for (int i = 0; i < 46; ++i) a.in[i] = (const float*)d_in[i];
    a.out = (float*)d_out; a.ws = (unsigned char*)d_ws;
#if MK_SINGLE
    a.ph_lo = 0; a.ph_hi = NPHASE;
    hipLaunchKernelGGL(fwd_kernel, dim3(grid), dim3(NWAVES * 64), LDS_BYTES, stream, a);
#else
    for (int p = 0; p < NPHASE; ++p) { a.ph_lo = p; a.ph_hi = p + 1; hipLaunchKernelGGL(fwd_kernel, dim3(grid), dim3(NWAVES * 64), LDS_BYTES, stream, a); }
#endif
}
```

```cpp
#include <hip/hip_runtime.h>
#include <cstdio>
#include <cstdint>
namespace pg8 {
#define PG8_LAS __attribute__((address_space(3)))
typedef unsigned short bf16_t;
typedef short bf16x8 __attribute__((ext_vector_type(8)));
typedef float f32x4 __attribute__((ext_vector_type(4)));
typedef unsigned u32x4 __attribute__((ext_vector_type(4)));
constexpr int BM = 256, BK = 64, HALF = 128, HTB = HALF * BK * 2  , STAGE_BYTES = 8 * HTB, NXCD = 8, WGM = 8;

__host__ __device__ __forceinline__ int lds_byte(int r, int c) { const int st = (r >> 4) * 2 + (c >> 5), rr = r & 15, cc = c & 31, ob = rr * 64 + cc * 2; return st * 1024 + (ob ^ (((ob >> 9) & 1) << 5)); }
__host__ __device__ __forceinline__ void stage_rc(int b, int& R, int& C) { const int st = b / 1024, sb = b % 1024, swz = sb ^ (((sb >> 9) & 1) << 5); R = (st >> 1) * 16 + swz / 64; C = (st & 1) * 32 + (swz % 64) / 2; }
__host__ __device__ __forceinline__ int perm32(int rho) { const int n = rho >> 4, i = rho & 15; return 8 * (i >> 2) + 4 * n + (i & 3); }

struct Unit { int pm, pa, pn, po; };
struct Gemm { const bf16_t* A; const bf16_t* Bt; int M, N, K; };

struct StaticOrder {
    int nM, nN, nwg, G, c;
    __host__ __device__ void init(int M, int N, int G_, int c_) { nM = M / BM; nN = N / BM; nwg = nM * nN; G = G_; c = c_; }
    __host__ __device__ bool next(int i, Unit& u) const {
        const long L = (long)i * G + c; if (L >= nwg) return false;
        int wgid = (int)L; { const int q = nwg / NXCD, r = nwg % NXCD, xcd = wgid % NXCD, off = wgid / NXCD; wgid = (xcd < r ? xcd * (q + 1) : r * (q + 1) + (xcd - r) * q) + off; }
        const int nig = WGM * nN, gid = wgid / nig, fm = gid * WGM, gsz = (nM - fm) < WGM ? (nM - fm) : WGM;
        u.pm = fm + ((wgid % nig) % gsz); u.pn = (wgid % nig) / gsz; u.pa = u.pm; u.po = u.pn; return true;
    }
    __device__ __forceinline__ void a_ready(const Unit&) const {}
    __device__ __forceinline__ void done(const Unit&) const {}
};

__device__ __forceinline__ unsigned cvt_pk_bf16(float lo, float hi) { unsigned r; asm volatile("v_cvt_pk_bf16_f32 %0, %1, %2" : "=v"(r) : "v"(lo), "v"(hi)); return r; }
typedef float f32x2 __attribute__((ext_vector_type(2)));

template <class Epi, class Sched, bool ALIGN_EPI = false, bool SP2 = false>
__device__ __forceinline__ void gemm_phase(PG8_LAS unsigned char* lds, const Gemm g, const Sched& S, const Epi& E) {
    int tid_ = threadIdx.x; asm volatile("" : "+v"(tid_));
    const int tid = tid_, wid = __builtin_amdgcn_readfirstlane(tid >> 6), lane = tid & 63, wr = wid >> 2, wc = wid & 3, fr = lane & 15, fq = lane >> 4;
    const int K = g.K, nt = K / BK;
    unsigned voffA[2], voffB[2];
#pragma unroll
    for (int i = 0; i < 2; ++i) { int R, C; stage_rc(tid * 16 + i * 8192, R, C); const int Rb = Epi::PERM ? ((R & ~31) + perm32(R & 31)) : R;
        voffA[i] = (unsigned)(R * K + C) * 2u; voffB[i] = (unsigned)(Rb * K + C) * 2u; }
    const size_t kstep = (size_t)(BK * 2);
    const size_t hstep = (size_t)HALF * K * 2;
    const size_t tstep = 2 * hstep;
    const unsigned ldsw = (unsigned)wid * 1024u;
    const int aoff = lds_byte(wr * 64 + fr, fq * 8), boff = lds_byte(wc * 32 + fr, fq * 8);
#define PG8_SA(b, h) (((b) * 2 + (h)) * HTB)
#define PG8_SB(b, h) ((4 + (b) * 2 + (h)) * HTB)
#define PG8_STAGE(bufoff, gbase, voff) do { _Pragma("unroll") for (int _i = 0; _i < 2; ++_i) \
        __builtin_amdgcn_global_load_lds((const unsigned*)((const char*)(gbase) + (voff)[_i]), (PG8_LAS unsigned*)(lds + (bufoff) + ldsw + _i * 8192), 16, 0, 0); } while (0)
#define PG8_LDA(dst, b, h) do { _Pragma("unroll") for (int m = 0; m < 4; ++m) _Pragma("unroll") for (int k = 0; k < 2; ++k) dst[m][k] = *(const PG8_LAS bf16x8*)(lds + PG8_SA(b, h) + aoff + m * 2048 + k * 1024); } while (0)
#define PG8_LDB(dst, b, h) do { _Pragma("unroll") for (int n = 0; n < 2; ++n) _Pragma("unroll") for (int k = 0; k < 2; ++k) dst[n][k] = *(const PG8_LAS bf16x8*)(lds + PG8_SB(b, h) + boff + n * 2048 + k * 1024); } while (0)
#define PG8_MMA(ai, bj, At, Bt) do { __builtin_amdgcn_s_setprio(1); _Pragma("unroll") for (int m = 0; m < 4; ++m) _Pragma("unroll") for (int n = 0; n < 2; ++n) _Pragma("unroll") for (int k = 0; k < 2; ++k) \
        acc[ai][bj][m][n] = __builtin_amdgcn_mfma_f32_16x16x32_bf16(Bt[n][k], At[m][k], acc[ai][bj][m][n], 0, 0, 0); __builtin_amdgcn_s_setprio(0); } while (0)
#define PG8_WAIT_V(n) asm volatile("s_waitcnt vmcnt(" #n ")" ::: "memory")
#define PG8_WAIT_L(n) asm volatile("s_waitcnt lgkmcnt(" #n ")" ::: "memory")
#define PG8_BAR __builtin_amdgcn_s_barrier()
#define PG8_SCHED __builtin_amdgcn_sched_barrier(0)
    Unit cur, nxt; int ui = 0;
    if (!S.next(0, cur)) return;
    f32x4 acc[2][2][4][2];
#pragma unroll
    for (int a = 0; a < 2; ++a)
#pragma unroll
        for (int b = 0; b < 2; ++b)
#pragma unroll
            for (int m = 0; m < 4; ++m)
#pragma unroll
                for (int n = 0; n < 2; ++n) acc[a][b][m][n] = (f32x4){0.f, 0.f, 0.f, 0.f};
    bf16x8 At[4][2], B0[2][2], B1[2][2];
    const char* cA = (const char*)g.A + (size_t)cur.pa * tstep; const char* cB = (const char*)g.Bt + (size_t)cur.pn * tstep;
    S.a_ready(cur);
    if constexpr (SP2) {
        PG8_STAGE(PG8_SB(0, 0), cB, voffB); PG8_STAGE(PG8_SB(0, 1), cB + hstep, voffB); PG8_STAGE(PG8_SA(0, 0), cA, voffA); PG8_STAGE(PG8_SA(0, 1), cA + hstep, voffA);
        if (wr == 1) PG8_BAR;
        PG8_WAIT_V(2); PG8_BAR;
        PG8_STAGE(PG8_SB(1, 0), cB + kstep, voffB); PG8_STAGE(PG8_SA(1, 0), cA + kstep, voffA); PG8_STAGE(PG8_SB(1, 1), cB + hstep + kstep, voffB);
        PG8_WAIT_V(6); PG8_BAR;
    } else {
        PG8_STAGE(PG8_SB(0, 0), cB, voffB); PG8_STAGE(PG8_SA(0, 0), cA, voffA); PG8_STAGE(PG8_SB(0, 1), cB + hstep, voffB); PG8_STAGE(PG8_SA(0, 1), cA + hstep, voffA);
        if (wr == 1) PG8_BAR;
        PG8_WAIT_V(4); PG8_BAR;
        PG8_STAGE(PG8_SB(1, 0), cB + kstep, voffB); PG8_STAGE(PG8_SA(1, 0), cA + kstep, voffA); PG8_STAGE(PG8_SB(1, 1), cB + hstep + kstep, voffB);
        PG8_WAIT_V(6); PG8_BAR;
    }
    for (;;) {
        const bool has_next = S.next(ui + 1, nxt);
        const char* nA = has_next ? (const char*)g.A + (size_t)nxt.pa * tstep : cA; const char* nB = has_next ? (const char*)g.Bt + (size_t)nxt.pn * tstep : cB;
        for (int t = 0; t < nt; t += 2) {
            const bool last = (t == nt - 2);
            const char* a1 = cA + (size_t)(t + 1) * kstep;
            const char* a2 = last ? nA : cA + (size_t)(t + 2) * kstep; const char* b2 = last ? nB : cB + (size_t)(t + 2) * kstep;
            const char* a3 = a2 + kstep; const char* b3 = b2 + kstep;
            if (last && has_next) S.a_ready(nxt);
            if constexpr (SP2) {
            PG8_LDB(B0, 0, 0); PG8_LDB(B1, 0, 1); PG8_SCHED; PG8_LDA(At, 0, 0); PG8_STAGE(PG8_SA(1, 1), a1 + hstep, voffA);
            PG8_WAIT_V(8); PG8_WAIT_L(0); PG8_BAR; PG8_MMA(0, 0, At, B0); PG8_MMA(0, 1, At, B1); PG8_BAR; PG8_SCHED;
            PG8_LDA(At, 0, 1); PG8_STAGE(PG8_SB(0, 0), b2, voffB); PG8_STAGE(PG8_SB(0, 1), b2 + hstep, voffB); PG8_STAGE(PG8_SA(0, 0), a2, voffA);
            PG8_WAIT_V(8); PG8_WAIT_L(0); PG8_BAR; PG8_MMA(1, 0, At, B0); PG8_MMA(1, 1, At, B1); PG8_BAR; PG8_SCHED;
            PG8_LDB(B0, 1, 0); PG8_LDB(B1, 1, 1); PG8_SCHED; PG8_LDA(At, 1, 0); PG8_STAGE(PG8_SA(0, 1), a2 + hstep, voffA);
            PG8_WAIT_V(8); PG8_WAIT_L(0); PG8_BAR; PG8_MMA(0, 0, At, B0); PG8_MMA(0, 1, At, B1); PG8_BAR; PG8_SCHED;
            PG8_LDA(At, 1, 1); PG8_STAGE(PG8_SB(1, 0), b3, voffB); PG8_STAGE(PG8_SB(1, 1), b3 + hstep, voffB); PG8_STAGE(PG8_SA(1, 0), a3, voffA);
            PG8_WAIT_V(8); PG8_WAIT_L(0); PG8_BAR; PG8_MMA(1, 0, At, B0); PG8_MMA(1, 1, At, B1); PG8_BAR; PG8_SCHED;
            } else {
            PG8_LDB(B0, 0, 0); PG8_SCHED; PG8_LDA(At, 0, 0); PG8_STAGE(PG8_SA(1, 1), a1 + hstep, voffA);
            PG8_WAIT_L(8); PG8_BAR; PG8_WAIT_L(0); PG8_MMA(0, 0, At, B0); PG8_BAR; PG8_SCHED;
            PG8_LDB(B1, 0, 1); PG8_STAGE(PG8_SB(0, 0), b2, voffB);
            PG8_BAR; PG8_WAIT_L(0); PG8_MMA(0, 1, At, B1); PG8_BAR;
            PG8_LDA(At, 0, 1); PG8_STAGE(PG8_SA(0, 0), a2, voffA);
            PG8_BAR; PG8_WAIT_L(0); PG8_MMA(1, 0, At, B0); PG8_BAR; PG8_SCHED;
            PG8_STAGE(PG8_SB(0, 1), b2 + hstep, voffB);
            PG8_WAIT_V(6); PG8_BAR; PG8_MMA(1, 1, At, B1); PG8_BAR;
            PG8_LDB(B0, 1, 0); PG8_SCHED; PG8_LDA(At, 1, 0); PG8_STAGE(PG8_SA(0, 1), a2 + hstep, voffA);
            PG8_WAIT_L(8); PG8_BAR; PG8_WAIT_L(0); PG8_MMA(0, 0, At, B0); PG8_BAR; PG8_SCHED;
            PG8_LDB(B1, 1, 1); PG8_STAGE(PG8_SB(1, 0), b3, voffB);
            PG8_BAR; PG8_WAIT_L(0); PG8_MMA(0, 1, At, B1); PG8_BAR;
            PG8_LDA(At, 1, 1); PG8_STAGE(PG8_SA(1, 0), a3, voffA);
            PG8_BAR; PG8_WAIT_L(0); PG8_MMA(1, 0, At, B0); PG8_BAR; PG8_SCHED;
            PG8_STAGE(PG8_SB(1, 1), b3 + hstep, voffB);
            PG8_WAIT_V(6); PG8_BAR; PG8_MMA(1, 1, At, B1); PG8_BAR;
            }
        }
        if constexpr (ALIGN_EPI) { if (wr == 0) PG8_BAR; }
        if constexpr (!Epi::AFTER_DRAIN) { E(acc, cur, wr, wc, fr, fq); S.done(cur); }
        if (!has_next) break;
#pragma unroll
        for (int a = 0; a < 2; ++a)
#pragma unroll
            for (int b = 0; b < 2; ++b)
#pragma unroll
                for (int m = 0; m < 4; ++m)
#pragma unroll
                    for (int n = 0; n < 2; ++n) acc[a][b][m][n] = (f32x4){0.f, 0.f, 0.f, 0.f};
        cur = nxt; cA = nA; cB = nB; ++ui;
        if constexpr (ALIGN_EPI) { if (wr == 1) PG8_BAR; }
    }
    PG8_WAIT_V(0);
    if constexpr (!ALIGN_EPI) { if (wr == 0) PG8_BAR; }
    PG8_BAR;
    if constexpr (Epi::AFTER_DRAIN) { E.fused(acc, cur, wr, wc, fr, fq, lds, wid, lane); S.done(cur); }
#undef PG8_SA
#undef PG8_SB
#undef PG8_STAGE
#undef PG8_LDA
#undef PG8_LDB
#undef PG8_MMA
#undef PG8_WAIT_V
#undef PG8_WAIT_L
#undef PG8_BAR
#undef PG8_SCHED
}
}
namespace pg8 {
struct EpiProj {
    static constexpr bool PERM = true, AFTER_DRAIN = false;
    bf16_t* PA; bf16_t* PB;
    __device__ __forceinline__ void operator()(const f32x4 (&acc)[2][2][4][2], const Unit& u, int wr, int wc, int fr, int fq) const {
        const int row0 = u.pm * BM + wr * 64 + fr;
        bf16_t* base; int ldc, colt;
        if (u.po < 7) { base = PA; ldc = 1792; colt = u.po * BM; } else { base = PB; ldc = 1536; colt = (u.po - 7) * BM; }
        const int col0 = colt + wc * 32 + 8 * fq;
#pragma unroll
        for (int ai = 0; ai < 2; ++ai)
#pragma unroll
            for (int m = 0; m < 4; ++m) { bf16_t* rowp = base + (size_t)(row0 + ai * HALF + m * 16) * ldc + col0;
#pragma unroll
                for (int bj = 0; bj < 2; ++bj) { const f32x4 v0 = acc[ai][bj][m][0], v1 = acc[ai][bj][m][1];
                    u32x4 w; w.x = cvt_pk_bf16(v0[0], v0[1]); w.y = cvt_pk_bf16(v0[2], v0[3]); w.z = cvt_pk_bf16(v1[0], v1[1]); w.w = cvt_pk_bf16(v1[2], v1[3]);
                    *(u32x4*)(rowp + bj * HALF) = w; } }
    }
};
struct EpiBf16Plain {
    static constexpr bool PERM = true, AFTER_DRAIN = false;
    bf16_t* O; int ldc;
    __device__ __forceinline__ void operator()(const f32x4 (&acc)[2][2][4][2], const Unit& u, int wr, int wc, int fr, int fq) const {
        const int row0 = u.pm * BM + wr * 64 + fr;
        const int col0 = u.po * BM + wc * 32 + 8 * fq;
#pragma unroll
        for (int ai = 0; ai < 2; ++ai)
#pragma unroll
            for (int m = 0; m < 4; ++m) { bf16_t* rowp = O + (size_t)(row0 + ai * HALF + m * 16) * ldc + col0;
#pragma unroll
                for (int bj = 0; bj < 2; ++bj) { const f32x4 v0 = acc[ai][bj][m][0], v1 = acc[ai][bj][m][1];
                    u32x4 w; w.x = cvt_pk_bf16(v0[0], v0[1]); w.y = cvt_pk_bf16(v0[2], v0[3]); w.z = cvt_pk_bf16(v1[0], v1[1]); w.w = cvt_pk_bf16(v1[2], v1[3]);
                    *(u32x4*)(rowp + bj * HALF) = w; } }
    }
};
struct EpiSwiglu {
    static constexpr bool PERM = true, AFTER_DRAIN = false;
    bf16_t* H; int ldc; long rowoff;
    __device__ __forceinline__ void operator()(const f32x4 (&acc)[2][2][4][2], const Unit& u, int wr, int wc, int fr, int fq) const {
        const long row0 = (long)u.pm * BM + wr * 64 + fr + rowoff;
        const int col0 = u.po * HALF + wc * 32 + 8 * fq;
#pragma unroll
        for (int ai = 0; ai < 2; ++ai)
#pragma unroll
            for (int m = 0; m < 4; ++m) { bf16_t* rowp = H + (size_t)(row0 + ai * HALF + m * 16) * ldc + col0;
                float o[8];
#pragma unroll
                for (int n = 0; n < 2; ++n)
#pragma unroll
                    for (int j = 0; j < 4; ++j) { const float g = acc[ai][0][m][n][j], up = acc[ai][1][m][n][j];
                        const float s = g * __builtin_amdgcn_rcpf(1.0f + __builtin_amdgcn_exp2f(-1.4426950408889634f * g)); o[n * 4 + j] = s * up; }
                u32x4 w; w.x = cvt_pk_bf16(o[0], o[1]); w.y = cvt_pk_bf16(o[2], o[3]); w.z = cvt_pk_bf16(o[4], o[5]); w.w = cvt_pk_bf16(o[6], o[7]);
                *(u32x4*)rowp = w; }
    }
};
struct EpiMoeDown {
    static constexpr bool PERM = true, AFTER_DRAIN = false;
    bf16_t* O; int ldc; const float* gs;
    __device__ __forceinline__ void operator()(const f32x4 (&acc)[2][2][4][2], const Unit& u, int wr, int wc, int fr, int fq) const {
        const int row0 = u.pm * BM + wr * 64 + fr;
        const int col0 = u.po * BM + wc * 32 + 8 * fq;
#pragma unroll
        for (int ai = 0; ai < 2; ++ai)
#pragma unroll
            for (int m = 0; m < 4; ++m) { const int row = row0 + ai * HALF + m * 16; const float gt = gs[row]; bf16_t* rowp = O + (size_t)row * ldc + col0;
#pragma unroll
                for (int bj = 0; bj < 2; ++bj) { const f32x4 v0 = acc[ai][bj][m][0] * gt, v1 = acc[ai][bj][m][1] * gt;
                    u32x4 w; w.x = cvt_pk_bf16(v0[0], v0[1]); w.y = cvt_pk_bf16(v0[2], v0[3]); w.z = cvt_pk_bf16(v1[0], v1[1]); w.w = cvt_pk_bf16(v1[2], v1[3]);
                    *(u32x4*)(rowp + bj * HALF) = w; } }
    }
};
struct MoeOrder {
    int t0, nT, nN, nwg, G, c, nNe, arel;
    int ts1, ts2, ts3, ts4, ts5, ts6, ts7;
    __device__ bool next(int i, Unit& u) const {
        const long L = (long)i * G + c; if (L >= nwg) return false;
        int wgid = (int)L; { const int q = nwg / NXCD, r = nwg % NXCD, xcd = wgid % NXCD, off = wgid / NXCD; wgid = (xcd < r ? xcd * (q + 1) : r * (q + 1) + (xcd - r) * q) + off; }
        const int nig = WGM * nN, gid = wgid / nig, fm = gid * WGM, gsz = (nT - fm) < WGM ? (nT - fm) : WGM;
        const int pml = fm + ((wgid % nig) % gsz), pnl = (wgid % nig) / gsz;
        u.pm = t0 + pml; u.pa = arel ? pml : u.pm; u.po = pnl;
        const int e = (u.pm >= ts1) + (u.pm >= ts2) + (u.pm >= ts3) + (u.pm >= ts4) + (u.pm >= ts5) + (u.pm >= ts6) + (u.pm >= ts7);
        u.pn = e * nNe + pnl; return true;
    }
    __device__ __forceinline__ void a_ready(const Unit&) const {}
    __device__ __forceinline__ void done(const Unit&) const {}
};
}
constexpr int NWAVES = 8;
constexpr int NBATCH = 4, SEQ = 8192, M = NBATCH * SEQ, D = 1024, NH = 8, HD = 64;
constexpr int NA = 1792, NPB = 1536, NPROJ = NA + NPB, FF = 3584, NE = 8;
constexpr int MOE_PART_TILES = 64, MOE_PARTS = 5;
constexpr float NORM_EPS = 1e-6f, LNX_EPS = 64e-5f, DECAY_SCALE = 0.6065306597126334f;
constexpr float SB_EXIT = -104.0f;

constexpr size_t MiB = 1u << 20;
constexpr size_t WS_CTL = 0, CTL_ZERO_BYTES = 1 * MiB;
constexpr size_t WS_WIN0 = 1 * MiB, WS_WIN1 = 8 * MiB, WS_WOUT0 = 15 * MiB, WS_WOUT1 = 17 * MiB, WS_WGU0 = 19 * MiB, WS_WDN0 = 33 * MiB;
constexpr size_t WS_SEL = 40 * MiB, WS_GTS = WS_SEL + 128 * 1024, WS_POS = WS_GTS + 256 * 1024, WS_GSORT = WS_POS + 256 * 1024;
constexpr size_t WS_HN = 41 * MiB, WS_YMIX = 105 * MiB, WS_VF = 169 * MiB, WS_PA = 201 * MiB, WS_PB = 313 * MiB, WS_Y = 409 * MiB;
constexpr size_t WS_H0 = 201 * MiB;
constexpr size_t WS_F = WS_YMIX;
constexpr size_t WS_WMGU = 105 * MiB, WS_WMDN = 217 * MiB, WS_HS = 273 * MiB, WS_HP = 405 * MiB, WS_END = 517 * MiB;
static_assert(WS_WIN0 + (size_t)NPROJ * D * 2 <= WS_WIN1 && WS_WIN1 + (size_t)NPROJ * D * 2 <= WS_WOUT0 && WS_WGU0 + (size_t)2 * FF * D * 2 <= WS_WDN0 && WS_WDN0 + (size_t)D * FF * 2 <= WS_SEL, "weights map");
static_assert(WS_GSORT + (size_t)(2 * M + 2048) * 4 <= WS_HN, "routing tables");
static_assert(WS_PA + (size_t)M * NA * 2 <= WS_PB && WS_PB + (size_t)M * NPB * 2 <= WS_Y && WS_H0 + (size_t)M * FF * 2 <= WS_END, "act map");
static_assert(WS_WMGU + (size_t)NE * 2 * FF * D * 2 <= WS_WMDN && WS_WMDN + (size_t)NE * D * FF * 2 <= WS_HS && WS_HS + (size_t)(2 * M + 2048) * D * 2 <= WS_HP && WS_HP + (size_t)MOE_PART_TILES * 256 * FF * 2 <= WS_END, "moe map");
constexpr int CW_BAR = 4096, CW_TOT = 16384, CW_CUR = 16384 + 1024;

constexpr int RING_BYTES = 131072, MISC_OFF = RING_BYTES + 320, LDS_BYTES = 147456;

#define GAS __attribute__((address_space(1)))
#define LAS __attribute__((address_space(3)))
typedef unsigned short bf16;
typedef unsigned v4u __attribute__((ext_vector_type(4)));
typedef unsigned v2u __attribute__((ext_vector_type(2)));
typedef float f32x4 __attribute__((ext_vector_type(4)));
typedef float f32x16 __attribute__((ext_vector_type(16)));
typedef short bf16x8 __attribute__((ext_vector_type(8)));
typedef short s16x4 __attribute__((ext_vector_type(4)));
typedef float f32x2_t __attribute__((ext_vector_type(2)));
typedef __bf16 bf16x2_t __attribute__((ext_vector_type(2)));
#define RLX_AGENT __ATOMIC_RELAXED, __HIP_MEMORY_SCOPE_AGENT
#define LDS_WAIT() asm volatile("s_waitcnt lgkmcnt(0)" ::: "memory")
#define DI __device__ __forceinline__
#define MFMA32(a, b, c) __builtin_amdgcn_mfma_f32_32x32x16_bf16((a), (b), (c), 0, 0, 0)

DI unsigned cvtpk(float lo, float hi) { f32x2_t v = {lo, hi}; bf16x2_t b = __builtin_convertvector(v, bf16x2_t); return __builtin_bit_cast(unsigned, b); }
DI unsigned short f2bf(float f) { return (unsigned short)(cvtpk(f, 0.f) & 0xffffu); }
DI float bf2f(unsigned short u) { return __uint_as_float((unsigned)u << 16); }
DI float bflo(unsigned u) { return __uint_as_float(u << 16); }
DI float bfhi(unsigned u) { return __uint_as_float(u & 0xffff0000u); }
DI float wave_sum(float v) {
#pragma unroll
    for (int o = 1; o < 64; o <<= 1) v += __shfl_xor(v, o);
    return v;
}
DI float sigmoidf_(float x) { return __builtin_amdgcn_rcpf(1.0f + __expf(-x)); }
DI int crow(int r, int hi) { return (r & 3) + 8 * (r >> 2) + 4 * hi; }

#define XB_TMO      128
#define XB_XCNT(j)  (256  + 64 * (j))
#define XB_XSUB(j)  (1280 + 64 * (j))
#define XB_XGEN(j)  (2304 + 64 * (j))
#define XB_TOP      3328
#define XB_TOPGEN   3392
#define XCD_BAR_WORDS 3456
#define XB_SPIN_CAP (1u << 22)
DI unsigned xb_ld(unsigned* p)              { return __hip_atomic_load(p, __ATOMIC_RELAXED, __HIP_MEMORY_SCOPE_AGENT); }
DI unsigned xb_add(unsigned* p, unsigned v) { return __hip_atomic_fetch_add(p, v, __ATOMIC_RELAXED, __HIP_MEMORY_SCOPE_AGENT); }
DI unsigned xb_xcc_id() { return (unsigned)__builtin_amdgcn_s_getreg((3 << 11) | 20) & 0xFu; }
#define XB_SPIN(cond, bar) do { unsigned _sp = 0; while (cond) { __builtin_amdgcn_s_sleep(1); \
    if ((++_sp & 255u) == 0u) { if (xb_ld(&(bar)[XB_TMO])) break; if (_sp > XB_SPIN_CAP) { atomicAdd(&(bar)[XB_TMO], 1u); break; } } } } while (0)
struct XcdBarrier { unsigned* bar; unsigned x; volatile LAS unsigned* st; };
DI XcdBarrier xcd_barrier_post(unsigned* bar, volatile LAS unsigned* st) {
    XcdBarrier b; b.bar = bar; b.x = xb_xcc_id(); b.st = st;
    if (threadIdx.x == 0) (void)xb_add(&bar[XB_XCNT(b.x)], 1u);
    return b;
}
DI void xcd_barrier_complete(unsigned* bar, unsigned x, unsigned& nloc, unsigned& nx) {
    const unsigned G = gridDim.x * gridDim.y * gridDim.z;
    unsigned sum, cnt, mine, sp = 0u;
    for (;;) {
        sum = 0u; cnt = 0u; mine = 0u;
#pragma unroll
        for (unsigned j = 0; j < 16; ++j) { const unsigned c = xb_ld(&bar[XB_XCNT(j)]); sum += c; cnt += (c > 0u) ? 1u : 0u; mine = (j == x) ? c : mine; }
        if (sum == G) break;
        __builtin_amdgcn_s_sleep(1);
        if ((++sp & 255u) == 0u) { if (xb_ld(&bar[XB_TMO])) break; if (sp > XB_SPIN_CAP) { atomicAdd(&bar[XB_TMO], 1u); break; } }
    }
    nloc = mine > 0u ? mine : 1u; nx = cnt > 0u ? cnt : 1u;
}
DI void xcd_barrier(const XcdBarrier& b) {
    asm volatile("s_waitcnt vmcnt(0)" ::: "memory");
    __syncthreads();
    if (threadIdx.x == 0) {
        unsigned* bar = b.bar; unsigned bx = b.x;
        asm volatile("" : "+s"(bar), "+s"(bx));
        __builtin_amdgcn_s_waitcnt(0);
        unsigned nloc = b.st[0], nx = b.st[1];
        if (nloc == 0u) { xcd_barrier_complete(bar, bx, nloc, nx); b.st[0] = nloc; b.st[1] = nx; }
        const unsigned old = xb_add(&bar[XB_XSUB(bx)], 1u);
        const unsigned gen = old / nloc;
        if (old + 1u == (gen + 1u) * nloc) {
            __builtin_amdgcn_fence(__ATOMIC_RELEASE, "agent");
            asm volatile("s_waitcnt vmcnt(0)" ::: "memory");
            const unsigned og = xb_add(&bar[XB_TOP], 1u);
            const unsigned tg = og / nx;
            if (og + 1u == (tg + 1u) * nx) xb_add(&bar[XB_TOPGEN], 1u);
            else XB_SPIN(xb_ld(&bar[XB_TOPGEN]) == tg, bar);
            __builtin_amdgcn_fence(__ATOMIC_ACQUIRE, "agent");
            xb_add(&bar[XB_XGEN(bx)], 1u);
            asm volatile("s_waitcnt vmcnt(0)" ::: "memory");
        } else {
            XB_SPIN(xb_ld(&bar[XB_XGEN(bx)]) == gen, bar);
            __builtin_amdgcn_fence(__ATOMIC_ACQUIRE, "agent");
            asm volatile("s_waitcnt vmcnt(0)" ::: "memory");
        }
    }
    __syncthreads();
}

DI void transpose_item(const float* W, int N, int k0, int n0, bf16* WT, int Kt, int drow0, LAS float* scr, int lane) {
#pragma unroll 8
    for (int i = 0; i < 32; ++i) { const int kk = 2 * i + (lane >> 5); scr[kk * 33 + (lane & 31)] = W[(size_t)(k0 + kk) * N + n0 + (lane & 31)]; }
    LDS_WAIT(); asm volatile("" ::: "memory");
    const int c = lane & 7;
#pragma unroll
    for (int j = 0; j < 4; ++j) { const int n = (lane >> 3) + 8 * j; const LAS float* s = scr + (8 * c) * 33 + n;
        v4u o; o.x = cvtpk(s[0 * 33], s[1 * 33]); o.y = cvtpk(s[2 * 33], s[3 * 33]); o.z = cvtpk(s[4 * 33], s[5 * 33]); o.w = cvtpk(s[6 * 33], s[7 * 33]);
        *(GAS v4u*)(WT + (size_t)(drow0 + n) * Kt + k0 + 8 * c) = o; }
    LDS_WAIT(); asm volatile("" ::: "memory");
}
template <int MODE>
DI void conv_matrix(const float* W, int K, int N, bf16* WT, int nrw, LAS float* scr, int gw, int NGW, int lane) {
    const int nblk = N / 32, nitems = (K / 64) * nblk;
    for (int it = gw; it < nitems; it += NGW) {
        const int kb = it / nblk, nb = it % nblk, n0 = nb * 32;
        int drow0;
        if (MODE == 0) drow0 = n0;
        else if (MODE == 1) drow0 = n0 < nrw ? n0 : NA + (n0 - nrw);
        else if (MODE == 2) drow0 = (n0 >> 7) * 256 + (n0 & 127);
        else drow0 = (n0 >> 7) * 256 + 128 + (n0 & 127);
        transpose_item(W, N, kb * 64, n0, WT, K, drow0, scr, lane);
    }
}
DI void zero_rows(bf16* WT, int Kt, int r0, int r1, int gw, int NGW, int lane) {
    const int per = Kt / 8;
    const long total = (long)(r1 - r0) * per;
    for (long i = (long)gw * 64 + lane; i < total; i += (long)NGW * 64) *(GAS v4u*)(WT + (size_t)r0 * Kt + i * 8) = (v4u){0u, 0u, 0u, 0u};
}

DI float dot4(f32x4 a) { return (a.x * a.x + a.y * a.y) + (a.z * a.z + a.w * a.w); }
DI f32x4 ld_bf16x4(const bf16* p) { const v2u u = *(const GAS v2u*)p; return (f32x4){bflo(u.x), bfhi(u.x), bflo(u.y), bfhi(u.y)}; }
DI void st_bf16x4(bf16* p, f32x4 v) { v2u u; u.x = cvtpk(v.x, v.y); u.y = cvtpk(v.z, v.w); *(GAS v2u*)p = u; }

DI void phase_norm0(const float* x, const float* g, bf16* hn, int gw, int NGW, int lane) {
    f32x4 gv[4];
#pragma unroll
    for (int j = 0; j < 4; ++j) gv[j] = *(const f32x4*)(g + 4 * lane + 256 * j);
    for (int m = gw; m < M; m += NGW) {
        f32x4 v[4]; float s = 0.f;
#pragma unroll
        for (int j = 0; j < 4; ++j) { v[j] = *(const GAS f32x4*)(x + (size_t)m * D + 4 * lane + 256 * j); s += dot4(v[j]); }
        const float rs = rsqrtf(wave_sum(s) * (1.f / D) + NORM_EPS);
#pragma unroll
        for (int j = 0; j < 4; ++j) st_bf16x4(hn + (size_t)m * D + 4 * lane + 256 * j, v[j] * rs * gv[j]);
    }
}
template <bool MOEF>
DI void phase_resnorm(const float* xin, const bf16* y, const unsigned* pos, const float* g1, const float* g2, float* xout, bf16* hn,
                      const float* rt, unsigned* sel, float* gts, unsigned* totals, int gw, int NGW, int lane) {
    f32x4 g1v[4], g2v[4];
#pragma unroll
    for (int j = 0; j < 4; ++j) { g1v[j] = *(const f32x4*)(g1 + 4 * lane + 256 * j); g2v[j] = g2 ? *(const f32x4*)(g2 + 4 * lane + 256 * j) : (f32x4){0.f, 0.f, 0.f, 0.f}; }
    unsigned mycnt = 0;
    for (int m = gw; m < M; m += NGW) {
        f32x4 v[4], yv[4]; float s = 0.f;
        if (MOEF) {
            const unsigned p0 = __hip_atomic_load(pos + 2 * m, RLX_AGENT), p1 = __hip_atomic_load(pos + 2 * m + 1, RLX_AGENT);
#pragma unroll
            for (int j = 0; j < 4; ++j) yv[j] = ld_bf16x4(y + (size_t)p0 * D + 4 * lane + 256 * j) + ld_bf16x4(y + (size_t)p1 * D + 4 * lane + 256 * j);
        } else {
#pragma unroll
            for (int j = 0; j < 4; ++j) yv[j] = ld_bf16x4(y + (size_t)m * D + 4 * lane + 256 * j);
        }
#pragma unroll
        for (int j = 0; j < 4; ++j) { v[j] = *(const GAS f32x4*)(xin + (size_t)m * D + 4 * lane + 256 * j); s += dot4(yv[j]); }
        const float rsy = rsqrtf(wave_sum(s) * (1.f / D) + NORM_EPS);
        float s2 = 0.f;
#pragma unroll
        for (int j = 0; j < 4; ++j) { v[j] = v[j] + yv[j] * rsy * g1v[j]; s2 += dot4(v[j]); *(GAS f32x4*)(xout + (size_t)m * D + 4 * lane + 256 * j) = v[j]; }
        if (g2) {
            const float rsx = rsqrtf(wave_sum(s2) * (1.f / D) + NORM_EPS);
#pragma unroll
            for (int j = 0; j < 4; ++j) { v[j] = v[j] * rsx * g2v[j]; st_bf16x4(hn + (size_t)m * D + 4 * lane + 256 * j, v[j]); }
            if (rt) {
                float pe[8];
#pragma unroll
                for (int e = 0; e < 8; ++e) pe[e] = 0.f;
#pragma unroll
                for (int j = 0; j < 4; ++j)
#pragma unroll
                    for (int i = 0; i < 4; ++i) { const float hv = v[j][i]; const float* rp = rt + (size_t)(4 * lane + 256 * j + i) * 8;
                        const f32x4 ra = *(const f32x4*)rp, rb = *(const f32x4*)(rp + 4);
                        pe[0] += hv * ra.x; pe[1] += hv * ra.y; pe[2] += hv * ra.z; pe[3] += hv * ra.w; pe[4] += hv * rb.x; pe[5] += hv * rb.y; pe[6] += hv * rb.z; pe[7] += hv * rb.w; }
                float v0 = -3.0e38f, v1 = -3.0e38f; int e0 = 0, e1 = 0;
#pragma unroll
                for (int e = 0; e < 8; ++e) { const float lg = wave_sum(pe[e]); if (lg > v0) { v1 = v0; e1 = e0; v0 = lg; e0 = e; } else if (lg > v1) { v1 = lg; e1 = e; } }
                const float ga = 1.0f / (1.0f + __expf(v1 - v0)), gb = 1.0f - ga;
                if (lane == 0) { sel[m] = (unsigned)e0 | ((unsigned)e1 << 8); gts[2 * m] = ga; gts[2 * m + 1] = gb; }
                if (lane == e0 || lane == e1) ++mycnt;
            }
        }
    }
    if (rt && lane < 8 && mycnt) __hip_atomic_fetch_add(totals + 64 * lane, mycnt, RLX_AGENT);
}

DI int moe_offsets(unsigned* totals, int lane, int& mytot) {
    int off = 0; mytot = 0;
#pragma unroll
    for (int e = 0; e < 8; ++e) { const int t = (int)__hip_atomic_load(totals + 64 * e, RLX_AGENT); if (e < lane) off += (t + 255) & ~255; if (e == lane) mytot = t; }
    return off;
}

DI void phase_moe_sort(const unsigned* sel, const float* gts, unsigned* totals, unsigned* cursor, unsigned* pos, float* gsort, const bf16* hn, bf16* hs, int gw, int NGW, int lane) {
    int mytot; const int myoff = moe_offsets(totals, lane, mytot);
    unsigned mycnt = 0;
    for (int m = gw; m < M; m += NGW) { const unsigned s = __hip_atomic_load(sel + m, RLX_AGENT); const int e0 = s & 255, e1 = (s >> 8) & 255; if (lane == e0 || lane == e1) ++mycnt; }
    unsigned mybase = 0;
    if (lane < 8 && mycnt) mybase = __hip_atomic_fetch_add(cursor + 64 * lane, mycnt, RLX_AGENT);
    unsigned mypos = (unsigned)myoff + mybase;
    for (int m = gw; m < M; m += NGW) {
        const unsigned s = __hip_atomic_load(sel + m, RLX_AGENT); const int e0 = s & 255, e1 = (s >> 8) & 255;
        const unsigned p0 = __shfl(mypos, e0), p1 = __shfl(mypos, e1);
        if (lane == e0 || lane == e1) ++mypos;
        if (lane == 0) { pos[2 * m] = p0; pos[2 * m + 1] = p1; gsort[p0] = __hip_atomic_load(gts + 2 * m, RLX_AGENT); gsort[p1] = __hip_atomic_load(gts + 2 * m + 1, RLX_AGENT); }
        const v4u a = *(const GAS v4u*)(hn + (size_t)m * D + 8 * lane), b = *(const GAS v4u*)(hn + (size_t)m * D + 512 + 8 * lane);
        *(GAS v4u*)(hs + (size_t)p0 * D + 8 * lane) = a; *(GAS v4u*)(hs + (size_t)p0 * D + 512 + 8 * lane) = b;
        *(GAS v4u*)(hs + (size_t)p1 * D + 8 * lane) = a; *(GAS v4u*)(hs + (size_t)p1 * D + 512 + 8 * lane) = b;
    }
#pragma unroll 1
    for (int e = 0; e < 8; ++e) {
        const int r0 = __shfl(myoff + mytot, e), r1 = __shfl(myoff + ((mytot + 255) & ~255), e);
        for (int r = r0 + gw; r < r1; r += NGW) { *(GAS v4u*)(hs + (size_t)r * D + 8 * lane) = (v4u){0u, 0u, 0u, 0u}; *(GAS v4u*)(hs + (size_t)r * D + 512 + 8 * lane) = (v4u){0u, 0u, 0u, 0u}; if (lane == 0) gsort[r] = 0.f; }
    }
}
struct RwkvP {
    const bf16* PA;
    const float *mu, *decay0, *decay_up, *iclr0, *iclr_up, *gate_up, *vres0, *vres_up, *k_k, *k_a, *r_k, *lnx_g, *lnx_b;
    bf16* vfirst;
    bf16* ymix;
    int has_vres;
};
DI void rwkv_seq_unit(const RwkvP& P, int b, int h, LAS unsigned char* lds, int tid) {
    const int lane = tid & 63, wave = __builtin_amdgcn_readfirstlane(tid >> 6);
    LAS float* SM = (LAS float*)lds;
    LAS float* Rl = (LAS float*)lds;            LAS float* Wl = Rl + 4096; LAS float* Kl = Rl + 8192; LAS float* Vl = Rl + 12288; LAS float* Zl = Rl + 16384; LAS float* Bl = Rl + 20480;
    LAS float* Yl = Rl + 24576;
    const int hc = h * 64 + lane;
    const float mu_r = P.mu[hc], mu_k = P.mu[512 + hc], mu_v = P.mu[1024 + hc];
    const float d0 = P.decay0[hc], i0 = P.iclr0[hc], vr0 = P.has_vres ? P.vres0[hc] : 0.f;
    const float kk_c = P.k_k[hc], ka_c = P.k_a[hc], rk_c = P.r_k[hc], lg_c = P.lnx_g[hc], lb_c = P.lnx_b[hc];
    LAS float* STl = Rl + 28672;
    for (int i = tid; i < 4096; i += NWAVES * 64) STl[i] = 0.f;
    const size_t rowb = (size_t)b * SEQ;
#pragma unroll 1
    for (int ch = 0; ch < SEQ / 64; ++ch) {
        const int t0 = ch * 64;
        for (int idx = tid; idx < 64 * 192; idx += NWAVES * 64) {
            const int t = idx / 192, c = idx % 192;
            float val = 0.f;
            if (c < 160 || P.has_vres) {
                const size_t row = rowb + t0 + t;
                const float cur = bf2f(P.PA[row * NA + 1536 + c]);
                const float prev = (t0 + t == 0) ? 0.f : bf2f(P.PA[(row - 1) * NA + 1536 + c]);
                const float xs = cur + P.mu[1536 + c] * (prev - cur);
                val = c < 32 ? tanhf(xs) : (c < 64 ? xs : (c < 160 ? sigmoidf_(xs) : xs));
            }
            SM[idx] = val;
        }
        __syncthreads();
        float dpre[8], ipre[8], gat[8], vpre[8];
#pragma unroll
        for (int i = 0; i < 8; ++i) { dpre[i] = d0; ipre[i] = i0; gat[i] = 0.f; vpre[i] = vr0; }
#pragma unroll 4
        for (int j = 0; j < 32; ++j) {
            const float wd = P.decay_up[j * 512 + hc], wi = P.iclr_up[j * 512 + hc], wv = P.has_vres ? P.vres_up[j * 512 + hc] : 0.f;
#pragma unroll
            for (int i = 0; i < 8; ++i) { const LAS float* sm = SM + (wave + 8 * i) * 192; dpre[i] += sm[j] * wd; ipre[i] += sm[32 + j] * wi; vpre[i] += sm[160 + j] * wv; }
        }
#pragma unroll 4
        for (int j = 0; j < 96; ++j) {
            const float wg = P.gate_up[j * 512 + hc];
#pragma unroll
            for (int i = 0; i < 8; ++i) gat[i] += SM[(wave + 8 * i) * 192 + 64 + j] * wg;
        }
        __syncthreads();
        float vv[8], bon[8];
#pragma unroll
        for (int i = 0; i < 8; ++i) {
            const int t = wave + 8 * i; const size_t row = rowb + t0 + t; const bool first = (t0 + t == 0);
            const bf16* pr = P.PA + row * NA; const bf16* pp = pr - NA;
            float r = bf2f(pr[hc]), k0 = bf2f(pr[512 + hc]), v = bf2f(pr[1024 + hc]);
            const float rp = first ? 0.f : bf2f(pp[hc]), kp = first ? 0.f : bf2f(pp[512 + hc]), vp = first ? 0.f : bf2f(pp[1024 + hc]);
            r = r + mu_r * (rp - r); k0 = k0 + mu_k * (kp - k0); v = v + mu_v * (vp - v);
            const float w = __expf(-DECAY_SCALE * sigmoidf_(dpre[i]));
            const float a = sigmoidf_(ipre[i]);
            if (P.has_vres) { const float vf = bf2f(P.vfirst[row * 512 + hc]); v = v + (vf - v) * sigmoidf_(vpre[i]); }
            else P.vfirst[row * 512 + hc] = f2bf(v);
            float kk = k0 * kk_c;
            const float nn = wave_sum(kk * kk);
            kk = kk * rsqrtf(fmaxf(nn, 1e-12f));
            const float k = k0 * (1.0f + (a - 1.0f) * ka_c);
            bon[i] = wave_sum(r * k * rk_c);
            vv[i] = v;
            Rl[t * 64 + lane] = r; Wl[t * 64 + lane] = w; Kl[t * 64 + lane] = k; Vl[t * 64 + lane] = v; Zl[t * 64 + lane] = -kk; Bl[t * 64 + lane] = kk * a;
        }
        __syncthreads();
        if (wave == 0) {
            float st[64];
#pragma unroll
            for (int j = 0; j < 64; ++j) st[j] = STl[j * 64 + lane];
#pragma unroll 1
            for (int t = 0; t < 64; ++t) {
                float sz = 0.f;
#pragma unroll
                for (int j = 0; j < 64; j += 4) { const f32x4 z = *(const LAS f32x4*)(Zl + t * 64 + j); sz += st[j] * z.x + st[j + 1] * z.y + st[j + 2] * z.z + st[j + 3] * z.w; if ((j & 12) == 12) asm volatile("" ::: "memory"); }
                const float vi = Vl[t * 64 + lane];
                float y = 0.f;
#pragma unroll
                for (int j = 0; j < 64; j += 4) {
                    const f32x4 w = *(const LAS f32x4*)(Wl + t * 64 + j), bb = *(const LAS f32x4*)(Bl + t * 64 + j), kq = *(const LAS f32x4*)(Kl + t * 64 + j), rr = *(const LAS f32x4*)(Rl + t * 64 + j);
                    st[j]     = st[j]     * w.x + (sz * bb.x + vi * kq.x);
                    st[j + 1] = st[j + 1] * w.y + (sz * bb.y + vi * kq.y);
                    st[j + 2] = st[j + 2] * w.z + (sz * bb.z + vi * kq.z);
                    st[j + 3] = st[j + 3] * w.w + (sz * bb.w + vi * kq.w);
                    y += st[j] * rr.x + st[j + 1] * rr.y + st[j + 2] * rr.z + st[j + 3] * rr.w;
                    if ((j & 4) == 4) asm volatile("" ::: "memory");
                }
                Yl[t * 64 + lane] = y;
            }
#pragma unroll
            for (int j = 0; j < 64; ++j) STl[j * 64 + lane] = st[j];
        }
        __syncthreads();
#pragma unroll
        for (int i = 0; i < 8; ++i) {
            const int t = wave + 8 * i; const size_t row = rowb + t0 + t;
            const float y = Yl[t * 64 + lane];
            const float mean = wave_sum(y) * (1.f / 64.f);
            const float dv = y - mean;
            const float var = wave_sum(dv * dv) * (1.f / 64.f);
            const float yn = dv * rsqrtf(var + LNX_EPS) * lg_c + lb_c;
            P.ymix[row * D + hc] = f2bf((yn + bon[i] * vv[i]) * gat[i]);
        }
        __syncthreads();
    }
}

constexpr int SB_VP = 40;
DI void sb_wave(const bf16* PB, bf16* ymix, const float* sb_g, int b, int h, int q0, LAS unsigned char* vtb, int lane) {
    const int qi = lane & 31, hh = lane >> 5;
    LAS bf16* vt = (LAS bf16*)vtb;
    const size_t rowb = (size_t)b * SEQ;
    bf16x8 qf[4];
#pragma unroll
    for (int s = 0; s < 4; ++s) qf[s] = *(const GAS bf16x8*)(PB + (rowb + q0 + qi) * NPB + h * 64 + 16 * s + 8 * hh);
    f32x16 o0, o1;
#pragma unroll
    for (int r = 0; r < 16; ++r) { o0[r] = 0.f; o1[r] = 0.f; }
    float carry = 0.f;
    const int q = q0 + qi;
#pragma unroll 1
    for (int kt = q0 / 32; kt >= 0; --kt) {
        const int kb = kt * 32;
        bf16x8 kf[4], vv[4];
#pragma unroll
        for (int s = 0; s < 4; ++s) kf[s] = *(const GAS bf16x8*)(PB + (rowb + kb + qi) * NPB + 512 + h * 64 + 16 * s + 8 * hh);
#pragma unroll
        for (int i = 0; i < 4; ++i) vv[i] = *(const GAS bf16x8*)(PB + (rowb + kb + qi) * NPB + 1024 + h * 64 + 32 * hh + 8 * i);
#pragma unroll
        for (int i = 0; i < 4; ++i)
#pragma unroll
            for (int e = 0; e < 8; ++e) vt[(32 * hh + 8 * i + e) * SB_VP + qi] = (bf16)vv[i][e];
        f32x16 sc;
#pragma unroll
        for (int r = 0; r < 16; ++r) sc[r] = 0.f;
#pragma unroll
        for (int s = 0; s < 4; ++s) sc = MFMA32(kf[s], qf[s], sc);
        float c[16], ls[16];
        const bool diag = (kb == q0);
#pragma unroll
        for (int r = 0; r < 16; ++r) {
            const float z = sc[r] * 0.125f;
            const float sp = fmaxf(z, 0.f) + __logf(1.0f + __expf(-fabsf(z)));
            const bool valid = !diag || (kb + crow(r, hh) < q);
            c[r] = valid ? -sp : 0.f;
            ls[r] = valid ? z - sp : -1.0e30f;
        }
        float G[4], PG[4];
#pragma unroll
        for (int g = 0; g < 4; ++g) { G[g] = (c[4 * g] + c[4 * g + 1]) + (c[4 * g + 2] + c[4 * g + 3]); PG[g] = __shfl_xor(G[g], 32); }
        float att[16];
        float after = carry;
#pragma unroll
        for (int g = 3; g >= 0; --g) {
            float sfx = after + (hh == 0 ? PG[g] : 0.f);
#pragma unroll
            for (int i = 3; i >= 0; --i) { att[4 * g + i] = __expf(ls[4 * g + i] + sfx); sfx += c[4 * g + i]; }
            after += G[g] + PG[g];
        }
        carry = after;
        bf16x8 pf[2];
#pragma unroll
        for (int s = 0; s < 2; ++s) { v4u p; p.x = cvtpk(att[8 * s], att[8 * s + 1]); p.y = cvtpk(att[8 * s + 2], att[8 * s + 3]); p.z = cvtpk(att[8 * s + 4], att[8 * s + 5]); p.w = cvtpk(att[8 * s + 6], att[8 * s + 7]); pf[s] = __builtin_bit_cast(bf16x8, p); }
        LDS_WAIT();
#pragma unroll
        for (int s = 0; s < 2; ++s) {
            const s16x4 a0 = *(const LAS s16x4*)(vt + qi * SB_VP + 16 * s + 4 * hh), a1 = *(const LAS s16x4*)(vt + qi * SB_VP + 16 * s + 8 + 4 * hh);
            const s16x4 b0 = *(const LAS s16x4*)(vt + (32 + qi) * SB_VP + 16 * s + 4 * hh), b1 = *(const LAS s16x4*)(vt + (32 + qi) * SB_VP + 16 * s + 8 + 4 * hh);
            const bf16x8 va = __builtin_shufflevector(a0, a1, 0, 1, 2, 3, 4, 5, 6, 7), vb = __builtin_shufflevector(b0, b1, 0, 1, 2, 3, 4, 5, 6, 7);
            o0 = MFMA32(va, pf[s], o0);
            o1 = MFMA32(vb, pf[s], o1);
        }
        LDS_WAIT();
        if (__all(carry < SB_EXIT)) break;
    }
    float ss = 0.f;
#pragma unroll
    for (int r = 0; r < 16; ++r) ss += o0[r] * o0[r] + o1[r] * o1[r];
    ss += __shfl_xor(ss, 32);
    const float scl = rsqrtf(ss * (1.f / 64.f) + NORM_EPS);
    bf16* orow = ymix + (rowb + q) * D + 512 + h * 64;
#pragma unroll
    for (int g = 0; g < 4; ++g) {
        const int d0 = 8 * g + 4 * hh;
        const f32x4 g0 = *(const f32x4*)(sb_g + h * 64 + d0), g1 = *(const f32x4*)(sb_g + h * 64 + 32 + d0);
        v2u w0, w1;
        w0.x = cvtpk(o0[4 * g] * scl * g0.x, o0[4 * g + 1] * scl * g0.y); w0.y = cvtpk(o0[4 * g + 2] * scl * g0.z, o0[4 * g + 3] * scl * g0.w);
        w1.x = cvtpk(o1[4 * g] * scl * g1.x, o1[4 * g + 1] * scl * g1.y); w1.y = cvtpk(o1[4 * g + 2] * scl * g1.z, o1[4 * g + 3] * scl * g1.w);
        *(GAS v2u*)(orow + d0) = w0; *(GAS v2u*)(orow + 32 + d0) = w1;
    }
}
constexpr int NPHASE = 24;
#ifndef MK_SINGLE
#define MK_SINGLE 1
#endif
struct Args { const float* in[46]; float* out; unsigned char* ws; int ph_lo, ph_hi; };

DI unsigned char* opq(unsigned char* p) { asm volatile("" : "+s"(p)); return p; }
DI int opqv(int v) { asm volatile("" : "+v"(v)); return v; }
DI const float* inp(int i) { const float* const* t = (const float* const*)__builtin_amdgcn_kernarg_segment_ptr(); asm volatile("" : "+s"(t)); return t[i]; }

__global__ void __launch_bounds__(NWAVES * 64, 2) fwd_kernel(Args args) {
    extern __shared__ __attribute__((aligned(16))) unsigned char lds_raw[];
    LAS unsigned char* lds = (LAS unsigned char*)lds_raw;
    volatile LAS unsigned* MISC = (volatile LAS unsigned*)(lds + MISC_OFF);
    const int tid0 = threadIdx.x, wave = __builtin_amdgcn_readfirstlane(tid0 >> 6);
    const int G = gridDim.x, blk = blockIdx.x;
    const int gw = blk * NWAVES + wave, NGW = G * NWAVES;
    unsigned char* ws0 = args.ws;
#define ws opq(ws0)
#define ctl ((unsigned*)(ws + WS_CTL))
    for (int u = tid0; u < (LDS_BYTES - RING_BYTES) / 4; u += NWAVES * 64) ((LAS unsigned*)(lds + RING_BYTES))[u] = 0u;
    __syncthreads();
    const int lo = args.ph_lo, hi = args.ph_hi;
    XcdBarrier bar; bar.bar = ctl + CW_BAR; bar.x = 0; bar.st = nullptr;
    if (hi - lo > 1) bar = xcd_barrier_post(ctl + CW_BAR, MISC + 8);
#ifndef PHMASK
#define PHMASK 0xFFFFFF
#endif
#define IN(k) (((PHMASK >> (k)) & 1) && lo <= (k) && (k) < hi)
#define SEAM(k) do { if (IN(k) && IN((k) + 1)) xcd_barrier(bar); } while (0)

#define B_HN ((bf16*)(ws + WS_HN))
#define B_YMIX ((bf16*)(ws + WS_YMIX))
#define B_VF ((bf16*)(ws + WS_VF))
#define B_PA ((bf16*)(ws + WS_PA))
#define B_PB ((bf16*)(ws + WS_PB))
#define B_Y ((bf16*)(ws + WS_Y))
    float* xo = args.out;
#define x_in inp(0)

    if (IN(0)) { const int tid = opqv(tid0), lane = tid & 63; (void)tid; (void)lane;
        LAS float* scr = (LAS float*)(lds + wave * 16384);
        conv_matrix<1>(inp(2), D, 3232, (bf16*)(ws + WS_WIN0), 1696, scr, gw, NGW, lane);
        conv_matrix<1>(inp(23), D, 3264, (bf16*)(ws + WS_WIN1), 1728, scr, gw, NGW, lane);
        zero_rows((bf16*)(ws + WS_WIN0), D, 1696, NA, gw, NGW, lane);
        zero_rows((bf16*)(ws + WS_WIN1), D, 1728, NA, gw, NGW, lane);
        conv_matrix<0>(inp(15), D, D, (bf16*)(ws + WS_WOUT0), 0, scr, gw, NGW, lane);
        conv_matrix<0>(inp(38), D, D, (bf16*)(ws + WS_WOUT1), 0, scr, gw, NGW, lane);
        conv_matrix<2>(inp(18), D, FF, (bf16*)(ws + WS_WGU0), 0, scr, gw, NGW, lane);
        conv_matrix<3>(inp(19), D, FF, (bf16*)(ws + WS_WGU0), 0, scr, gw, NGW, lane);
        conv_matrix<0>(inp(20), FF, D, (bf16*)(ws + WS_WDN0), 0, scr, gw, NGW, lane);
        phase_norm0(x_in, inp(1), B_HN, gw, NGW, lane);
    }
    SEAM(0);

#pragma unroll
    for (int l = 0; l < 2; ++l) {
        const int pb = l ? 8 : 1;
        if (IN(pb)) { const int tid = opqv(tid0), lane = tid & 63; (void)tid; (void)lane;
            pg8::Gemm g{B_HN, (const bf16*)(ws + (l ? WS_WIN1 : WS_WIN0)), M, NPROJ, D}; pg8::StaticOrder S; S.init(M, NPROJ, G, blk);
            pg8::EpiProj E{B_PA, B_PB};
            pg8::gemm_phase<pg8::EpiProj, pg8::StaticOrder, true, true>(lds, g, S, E);
        }
        SEAM(pb);
        if (IN(pb + 1)) { const int tid = opqv(tid0), lane = tid & 63; (void)tid; (void)lane;
            const int o = l ? 21 : 0;
            RwkvP P;
            P.PA = B_PA; P.mu = inp(3 + o); P.decay0 = inp(4 + o); P.decay_up = inp(5 + o); P.iclr0 = inp(6 + o); P.iclr_up = inp(7 + o); P.gate_up = inp(8 + o);
            P.vres0 = inp(30); P.vres_up = inp(31);
            const int o2 = l ? 23 : 0;
            P.k_k = inp(9 + o2); P.k_a = inp(10 + o2); P.r_k = inp(11 + o2); P.lnx_g = inp(12 + o2); P.lnx_b = inp(13 + o2);
            P.vfirst = B_VF; P.ymix = B_YMIX; P.has_vres = l;
            const float* sbg = inp(14 + o2);
            const bool split = G > 32;
#ifndef NO_RWKV
            if (!split || blk < 32) for (int ru = blk; ru < 32; ru += G) rwkv_seq_unit(P, ru >> 3, ru & 7, lds, tid);
#endif
#ifndef NO_SB
            if (!split || blk >= 32) {
                const int sbw = split ? G - 32 : G, sbi = split ? blk - 32 : blk;
                for (int u = sbi; u < NBATCH * NH * (SEQ / 256); u += sbw) {
                    const int qb = u & 31, bh = u >> 5;
                    sb_wave(B_PB, B_YMIX, sbg, bh >> 3, bh & 7, qb * 256 + wave * 32, lds + wave * 8192, lane);
                }
            }
#endif
        }
        SEAM(pb + 1);
        if (IN(pb + 2)) { const int tid = opqv(tid0), lane = tid & 63; (void)tid; (void)lane;
            pg8::Gemm g{B_YMIX, (const bf16*)(ws + (l ? WS_WOUT1 : WS_WOUT0)), M, D, D}; pg8::StaticOrder S; S.init(M, D, G, blk);
            pg8::EpiBf16Plain E{B_Y, D};
            pg8::gemm_phase<pg8::EpiBf16Plain, pg8::StaticOrder, true, true>(lds, g, S, E);
        }
        SEAM(pb + 2);
        if (IN(pb + 3)) { const int tid = opqv(tid0), lane = tid & 63; (void)tid; (void)lane;
            if (l == 0) phase_resnorm<false>(x_in, B_Y, nullptr, inp(16), inp(17), xo, B_HN, nullptr, nullptr, nullptr, nullptr, gw, NGW, lane);
            else phase_resnorm<false>(xo, B_Y, nullptr, inp(39), inp(40), xo, B_HN, inp(41), (unsigned*)(ws + WS_SEL), (float*)(ws + WS_GTS), ctl + CW_TOT, gw, NGW, lane);
        }
        SEAM(pb + 3);
    if (l == 0) {
        if (IN(5)) { const int tid = opqv(tid0), lane = tid & 63; (void)tid; (void)lane;
            pg8::Gemm g{B_HN, (const bf16*)(ws + WS_WGU0), M, 2 * FF, D}; pg8::StaticOrder S; S.init(M, 2 * FF, G, blk);
            pg8::EpiSwiglu E{(bf16*)(ws + WS_H0), FF, 0};
            pg8::gemm_phase<pg8::EpiSwiglu, pg8::StaticOrder, true, true>(lds, g, S, E);
        }
        SEAM(5);
        if (IN(6)) { const int tid = opqv(tid0), lane = tid & 63; (void)tid; (void)lane;
            pg8::Gemm g{(const bf16*)(ws + WS_H0), (const bf16*)(ws + WS_WDN0), M, D, FF}; pg8::StaticOrder S; S.init(M, D, G, blk);
            pg8::EpiBf16Plain E{(bf16*)(ws + WS_F), D};
            pg8::gemm_phase<pg8::EpiBf16Plain, pg8::StaticOrder, true, true>(lds, g, S, E);
        }
        SEAM(6);
        if (IN(7)) { const int tid = opqv(tid0), lane = tid & 63; (void)tid; phase_resnorm<false>(xo, (const bf16*)(ws + WS_F), nullptr, inp(21), inp(22), xo, B_HN, nullptr, nullptr, nullptr, nullptr, gw, NGW, lane); }
        SEAM(7);
    } else {
        if (IN(12)) { const int tid = opqv(tid0), lane = tid & 63; (void)tid; (void)lane;
            LAS float* scr = (LAS float*)(lds + wave * 16384);
#pragma unroll 1
            for (int e = 0; e < NE; ++e) {
                conv_matrix<2>(inp(42) + (size_t)e * D * FF, D, FF, (bf16*)(ws + WS_WMGU) + (size_t)e * 2 * FF * D, 0, scr, gw, NGW, lane);
                conv_matrix<3>(inp(43) + (size_t)e * D * FF, D, FF, (bf16*)(ws + WS_WMGU) + (size_t)e * 2 * FF * D, 0, scr, gw, NGW, lane);
                conv_matrix<0>(inp(44) + (size_t)e * D * FF, FF, D, (bf16*)(ws + WS_WMDN) + (size_t)e * D * FF, 0, scr, gw, NGW, lane);
            }
            phase_moe_sort((const unsigned*)(ws + WS_SEL), (const float*)(ws + WS_GTS), ctl + CW_TOT, ctl + CW_CUR, (unsigned*)(ws + WS_POS), (float*)(ws + WS_GSORT), B_HN, (bf16*)(ws + WS_HS), gw, NGW, lane);
        }
        SEAM(12);
#pragma unroll 1
        for (int p = 0; p < MOE_PARTS; ++p) {
            const int phg = 13 + 2 * p;
            if (IN(phg) || IN(phg + 1)) {
                const int lane = opqv(tid0) & 63;
                int mytot; const int myoff = moe_offsets(ctl + CW_TOT, lane, mytot);
                pg8::MoeOrder S;
                const int nTiles = __builtin_amdgcn_readfirstlane(__shfl(myoff, 8)) >> 8;
                S.ts1 = __builtin_amdgcn_readfirstlane(__shfl(myoff, 1)) >> 8; S.ts2 = __builtin_amdgcn_readfirstlane(__shfl(myoff, 2)) >> 8; S.ts3 = __builtin_amdgcn_readfirstlane(__shfl(myoff, 3)) >> 8;
                S.ts4 = __builtin_amdgcn_readfirstlane(__shfl(myoff, 4)) >> 8; S.ts5 = __builtin_amdgcn_readfirstlane(__shfl(myoff, 5)) >> 8; S.ts6 = __builtin_amdgcn_readfirstlane(__shfl(myoff, 6)) >> 8;
                S.ts7 = __builtin_amdgcn_readfirstlane(__shfl(myoff, 7)) >> 8;
                const int t0 = p * MOE_PART_TILES; int nT = nTiles - t0; nT = nT < 0 ? 0 : (nT > MOE_PART_TILES ? MOE_PART_TILES : nT);
                S.t0 = t0; S.nT = nT; S.G = G; S.c = blk;
                if (IN(phg)) { const int tid = opqv(tid0), lane = tid & 63; (void)tid; (void)lane;
                    S.nN = 2 * FF / 256; S.nwg = nT * S.nN; S.nNe = 2 * FF / 256; S.arel = 0;
                    pg8::Gemm g{(const bf16*)(ws + WS_HS), (const bf16*)(ws + WS_WMGU), 0, 0, D};
                    pg8::EpiSwiglu E{(bf16*)(ws + WS_HP), FF, -(long)t0 * 256};
                    pg8::gemm_phase<pg8::EpiSwiglu, pg8::MoeOrder, true, true>(lds, g, S, E);
                }
                SEAM(phg);
                if (IN(phg + 1)) { const int tid = opqv(tid0), lane = tid & 63; (void)tid; (void)lane;
                    S.nN = D / 256; S.nwg = nT * S.nN; S.nNe = D / 256; S.arel = 1;
                    pg8::Gemm g{(const bf16*)(ws + WS_HP), (const bf16*)(ws + WS_WMDN), 0, 0, FF};
                    pg8::EpiMoeDown E{(bf16*)(ws + WS_HS), D, (const float*)(ws + WS_GSORT)};
                    pg8::gemm_phase<pg8::EpiMoeDown, pg8::MoeOrder, true, true>(lds, g, S, E);
                }
                SEAM(phg + 1);
            }
        }
        if (IN(23)) { const int tid = opqv(tid0), lane = tid & 63; (void)tid; phase_resnorm<true>(xo, (const bf16*)(ws + WS_HS), (const unsigned*)(ws + WS_POS), inp(45), nullptr, xo, nullptr, nullptr, nullptr, nullptr, nullptr, gw, NGW, lane); }
    }
    }
#undef IN
#undef SEAM
#undef x_in
#undef ws
#undef ctl
#undef B_HN
#undef B_YMIX
#undef B_VF
#undef B_PA
#undef B_PB
#undef B_Y
}

extern "C" void kernel_launch(void* const* d_in, const int* in_sizes, int n_in, void* d_out, int out_size, void* d_ws, size_t ws_size, hipStream_t stream) {
    static int grid = 0;
    if (grid == 0) {
        if (n_in != 46 || in_sizes[0] != M * D || out_size != M * D || ws_size < WS_END) { fprintf(stderr, "kernel_launch: unexpected problem: n_in %d in0 %d out %d ws %zu (need %zu)\n", n_in, n_in > 0 ? in_sizes[0] : -1, out_size, ws_size, (size_t)WS_END); grid = -1; return; }
        int dev = 0, cus = 0, per_cu = 0;
        if (hipGetDevice(&dev) != hipSuccess || hipDeviceGetAttribute(&cus, hipDeviceAttributeMultiprocessorCount, dev) != hipSuccess) { grid = -1; return; }
        if (hipFuncSetAttribute((const void*)fwd_kernel, hipFuncAttributeMaxDynamicSharedMemorySize, LDS_BYTES) != hipSuccess) { fprintf(stderr, "kernel_launch: hipFuncSetAttribute failed\n"); grid = -1; return; }
        if (hipOccupancyMaxActiveBlocksPerMultiprocessor(&per_cu, (const void*)fwd_kernel, NWAVES * 64, LDS_BYTES) != hipSuccess || per_cu < 1) { fprintf(stderr, "kernel_launch: occupancy query says %d\n", per_cu); }
        (void)hipGetLastError();
        grid = cus;
    }
    if (grid < 0) return;
    (void)hipMemsetAsync((char*)d_ws + WS_CTL, 0, CTL_ZERO_BYTES, stream);
    Args a{};
    for (int i = 0; i < 46; ++i) a.in[i] = (const float*)d_in[i];
    a.out = (float*)d_out; a.ws = (unsigned char*)d_ws;
#if MK_SINGLE
    a.ph_lo = 0; a.ph_hi = NPHASE;
    hipLaunchKernelGGL(fwd_kernel, dim3(grid), dim3(NWAVES * 64), LDS_BYTES, stream, a);
#else
    for (int p = 0; p < NPHASE; ++p) { a.ph_lo = p; a.ph_hi = p + 1; hipLaunchKernelGGL(fwd_kernel, dim3(grid), dim3(NWAVES * 64), LDS_BYTES, stream, a); }
#endif
}
```

```cpp
#include <hip/hip_runtime.h>
#include <cstdio>
#include <cstdint>
namespace pg8 {
#define PG8_LAS __attribute__((address_space(3)))
typedef unsigned short bf16_t;
typedef short bf16x8 __attribute__((ext_vector_type(8)));
typedef float f32x4 __attribute__((ext_vector_type(4)));
typedef unsigned u32x4 __attribute__((ext_vector_type(4)));
constexpr int BM = 256, BK = 64, HALF = 128, HTB = HALF * BK * 2  , STAGE_BYTES = 8 * HTB, NXCD = 8, WGM = 8;

__host__ __device__ __forceinline__ int lds_byte(int r, int c) { const int st = (r >> 4) * 2 + (c >> 5), rr = r & 15, cc = c & 31, ob = rr * 64 + cc * 2; return st * 1024 + (ob ^ (((ob >> 9) & 1) << 5)); }
__host__ __device__ __forceinline__ void stage_rc(int b, int& R, int& C) { const int st = b / 1024, sb = b % 1024, swz = sb ^ (((sb >> 9) & 1) << 5); R = (st >> 1) * 16 + swz / 64; C = (st & 1) * 32 + (swz % 64) / 2; }
__host__ __device__ __forceinline__ int perm32(int rho) { const int n = rho >> 4, i = rho & 15; return 8 * (i >> 2) + 4 * n + (i & 3); }

struct Unit { int pm, pa, pn, po; };
struct Gemm { const bf16_t* A; const bf16_t* Bt; int M, N, K; };

struct StaticOrder {
    int nM, nN, nwg, G, c;
    __host__ __device__ void init(int M, int N, int G_, int c_) { nM = M / BM; nN = N / BM; nwg = nM * nN; G = G_; c = c_; }
    __host__ __device__ bool next(int i, Unit& u) const {
        const long L = (long)i * G + c; if (L >= nwg) return false;
        int wgid = (int)L; { const int q = nwg / NXCD, r = nwg % NXCD, xcd = wgid % NXCD, off = wgid / NXCD; wgid = (xcd < r ? xcd * (q + 1) : r * (q + 1) + (xcd - r) * q) + off; }
        const int nig = WGM * nN, gid = wgid / nig, fm = gid * WGM, gsz = (nM - fm) < WGM ? (nM - fm) : WGM;
        u.pm = fm + ((wgid % nig) % gsz); u.pn = (wgid % nig) / gsz; u.pa = u.pm; u.po = u.pn; return true;
    }
    __device__ __forceinline__ void a_ready(const Unit&) const {}
    __device__ __forceinline__ void done(const Unit&) const {}
};

__device__ __forceinline__ unsigned cvt_pk_bf16(float lo, float hi) { unsigned r; asm volatile("v_cvt_pk_bf16_f32 %0, %1, %2" : "=v"(r) : "v"(lo), "v"(hi)); return r; }
typedef float f32x2 __attribute__((ext_vector_type(2)));

template <class Epi, class Sched, bool ALIGN_EPI = false, bool SP2 = false>
__device__ __forceinline__ void gemm_phase(PG8_LAS unsigned char* lds, const Gemm g, const Sched& S, const Epi& E, int tid_in) {
    int tid_ = tid_in; asm volatile("" : "+v"(tid_));
    const int tid = tid_, wid = __builtin_amdgcn_readfirstlane(tid >> 6), lane = tid & 63, wr = wid >> 2, wc = wid & 3, fr = lane & 15, fq = lane >> 4;
    const int K = g.K, nt = K / BK;
    unsigned voffA[2], voffB[2];
#pragma unroll
    for (int i = 0; i < 2; ++i) { int R, C; stage_rc(tid * 16 + i * 8192, R, C); const int Rb = Epi::PERM ? ((R & ~31) + perm32(R & 31)) : R;
        voffA[i] = (unsigned)(R * K + C) * 2u; voffB[i] = (unsigned)(Rb * K + C) * 2u; }
    const size_t kstep = (size_t)(BK * 2);
    const size_t hstep = (size_t)HALF * K * 2;
    const size_t tstep = 2 * hstep;
    const unsigned ldsw = (unsigned)wid * 1024u;
    const int aoff = lds_byte(wr * 64 + fr, fq * 8), boff = lds_byte(wc * 32 + fr, fq * 8);
#define PG8_SA(b, h) (((b) * 2 + (h)) * HTB)
#define PG8_SB(b, h) ((4 + (b) * 2 + (h)) * HTB)
#define PG8_STAGE(bufoff, gbase, voff) do { _Pragma("unroll") for (int _i = 0; _i < 2; ++_i) \
        __builtin_amdgcn_global_load_lds((const unsigned*)((const char*)(gbase) + (voff)[_i]), (PG8_LAS unsigned*)(lds + (bufoff) + ldsw + _i * 8192), 16, 0, 0); } while (0)
#define PG8_LDA(dst, b, h) do { _Pragma("unroll") for (int m = 0; m < 4; ++m) _Pragma("unroll") for (int k = 0; k < 2; ++k) dst[m][k] = *(const PG8_LAS bf16x8*)(lds + PG8_SA(b, h) + aoff + m * 2048 + k * 1024); } while (0)
#define PG8_LDB(dst, b, h) do { _Pragma("unroll") for (int n = 0; n < 2; ++n) _Pragma("unroll") for (int k = 0; k < 2; ++k) dst[n][k] = *(const PG8_LAS bf16x8*)(lds + PG8_SB(b, h) + boff + n * 2048 + k * 1024); } while (0)
#define PG8_MMA(ai, bj, At, Bt) do { __builtin_amdgcn_s_setprio(1); _Pragma("unroll") for (int m = 0; m < 4; ++m) _Pragma("unroll") for (int n = 0; n < 2; ++n) _Pragma("unroll") for (int k = 0; k < 2; ++k) \
        acc[ai][bj][m][n] = __builtin_amdgcn_mfma_f32_16x16x32_bf16(Bt[n][k], At[m][k], acc[ai][bj][m][n], 0, 0, 0); __builtin_amdgcn_s_setprio(0); } while (0)
#define PG8_WAIT_V(n) asm volatile("s_waitcnt vmcnt(" #n ")" ::: "memory")
#define PG8_WAIT_L(n) asm volatile("s_waitcnt lgkmcnt(" #n ")" ::: "memory")
#define PG8_BAR __builtin_amdgcn_s_barrier()
#define PG8_SCHED __builtin_amdgcn_sched_barrier(0)
    Unit cur, nxt; int ui = 0;
    if (!S.next(0, cur)) return;
    f32x4 acc[2][2][4][2];
#pragma unroll
    for (int a = 0; a < 2; ++a)
#pragma unroll
        for (int b = 0; b < 2; ++b)
#pragma unroll
            for (int m = 0; m < 4; ++m)
#pragma unroll
                for (int n = 0; n < 2; ++n) acc[a][b][m][n] = (f32x4){0.f, 0.f, 0.f, 0.f};
    bf16x8 At[4][2], B0[2][2], B1[2][2];
    const char* cA = (const char*)g.A + (size_t)cur.pa * tstep; const char* cB = (const char*)g.Bt + (size_t)cur.pn * tstep;
    S.a_ready(cur);
    if constexpr (SP2) {
        PG8_STAGE(PG8_SB(0, 0), cB, voffB); PG8_STAGE(PG8_SB(0, 1), cB + hstep, voffB); PG8_STAGE(PG8_SA(0, 0), cA, voffA); PG8_STAGE(PG8_SA(0, 1), cA + hstep, voffA);
        if (wr == 1) PG8_BAR;
        PG8_WAIT_V(2); PG8_BAR;
        PG8_STAGE(PG8_SB(1, 0), cB + kstep, voffB); PG8_STAGE(PG8_SA(1, 0), cA + kstep, voffA); PG8_STAGE(PG8_SB(1, 1), cB + hstep + kstep, voffB);
        PG8_WAIT_V(6); PG8_BAR;
    } else {
        PG8_STAGE(PG8_SB(0, 0), cB, voffB); PG8_STAGE(PG8_SA(0, 0), cA, voffA); PG8_STAGE(PG8_SB(0, 1), cB + hstep, voffB); PG8_STAGE(PG8_SA(0, 1), cA + hstep, voffA);
        if (wr == 1) PG8_BAR;
        PG8_WAIT_V(4); PG8_BAR;
        PG8_STAGE(PG8_SB(1, 0), cB + kstep, voffB); PG8_STAGE(PG8_SA(1, 0), cA + kstep, voffA); PG8_STAGE(PG8_SB(1, 1), cB + hstep + kstep, voffB);
        PG8_WAIT_V(6); PG8_BAR;
    }
    for (;;) {
        const bool has_next = S.next(ui + 1, nxt);
        const char* nA = has_next ? (const char*)g.A + (size_t)nxt.pa * tstep : cA; const char* nB = has_next ? (const char*)g.Bt + (size_t)nxt.pn * tstep : cB;
        for (int t = 0; t < nt; t += 2) {
            const bool last = (t == nt - 2);
            const char* a1 = cA + (size_t)(t + 1) * kstep;
            const char* a2 = last ? nA : cA + (size_t)(t + 2) * kstep; const char* b2 = last ? nB : cB + (size_t)(t + 2) * kstep;
            const char* a3 = a2 + kstep; const char* b3 = b2 + kstep;
            if (last && has_next) S.a_ready(nxt);
            if constexpr (SP2) {
            PG8_LDB(B0, 0, 0); PG8_LDB(B1, 0, 1); PG8_SCHED; PG8_LDA(At, 0, 0); PG8_STAGE(PG8_SA(1, 1), a1 + hstep, voffA);
            PG8_WAIT_V(8); PG8_WAIT_L(0); PG8_BAR; PG8_MMA(0, 0, At, B0); PG8_MMA(0, 1, At, B1); PG8_BAR; PG8_SCHED;
            PG8_LDA(At, 0, 1); PG8_STAGE(PG8_SB(0, 0), b2, voffB); PG8_STAGE(PG8_SB(0, 1), b2 + hstep, voffB); PG8_STAGE(PG8_SA(0, 0), a2, voffA);
            PG8_WAIT_V(8); PG8_WAIT_L(0); PG8_BAR; PG8_MMA(1, 0, At, B0); PG8_MMA(1, 1, At, B1); PG8_BAR; PG8_SCHED;
            PG8_LDB(B0, 1, 0); PG8_LDB(B1, 1, 1); PG8_SCHED; PG8_LDA(At, 1, 0); PG8_STAGE(PG8_SA(0, 1), a2 + hstep, voffA);
            PG8_WAIT_V(8); PG8_WAIT_L(0); PG8_BAR; PG8_MMA(0, 0, At, B0); PG8_MMA(0, 1, At, B1); PG8_BAR; PG8_SCHED;
            PG8_LDA(At, 1, 1); PG8_STAGE(PG8_SB(1, 0), b3, voffB); PG8_STAGE(PG8_SB(1, 1), b3 + hstep, voffB); PG8_STAGE(PG8_SA(1, 0), a3, voffA);
            PG8_WAIT_V(8); PG8_WAIT_L(0); PG8_BAR; PG8_MMA(1, 0, At, B0); PG8_MMA(1, 1, At, B1); PG8_BAR; PG8_SCHED;
            } else {
            PG8_LDB(B0, 0, 0); PG8_SCHED; PG8_LDA(At, 0, 0); PG8_STAGE(PG8_SA(1, 1), a1 + hstep, voffA);
            PG8_WAIT_L(8); PG8_BAR; PG8_WAIT_L(0); PG8_MMA(0, 0, At, B0); PG8_BAR; PG8_SCHED;
            PG8_LDB(B1, 0, 1); PG8_STAGE(PG8_SB(0, 0), b2, voffB);
            PG8_BAR; PG8_WAIT_L(0); PG8_MMA(0, 1, At, B1); PG8_BAR;
            PG8_LDA(At, 0, 1); PG8_STAGE(PG8_SA(0, 0), a2, voffA);
            PG8_BAR; PG8_WAIT_L(0); PG8_MMA(1, 0, At, B0); PG8_BAR; PG8_SCHED;
            PG8_STAGE(PG8_SB(0, 1), b2 + hstep, voffB);
            PG8_WAIT_V(6); PG8_BAR; PG8_MMA(1, 1, At, B1); PG8_BAR;
            PG8_LDB(B0, 1, 0); PG8_SCHED; PG8_LDA(At, 1, 0); PG8_STAGE(PG8_SA(0, 1), a2 + hstep, voffA);
            PG8_WAIT_L(8); PG8_BAR; PG8_WAIT_L(0); PG8_MMA(0, 0, At, B0); PG8_BAR; PG8_SCHED;
            PG8_LDB(B1, 1, 1); PG8_STAGE(PG8_SB(1, 0), b3, voffB);
            PG8_BAR; PG8_WAIT_L(0); PG8_MMA(0, 1, At, B1); PG8_BAR;
            PG8_LDA(At, 1, 1); PG8_STAGE(PG8_SA(1, 0), a3, voffA);
            PG8_BAR; PG8_WAIT_L(0); PG8_MMA(1, 0, At, B0); PG8_BAR; PG8_SCHED;
            PG8_STAGE(PG8_SB(1, 1), b3 + hstep, voffB);
            PG8_WAIT_V(6); PG8_BAR; PG8_MMA(1, 1, At, B1); PG8_BAR;
            }
        }
        if constexpr (ALIGN_EPI) { if (wr == 0) PG8_BAR; }
        if constexpr (!Epi::AFTER_DRAIN) { E(acc, cur, wr, wc, fr, fq); S.done(cur); }
        if (!has_next) break;
#pragma unroll
        for (int a = 0; a < 2; ++a)
#pragma unroll
            for (int b = 0; b < 2; ++b)
#pragma unroll
                for (int m = 0; m < 4; ++m)
#pragma unroll
                    for (int n = 0; n < 2; ++n) acc[a][b][m][n] = (f32x4){0.f, 0.f, 0.f, 0.f};
        cur = nxt; cA = nA; cB = nB; ++ui;
        if constexpr (ALIGN_EPI) { if (wr == 1) PG8_BAR; }
    }
    PG8_WAIT_V(0);
    if constexpr (!ALIGN_EPI) { if (wr == 0) PG8_BAR; }
    PG8_BAR;
    if constexpr (Epi::AFTER_DRAIN) { E.fused(acc, cur, wr, wc, fr, fq, lds, wid, lane); S.done(cur); }
#undef PG8_SA
#undef PG8_SB
#undef PG8_STAGE
#undef PG8_LDA
#undef PG8_LDB
#undef PG8_MMA
#undef PG8_WAIT_V
#undef PG8_WAIT_L
#undef PG8_BAR
#undef PG8_SCHED
}
}
namespace pg8 {
struct EpiProj {
    static constexpr bool PERM = true, AFTER_DRAIN = false;
    bf16_t* PA; bf16_t* PB;
    __device__ __forceinline__ void operator()(const f32x4 (&acc)[2][2][4][2], const Unit& u, int wr, int wc, int fr, int fq) const {
        const int row0 = u.pm * BM + wr * 64 + fr;
        bf16_t* base; int ldc, colt;
        if (u.po < 7) { base = PA; ldc = 1792; colt = u.po * BM; } else { base = PB; ldc = 1536; colt = (u.po - 7) * BM; }
        const int col0 = colt + wc * 32 + 8 * fq;
#pragma unroll
        for (int ai = 0; ai < 2; ++ai)
#pragma unroll
            for (int m = 0; m < 4; ++m) { bf16_t* rowp = base + (size_t)(row0 + ai * HALF + m * 16) * ldc + col0;
#pragma unroll
                for (int bj = 0; bj < 2; ++bj) { const f32x4 v0 = acc[ai][bj][m][0], v1 = acc[ai][bj][m][1];
                    u32x4 w; w.x = cvt_pk_bf16(v0[0], v0[1]); w.y = cvt_pk_bf16(v0[2], v0[3]); w.z = cvt_pk_bf16(v1[0], v1[1]); w.w = cvt_pk_bf16(v1[2], v1[3]);
                    *(u32x4*)(rowp + bj * HALF) = w; } }
    }
};
struct EpiBf16Plain {
    static constexpr bool PERM = true, AFTER_DRAIN = false;
    bf16_t* O; int ldc;
    __device__ __forceinline__ void operator()(const f32x4 (&acc)[2][2][4][2], const Unit& u, int wr, int wc, int fr, int fq) const {
        const int row0 = u.pm * BM + wr * 64 + fr;
        const int col0 = u.po * BM + wc * 32 + 8 * fq;
#pragma unroll
        for (int ai = 0; ai < 2; ++ai)
#pragma unroll
            for (int m = 0; m < 4; ++m) { bf16_t* rowp = O + (size_t)(row0 + ai * HALF + m * 16) * ldc + col0;
#pragma unroll
                for (int bj = 0; bj < 2; ++bj) { const f32x4 v0 = acc[ai][bj][m][0], v1 = acc[ai][bj][m][1];
                    u32x4 w; w.x = cvt_pk_bf16(v0[0], v0[1]); w.y = cvt_pk_bf16(v0[2], v0[3]); w.z = cvt_pk_bf16(v1[0], v1[1]); w.w = cvt_pk_bf16(v1[2], v1[3]);
                    *(u32x4*)(rowp + bj * HALF) = w; } }
    }
};
struct EpiSwiglu {
    static constexpr bool PERM = true, AFTER_DRAIN = false;
    bf16_t* H; int ldc; long rowoff;
    __device__ __forceinline__ void operator()(const f32x4 (&acc)[2][2][4][2], const Unit& u, int wr, int wc, int fr, int fq) const {
        const long row0 = (long)u.pm * BM + wr * 64 + fr + rowoff;
        const int col0 = u.po * HALF + wc * 32 + 8 * fq;
#pragma unroll
        for (int ai = 0; ai < 2; ++ai)
#pragma unroll
            for (int m = 0; m < 4; ++m) { bf16_t* rowp = H + (size_t)(row0 + ai * HALF + m * 16) * ldc + col0;
                float o[8];
#pragma unroll
                for (int n = 0; n < 2; ++n)
#pragma unroll
                    for (int j = 0; j < 4; ++j) { const float g = acc[ai][0][m][n][j], up = acc[ai][1][m][n][j];
                        const float s = g * __builtin_amdgcn_rcpf(1.0f + __builtin_amdgcn_exp2f(-1.4426950408889634f * g)); o[n * 4 + j] = s * up; }
                u32x4 w; w.x = cvt_pk_bf16(o[0], o[1]); w.y = cvt_pk_bf16(o[2], o[3]); w.z = cvt_pk_bf16(o[4], o[5]); w.w = cvt_pk_bf16(o[6], o[7]);
                *(u32x4*)rowp = w; }
    }
};
struct EpiMoeDown {
    static constexpr bool PERM = true, AFTER_DRAIN = false;
    bf16_t* O; int ldc; const float* gs;
    __device__ __forceinline__ void operator()(const f32x4 (&acc)[2][2][4][2], const Unit& u, int wr, int wc, int fr, int fq) const {
        const int row0 = u.pm * BM + wr * 64 + fr;
        const int col0 = u.po * BM + wc * 32 + 8 * fq;
#pragma unroll
        for (int ai = 0; ai < 2; ++ai)
#pragma unroll
            for (int m = 0; m < 4; ++m) { const int row = row0 + ai * HALF + m * 16; const float gt = gs[row]; bf16_t* rowp = O + (size_t)row * ldc + col0;
#pragma unroll
                for (int bj = 0; bj < 2; ++bj) { const f32x4 v0 = acc[ai][bj][m][0] * gt, v1 = acc[ai][bj][m][1] * gt;
                    u32x4 w; w.x = cvt_pk_bf16(v0[0], v0[1]); w.y = cvt_pk_bf16(v0[2], v0[3]); w.z = cvt_pk_bf16(v1[0], v1[1]); w.w = cvt_pk_bf16(v1[2], v1[3]);
                    *(u32x4*)(rowp + bj * HALF) = w; } }
    }
};
struct MoeOrder {
    int t0, nT, nN, nwg, G, c, nNe, arel;
    int ts1, ts2, ts3, ts4, ts5, ts6, ts7;
    __device__ bool next(int i, Unit& u) const {
        const long L = (long)i * G + c; if (L >= nwg) return false;
        int wgid = (int)L; { const int q = nwg / NXCD, r = nwg % NXCD, xcd = wgid % NXCD, off = wgid / NXCD; wgid = (xcd < r ? xcd * (q + 1) : r * (q + 1) + (xcd - r) * q) + off; }
        const int nig = WGM * nN, gid = wgid / nig, fm = gid * WGM, gsz = (nT - fm) < WGM ? (nT - fm) : WGM;
        const int pml = fm + ((wgid % nig) % gsz), pnl = (wgid % nig) / gsz;
        u.pm = t0 + pml; u.pa = arel ? pml : u.pm; u.po = pnl;
        const int e = (u.pm >= ts1) + (u.pm >= ts2) + (u.pm >= ts3) + (u.pm >= ts4) + (u.pm >= ts5) + (u.pm >= ts6) + (u.pm >= ts7);
        u.pn = e * nNe + pnl; return true;
    }
    __device__ __forceinline__ void a_ready(const Unit&) const {}
    __device__ __forceinline__ void done(const Unit&) const {}
};
}
constexpr int NWAVES = 8;
constexpr int NBATCH = 4, SEQ = 8192, M = NBATCH * SEQ, D = 1024, NH = 8, HD = 64;
constexpr int NA = 1792, NPB = 1536, NPROJ = NA + NPB, FF = 3584, NE = 8;
constexpr int MOE_PART_TILES = 64, MOE_PARTS = 5;
constexpr float NORM_EPS = 1e-6f, LNX_EPS = 64e-5f, DECAY_SCALE = 0.6065306597126334f;
constexpr float SB_EXIT = -104.0f;

constexpr size_t MiB = 1u << 20;
constexpr size_t WS_CTL = 0, CTL_ZERO_BYTES = 1 * MiB;
constexpr size_t WS_WIN0 = 1 * MiB, WS_WIN1 = 8 * MiB, WS_WOUT0 = 15 * MiB, WS_WOUT1 = 17 * MiB, WS_WGU0 = 19 * MiB, WS_WDN0 = 33 * MiB;
constexpr size_t WS_SEL = 40 * MiB, WS_GTS = WS_SEL + 128 * 1024, WS_POS = WS_GTS + 256 * 1024, WS_GSORT = WS_POS + 256 * 1024;
constexpr size_t WS_VF = 41 * MiB;
constexpr size_t WS_PA = 73 * MiB;
constexpr size_t WS_YMIX = 73 * MiB;
constexpr size_t WS_PB = 185 * MiB;
constexpr size_t WS_Y = 185 * MiB;
constexpr size_t WS_F = 185 * MiB;
constexpr size_t WS_SCR = 281 * MiB;
constexpr size_t WS_ZH = WS_SCR, WS_RH = WS_SCR + 32 * MiB, WS_BF = WS_SCR + 64 * MiB, WS_U0F = WS_SCR + 96 * MiB, WS_YF = WS_SCR + 128 * MiB, WS_GTF = WS_SCR + 160 * MiB, WS_GF = WS_SCR + 192 * MiB, WS_PLF = WS_SCR + 256 * MiB;
constexpr size_t WS_HN = 281 * MiB;
constexpr size_t WS_HNF0 = 73 * MiB, WS_HNF1 = 41 * MiB;
constexpr size_t WS_H0 = 281 * MiB;
constexpr size_t WS_UPT = 14 * MiB + 512 * 1024;
constexpr size_t WS_BON = 40 * MiB;
constexpr size_t WS_WMGU = 105 * MiB, WS_WMDN = 217 * MiB, WS_HS = 273 * MiB, WS_HP = 405 * MiB, WS_END = 539 * MiB;
static_assert(WS_WIN0 + (size_t)NPROJ * D * 2 <= WS_WIN1 && WS_WIN1 + (size_t)NPROJ * D * 2 <= WS_UPT && WS_UPT + 2 * 8 * 12288 * 2 <= WS_WOUT0 && WS_WGU0 + (size_t)2 * FF * D * 2 <= WS_WDN0, "weights map");
static_assert(WS_GSORT + (size_t)(2 * M + 2048) * 4 <= 41 * MiB, "routing tables");
static_assert(WS_PA + (size_t)M * NA * 2 <= WS_PB && WS_PB + (size_t)M * NPB * 2 <= WS_SCR && WS_PLF + (size_t)8192 * 64 * 4 <= WS_END && WS_H0 + (size_t)M * FF * 2 <= WS_END, "act map");
static_assert(WS_WMGU + (size_t)NE * 2 * FF * D * 2 <= WS_WMDN && WS_WMDN + (size_t)NE * D * FF * 2 <= WS_HS && WS_HS + (size_t)(2 * M + 2048) * D * 2 <= WS_HP && WS_HP + (size_t)MOE_PART_TILES * 256 * FF * 2 <= WS_END, "moe map");
constexpr int CW_BAR = 4096, CW_TOT = 16384, CW_CUR = 16384 + 1024;

constexpr int RING_BYTES = 131072, LDS_BYTES = 163840, MISC_OFF = LDS_BYTES - 512;

#define GAS __attribute__((address_space(1)))
#define LAS __attribute__((address_space(3)))
typedef unsigned short bf16;
typedef unsigned v4u __attribute__((ext_vector_type(4)));
typedef unsigned v2u __attribute__((ext_vector_type(2)));
typedef float f32x4 __attribute__((ext_vector_type(4)));
typedef float f32x16 __attribute__((ext_vector_type(16)));
typedef short bf16x8 __attribute__((ext_vector_type(8)));
typedef short s16x4 __attribute__((ext_vector_type(4)));
typedef float f32x2_t __attribute__((ext_vector_type(2)));
typedef __bf16 bf16x2_t __attribute__((ext_vector_type(2)));
#define RLX_AGENT __ATOMIC_RELAXED, __HIP_MEMORY_SCOPE_AGENT
#define LDS_WAIT() asm volatile("s_waitcnt lgkmcnt(0)" ::: "memory")
#define DI __device__ __forceinline__
#define MFMA32(a, b, c) __builtin_amdgcn_mfma_f32_32x32x16_bf16((a), (b), (c), 0, 0, 0)

DI unsigned cvtpk(float lo, float hi) { f32x2_t v = {lo, hi}; bf16x2_t b = __builtin_convertvector(v, bf16x2_t); return __builtin_bit_cast(unsigned, b); }
DI unsigned short f2bf(float f) { return (unsigned short)(cvtpk(f, 0.f) & 0xffffu); }
DI float bf2f(unsigned short u) { return __uint_as_float((unsigned)u << 16); }
DI float bflo(unsigned u) { return __uint_as_float(u << 16); }
DI float bfhi(unsigned u) { return __uint_as_float(u & 0xffff0000u); }
DI int lane_id() { int l; asm volatile("v_mbcnt_lo_u32_b32 %0, -1, 0\n\tv_mbcnt_hi_u32_b32 %0, -1, %0" : "=v"(l)); return l; }
DI float shx(float v, int o, int lane) { return __builtin_bit_cast(float, __builtin_amdgcn_ds_bpermute((lane ^ o) << 2, __builtin_bit_cast(int, v))); }
DI int shi(int v, int src) { return __builtin_amdgcn_ds_bpermute(src << 2, v); }
DI float wave_sum(float v, int lane) {
#pragma unroll
    for (int o = 1; o < 64; o <<= 1) v += shx(v, o, lane);
    return v;
}
DI float sigmoidf_(float x) { return __builtin_amdgcn_rcpf(1.0f + __expf(-x)); }
DI int crow(int r, int hi) { return (r & 3) + 8 * (r >> 2) + 4 * hi; }

#define XB_TMO      128
#define XB_XCNT(j)  (256  + 64 * (j))
#define XB_XSUB(j)  (1280 + 64 * (j))
#define XB_XGEN(j)  (2304 + 64 * (j))
#define XB_TOP      3328
#define XB_TOPGEN   3392
#define XCD_BAR_WORDS 3456
#define XB_SPIN_CAP (1u << 22)
DI unsigned xb_ld(unsigned* p)              { return __hip_atomic_load(p, __ATOMIC_RELAXED, __HIP_MEMORY_SCOPE_AGENT); }
DI unsigned xb_add(unsigned* p, unsigned v) { return __hip_atomic_fetch_add(p, v, __ATOMIC_RELAXED, __HIP_MEMORY_SCOPE_AGENT); }
DI unsigned xb_xcc_id() { return (unsigned)__builtin_amdgcn_s_getreg((3 << 11) | 20) & 0xFu; }
#define XB_SPIN(cond, bar) do { unsigned _sp = 0; while (cond) { __builtin_amdgcn_s_sleep(1); \
    if ((++_sp & 255u) == 0u) { if (xb_ld(&(bar)[XB_TMO])) break; if (_sp > XB_SPIN_CAP) { atomicAdd(&(bar)[XB_TMO], 1u); break; } } } } while (0)
struct XcdBarrier { unsigned* bar; unsigned x; volatile LAS unsigned* st; };
DI XcdBarrier xcd_barrier_post(unsigned* bar, volatile LAS unsigned* st, int tid) {
    XcdBarrier b; b.bar = bar; b.x = xb_xcc_id(); b.st = st;
    if (tid == 0) (void)xb_add(&bar[XB_XCNT(b.x)], 1u);
    return b;
}
DI void xcd_barrier_complete(unsigned* bar, unsigned x, unsigned& nloc, unsigned& nx) {
    const unsigned G = gridDim.x * gridDim.y * gridDim.z;
    unsigned sum, cnt, mine, sp = 0u;
    for (;;) {
        sum = 0u; cnt = 0u; mine = 0u;
#pragma unroll
        for (unsigned j = 0; j < 16; ++j) { const unsigned c = xb_ld(&bar[XB_XCNT(j)]); sum += c; cnt += (c > 0u) ? 1u : 0u; mine = (j == x) ? c : mine; }
        if (sum == G) break;
        __builtin_amdgcn_s_sleep(1);
        if ((++sp & 255u) == 0u) { if (xb_ld(&bar[XB_TMO])) break; if (sp > XB_SPIN_CAP) { atomicAdd(&bar[XB_TMO], 1u); break; } }
    }
    nloc = mine > 0u ? mine : 1u; nx = cnt > 0u ? cnt : 1u;
}
DI void xcd_barrier(const XcdBarrier& b, int tid) {
    asm volatile("s_waitcnt vmcnt(0)" ::: "memory");
    __syncthreads();
    if (tid == 0) {
        unsigned* bar = b.bar; const unsigned bx = b.x;
        __builtin_amdgcn_s_waitcnt(0);
        unsigned nloc = b.st[0], nx = b.st[1];
        if (nloc == 0u) { xcd_barrier_complete(bar, bx, nloc, nx); b.st[0] = nloc; b.st[1] = nx; }
        const unsigned old = xb_add(&bar[XB_XSUB(bx)], 1u);
        const unsigned gen = old / nloc;
        if (old + 1u == (gen + 1u) * nloc) {
            __builtin_amdgcn_fence(__ATOMIC_RELEASE, "agent");
            asm volatile("s_waitcnt vmcnt(0)" ::: "memory");
            const unsigned og = xb_add(&bar[XB_TOP], 1u);
            const unsigned tg = og / nx;
            if (og + 1u == (tg + 1u) * nx) xb_add(&bar[XB_TOPGEN], 1u);
            else XB_SPIN(xb_ld(&bar[XB_TOPGEN]) == tg, bar);
            __builtin_amdgcn_fence(__ATOMIC_ACQUIRE, "agent");
            xb_add(&bar[XB_XGEN(bx)], 1u);
            asm volatile("s_waitcnt vmcnt(0)" ::: "memory");
        } else {
            XB_SPIN(xb_ld(&bar[XB_XGEN(bx)]) == gen, bar);
            __builtin_amdgcn_fence(__ATOMIC_ACQUIRE, "agent");
            asm volatile("s_waitcnt vmcnt(0)" ::: "memory");
        }
    }
    __syncthreads();
}

DI void transpose_item(const float* W, int N, int k0, int n0, bf16* WT, int Kt, int drow0, LAS float* scr, int lane) {
#pragma unroll 8
    for (int i = 0; i < 32; ++i) { const int kk = 2 * i + (lane >> 5); scr[kk * 33 + (lane & 31)] = W[(size_t)(k0 + kk) * N + n0 + (lane & 31)]; }
    LDS_WAIT(); asm volatile("" ::: "memory");
    const int c = lane & 7;
#pragma unroll
    for (int j = 0; j < 4; ++j) { const int n = (lane >> 3) + 8 * j; const LAS float* s = scr + (8 * c) * 33 + n;
        v4u o; o.x = cvtpk(s[0 * 33], s[1 * 33]); o.y = cvtpk(s[2 * 33], s[3 * 33]); o.z = cvtpk(s[4 * 33], s[5 * 33]); o.w = cvtpk(s[6 * 33], s[7 * 33]);
        *(GAS v4u*)(WT + (size_t)(drow0 + n) * Kt + k0 + 8 * c) = o; }
    LDS_WAIT(); asm volatile("" ::: "memory");
}
template <int MODE>
DI void conv_matrix(const float* W, int K, int N, bf16* WT, int nrw, LAS float* scr, int gw, int NGW, int lane) {
    const int nblk = N / 32, nitems = (K / 64) * nblk;
    for (int it = gw; it < nitems; it += NGW) {
        const int kb = it / nblk, nb = it % nblk, n0 = nb * 32;
        int drow0;
        if (MODE == 0) drow0 = n0;
        else if (MODE == 1) drow0 = n0 < nrw ? n0 : NA + (n0 - nrw);
        else if (MODE == 2) drow0 = (n0 >> 7) * 256 + (n0 & 127);
        else drow0 = (n0 >> 7) * 256 + 128 + (n0 & 127);
        transpose_item(W, N, kb * 64, n0, WT, K, drow0, scr, lane);
    }
}
DI void zero_rows(bf16* WT, int Kt, int r0, int r1, int gw, int NGW, int lane) {
    const int per = Kt / 8;
    const long total = (long)(r1 - r0) * per;
    for (long i = (long)gw * 64 + lane; i < total; i += (long)NGW * 64) *(GAS v4u*)(WT + (size_t)r0 * Kt + i * 8) = (v4u){0u, 0u, 0u, 0u};
}

DI float dot4(f32x4 a) { return (a.x * a.x + a.y * a.y) + (a.z * a.z + a.w * a.w); }
DI f32x4 ld_bf16x4(const bf16* p) { const v2u u = *(const GAS v2u*)p; return (f32x4){bflo(u.x), bfhi(u.x), bflo(u.y), bfhi(u.y)}; }
DI void st_bf16x4(bf16* p, f32x4 v) { v2u u; u.x = cvtpk(v.x, v.y); u.y = cvtpk(v.z, v.w); *(GAS v2u*)p = u; }

DI void phase_norm0(const float* x, const float* g, bf16* hn, int gw, int NGW, int lane) {
    f32x4 gv[4];
#pragma unroll
    for (int j = 0; j < 4; ++j) gv[j] = *(const f32x4*)(g + 4 * lane + 256 * j);
    for (int m = gw; m < M; m += NGW) {
        f32x4 v[4]; float s = 0.f;
#pragma unroll
        for (int j = 0; j < 4; ++j) { v[j] = *(const GAS f32x4*)(x + (size_t)m * D + 4 * lane + 256 * j); s += dot4(v[j]); }
        const float rs = rsqrtf(wave_sum(s, lane) * (1.f / D) + NORM_EPS);
#pragma unroll
        for (int j = 0; j < 4; ++j) st_bf16x4(hn + (size_t)m * D + 4 * lane + 256 * j, v[j] * rs * gv[j]);
    }
}
template <bool MOEF>
DI void phase_resnorm(const float* xin, const bf16* y, const unsigned* pos, const float* g1, const float* g2, float* xout, bf16* hn,
                      const float* rt, unsigned* sel, float* gts, unsigned* totals, int gw, int NGW, int lane) {
    f32x4 g1v[4], g2v[4];
#pragma unroll
    for (int j = 0; j < 4; ++j) { g1v[j] = *(const f32x4*)(g1 + 4 * lane + 256 * j); g2v[j] = g2 ? *(const f32x4*)(g2 + 4 * lane + 256 * j) : (f32x4){0.f, 0.f, 0.f, 0.f}; }
    unsigned mycnt = 0;
    for (int m = gw; m < M; m += NGW) {
        f32x4 v[4], yv[4]; float s = 0.f;
        if (MOEF) {
            const unsigned p0 = __hip_atomic_load(pos + 2 * m, RLX_AGENT), p1 = __hip_atomic_load(pos + 2 * m + 1, RLX_AGENT);
#pragma unroll
            for (int j = 0; j < 4; ++j) yv[j] = ld_bf16x4(y + (size_t)p0 * D + 4 * lane + 256 * j) + ld_bf16x4(y + (size_t)p1 * D + 4 * lane + 256 * j);
        } else {
#pragma unroll
            for (int j = 0; j < 4; ++j) yv[j] = ld_bf16x4(y + (size_t)m * D + 4 * lane + 256 * j);
        }
#pragma unroll
        for (int j = 0; j < 4; ++j) { v[j] = *(const GAS f32x4*)(xin + (size_t)m * D + 4 * lane + 256 * j); s += dot4(yv[j]); }
        const float rsy = rsqrtf(wave_sum(s, lane) * (1.f / D) + NORM_EPS);
        float s2 = 0.f;
#pragma unroll
        for (int j = 0; j < 4; ++j) { v[j] = v[j] + yv[j] * rsy * g1v[j]; s2 += dot4(v[j]); *(GAS f32x4*)(xout + (size_t)m * D + 4 * lane + 256 * j) = v[j]; }
        if (g2) {
            const float rsx = rsqrtf(wave_sum(s2, lane) * (1.f / D) + NORM_EPS);
#pragma unroll
            for (int j = 0; j < 4; ++j) { v[j] = v[j] * rsx * g2v[j]; st_bf16x4(hn + (size_t)m * D + 4 * lane + 256 * j, v[j]); }
            if (rt) {
                float pe[8];
#pragma unroll
                for (int e = 0; e < 8; ++e) pe[e] = 0.f;
#pragma unroll
                for (int j = 0; j < 4; ++j)
#pragma unroll
                    for (int i = 0; i < 4; ++i) { const float hv = v[j][i]; const float* rp = rt + (size_t)(4 * lane + 256 * j + i) * 8;
                        const f32x4 ra = *(const f32x4*)rp, rb = *(const f32x4*)(rp + 4);
                        pe[0] += hv * ra.x; pe[1] += hv * ra.y; pe[2] += hv * ra.z; pe[3] += hv * ra.w; pe[4] += hv * rb.x; pe[5] += hv * rb.y; pe[6] += hv * rb.z; pe[7] += hv * rb.w; }
                float v0 = -3.0e38f, v1 = -3.0e38f; int e0 = 0, e1 = 0;
#pragma unroll
                for (int e = 0; e < 8; ++e) { const float lg = wave_sum(pe[e], lane); if (lg > v0) { v1 = v0; e1 = e0; v0 = lg; e0 = e; } else if (lg > v1) { v1 = lg; e1 = e; } }
                const float ga = 1.0f / (1.0f + __expf(v1 - v0)), gb = 1.0f - ga;
                if (lane == 0) { sel[m] = (unsigned)e0 | ((unsigned)e1 << 8); gts[2 * m] = ga; gts[2 * m + 1] = gb; }
                if (lane == e0 || lane == e1) ++mycnt;
            }
        }
    }
    if (rt && lane < 8 && mycnt) __hip_atomic_fetch_add(totals + 64 * lane, mycnt, RLX_AGENT);
}

DI int moe_offsets(unsigned* totals, int lane, int& mytot) {
    int off = 0; mytot = 0;
#pragma unroll
    for (int e = 0; e < 8; ++e) { const int t = (int)__hip_atomic_load(totals + 64 * e, RLX_AGENT); if (e < lane) off += (t + 255) & ~255; if (e == lane) mytot = t; }
    return off;
}

DI void phase_moe_sort(const unsigned* sel, const float* gts, unsigned* totals, unsigned* cursor, unsigned* pos, float* gsort, const bf16* hn, bf16* hs, int gw, int NGW, int lane) {
    int mytot; const int myoff = moe_offsets(totals, lane, mytot);
    unsigned mycnt = 0;
    for (int m = gw; m < M; m += NGW) { const unsigned s = __hip_atomic_load(sel + m, RLX_AGENT); const int e0 = s & 255, e1 = (s >> 8) & 255; if (lane == e0 || lane == e1) ++mycnt; }
    unsigned mybase = 0;
    if (lane < 8 && mycnt) mybase = __hip_atomic_fetch_add(cursor + 64 * lane, mycnt, RLX_AGENT);
    unsigned mypos = (unsigned)myoff + mybase;
    for (int m = gw; m < M; m += NGW) {
        const unsigned s = __hip_atomic_load(sel + m, RLX_AGENT); const int e0 = s & 255, e1 = (s >> 8) & 255;
        const unsigned p0 = (unsigned)shi((int)mypos, e0), p1 = (unsigned)shi((int)mypos, e1);
        if (lane == e0 || lane == e1) ++mypos;
        if (lane == 0) { pos[2 * m] = p0; pos[2 * m + 1] = p1; gsort[p0] = __hip_atomic_load(gts + 2 * m, RLX_AGENT); gsort[p1] = __hip_atomic_load(gts + 2 * m + 1, RLX_AGENT); }
        const v4u a = *(const GAS v4u*)(hn + (size_t)m * D + 8 * lane), b = *(const GAS v4u*)(hn + (size_t)m * D + 512 + 8 * lane);
        *(GAS v4u*)(hs + (size_t)p0 * D + 8 * lane) = a; *(GAS v4u*)(hs + (size_t)p0 * D + 512 + 8 * lane) = b;
        *(GAS v4u*)(hs + (size_t)p1 * D + 8 * lane) = a; *(GAS v4u*)(hs + (size_t)p1 * D + 512 + 8 * lane) = b;
    }
#pragma unroll 1
    for (int e = 0; e < 8; ++e) {
        const int r0 = shi(myoff + mytot, e), r1 = shi(myoff + ((mytot + 255) & ~255), e);
        for (int r = r0 + gw; r < r1; r += NGW) { *(GAS v4u*)(hs + (size_t)r * D + 8 * lane) = (v4u){0u, 0u, 0u, 0u}; *(GAS v4u*)(hs + (size_t)r * D + 512 + 8 * lane) = (v4u){0u, 0u, 0u, 0u}; if (lane == 0) gsort[r] = 0.f; }
    }
}
constexpr int SB_VP = 40;
DI void sb_wave(const bf16* PB, bf16* ymix, const float* sb_g, int b, int h, int q0, LAS unsigned char* vtb, int lane) {
    const int qi = lane & 31, hh = lane >> 5;
    LAS bf16* vt = (LAS bf16*)vtb;
    const size_t rowb = (size_t)b * SEQ;
    bf16x8 qf[4];
#pragma unroll
    for (int s = 0; s < 4; ++s) qf[s] = *(const GAS bf16x8*)(PB + (rowb + q0 + qi) * NPB + h * 64 + 16 * s + 8 * hh);
    f32x16 o0, o1;
#pragma unroll
    for (int r = 0; r < 16; ++r) { o0[r] = 0.f; o1[r] = 0.f; }
    float carry = 0.f;
    const int q = q0 + qi;
#pragma unroll 1
    for (int kt = q0 / 32; kt >= 0; --kt) {
        const int kb = kt * 32;
        bf16x8 kf[4], vv[4];
#pragma unroll
        for (int s = 0; s < 4; ++s) kf[s] = *(const GAS bf16x8*)(PB + (rowb + kb + qi) * NPB + 512 + h * 64 + 16 * s + 8 * hh);
#pragma unroll
        for (int i = 0; i < 4; ++i) vv[i] = *(const GAS bf16x8*)(PB + (rowb + kb + qi) * NPB + 1024 + h * 64 + 32 * hh + 8 * i);
#pragma unroll
        for (int i = 0; i < 4; ++i)
#pragma unroll
            for (int e = 0; e < 8; ++e) vt[(32 * hh + 8 * i + e) * SB_VP + qi] = (bf16)vv[i][e];
        f32x16 sc;
#pragma unroll
        for (int r = 0; r < 16; ++r) sc[r] = 0.f;
#pragma unroll
        for (int s = 0; s < 4; ++s) sc = MFMA32(kf[s], qf[s], sc);
        float c[16], ls[16];
        const bool diag = (kb == q0);
#pragma unroll
        for (int r = 0; r < 16; ++r) {
            const float z = sc[r] * 0.125f;
            const float sp = fmaxf(z, 0.f) + __logf(1.0f + __expf(-fabsf(z)));
            const bool valid = !diag || (kb + crow(r, hh) < q);
            c[r] = valid ? -sp : 0.f;
            ls[r] = valid ? z - sp : -1.0e30f;
        }
        float G[4], PG[4];
#pragma unroll
        for (int g = 0; g < 4; ++g) { G[g] = (c[4 * g] + c[4 * g + 1]) + (c[4 * g + 2] + c[4 * g + 3]); PG[g] = shx(G[g], 32, lane); }
        float att[16];
        float after = carry;
#pragma unroll
        for (int g = 3; g >= 0; --g) {
            float sfx = after + (hh == 0 ? PG[g] : 0.f);
#pragma unroll
            for (int i = 3; i >= 0; --i) { att[4 * g + i] = __expf(ls[4 * g + i] + sfx); sfx += c[4 * g + i]; }
            after += G[g] + PG[g];
        }
        carry = after;
        bf16x8 pf[2];
#pragma unroll
        for (int s = 0; s < 2; ++s) { v4u p; p.x = cvtpk(att[8 * s], att[8 * s + 1]); p.y = cvtpk(att[8 * s + 2], att[8 * s + 3]); p.z = cvtpk(att[8 * s + 4], att[8 * s + 5]); p.w = cvtpk(att[8 * s + 6], att[8 * s + 7]); pf[s] = __builtin_bit_cast(bf16x8, p); }
        LDS_WAIT();
#pragma unroll
        for (int s = 0; s < 2; ++s) {
            const s16x4 a0 = *(const LAS s16x4*)(vt + qi * SB_VP + 16 * s + 4 * hh), a1 = *(const LAS s16x4*)(vt + qi * SB_VP + 16 * s + 8 + 4 * hh);
            const s16x4 b0 = *(const LAS s16x4*)(vt + (32 + qi) * SB_VP + 16 * s + 4 * hh), b1 = *(const LAS s16x4*)(vt + (32 + qi) * SB_VP + 16 * s + 8 + 4 * hh);
            const bf16x8 va = __builtin_shufflevector(a0, a1, 0, 1, 2, 3, 4, 5, 6, 7), vb = __builtin_shufflevector(b0, b1, 0, 1, 2, 3, 4, 5, 6, 7);
            o0 = MFMA32(va, pf[s], o0);
            o1 = MFMA32(vb, pf[s], o1);
        }
        LDS_WAIT();
        if (__all(carry < SB_EXIT)) break;
    }
    float ss = 0.f;
#pragma unroll
    for (int r = 0; r < 16; ++r) ss += o0[r] * o0[r] + o1[r] * o1[r];
    ss += shx(ss, 32, lane);
    const float scl = rsqrtf(ss * (1.f / 64.f) + NORM_EPS);
    bf16* orow = ymix + (rowb + q) * D + 512 + h * 64;
#pragma unroll
    for (int g = 0; g < 4; ++g) {
        const int d0 = 8 * g + 4 * hh;
        const f32x4 g0 = *(const f32x4*)(sb_g + h * 64 + d0), g1 = *(const f32x4*)(sb_g + h * 64 + 32 + d0);
        v2u w0, w1;
        w0.x = cvtpk(o0[4 * g] * scl * g0.x, o0[4 * g + 1] * scl * g0.y); w0.y = cvtpk(o0[4 * g + 2] * scl * g0.z, o0[4 * g + 3] * scl * g0.w);
        w1.x = cvtpk(o1[4 * g] * scl * g1.x, o1[4 * g + 1] * scl * g1.y); w1.y = cvtpk(o1[4 * g + 2] * scl * g1.z, o1[4 * g + 3] * scl * g1.w);
        *(GAS v2u*)(orow + d0) = w0; *(GAS v2u*)(orow + 32 + d0) = w1;
    }
}
constexpr int RW_L = 32, RW_NCH = SEQ / RW_L;
constexpr size_t RW_UNITS = (size_t)NBATCH * NH * RW_NCH;
struct RwkvC {
    const bf16* PA; const float* mu; const float *decay0, *iclr0, *vres0, *k_k, *k_a, *r_k, *lnx_g, *lnx_b;
    const bf16* upT;
    unsigned* VFf;
    bf16* ZH; bf16* RH;
    unsigned* BF;
    unsigned* U0F; unsigned* YF;
    unsigned* GTF;
    unsigned* GF;
    float* PLF;
    float* BON;
    bf16* ymix;
    int has_vres;
};
DI bf16x8 pk8(const f32x16& x, int s) { v4u p; p.x = cvtpk(x[8 * s], x[8 * s + 1]); p.y = cvtpk(x[8 * s + 2], x[8 * s + 3]); p.z = cvtpk(x[8 * s + 4], x[8 * s + 5]); p.w = cvtpk(x[8 * s + 6], x[8 * s + 7]); return __builtin_bit_cast(bf16x8, p); }
DI void st_frag(unsigned* p, const f32x16& x) {
    v4u a, b; a.x = cvtpk(x[0], x[1]); a.y = cvtpk(x[2], x[3]); a.z = cvtpk(x[4], x[5]); a.w = cvtpk(x[6], x[7]);
    b.x = cvtpk(x[8], x[9]); b.y = cvtpk(x[10], x[11]); b.z = cvtpk(x[12], x[13]); b.w = cvtpk(x[14], x[15]);
    *(GAS v4u*)p = a; *(GAS v4u*)(p + 4) = b;
}
DI f32x16 ld_frag(const unsigned* p) {
    const v4u a = *(const GAS v4u*)p, b = *(const GAS v4u*)(p + 4); f32x16 x;
    x[0] = bflo(a.x); x[1] = bfhi(a.x); x[2] = bflo(a.y); x[3] = bfhi(a.y); x[4] = bflo(a.z); x[5] = bfhi(a.z); x[6] = bflo(a.w); x[7] = bfhi(a.w);
    x[8] = bflo(b.x); x[9] = bfhi(b.x); x[10] = bflo(b.y); x[11] = bfhi(b.y); x[12] = bflo(b.z); x[13] = bfhi(b.z); x[14] = bflo(b.w); x[15] = bfhi(b.w);
    return x;
}
DI f32x16 zero16() { f32x16 z;
#pragma unroll
    for (int i = 0; i < 16; ++i) z[i] = 0.f;
    return z; }
DI float half_sum(float v, int lane) {
#pragma unroll
    for (int o = 1; o < 32; o <<= 1) v += shx(v, o, lane);
    return v;
}
constexpr int RW_SP = 72;
DI void stage_n(LAS bf16* img, const f32x16& x0, const f32x16& x1, int cl, int hi) {
#pragma unroll
    for (int r = 0; r < 16; ++r) { img[crow(r, hi) * RW_SP + cl] = f2bf(x0[r]); img[crow(r, hi) * RW_SP + 32 + cl] = f2bf(x1[r]); }
}
DI bf16x8 frag_nat(const LAS bf16* img, int pitch, int row, int S, int hh) { return *(const LAS bf16x8*)(img + row * pitch + 16 * S + 8 * hh); }
DI bf16x8 frag_perm(const LAS bf16* img, int pitch, int row, int S, int hh) {
    const s16x4 a = *(const LAS s16x4*)(img + row * pitch + 16 * S + 4 * hh), b = *(const LAS s16x4*)(img + row * pitch + 16 * S + 8 + 4 * hh);
    return __builtin_shufflevector(a, b, 0, 1, 2, 3, 4, 5, 6, 7);
}

constexpr int RW_WAVE_LDS = 19456;
DI unsigned pk2f(float a, float b) { return cvtpk(a, b); }
DI bf16x8 pkq(const unsigned (&p)[8], int s) { v4u q; q.x = p[4 * s]; q.y = p[4 * s + 1]; q.z = p[4 * s + 2]; q.w = p[4 * s + 3]; return __builtin_bit_cast(bf16x8, q); }
DI void rwkv_pre_unit(const RwkvC& P, int b, int h, int ch, LAS unsigned char* lw_, int lane) {
    const int cl = lane & 31, hi = lane >> 5;
    const unsigned unit = (unsigned)((b * NH + h) * RW_NCH + ch);
    const unsigned row0 = (unsigned)(b * SEQ + ch * RW_L);
    LAS bf16* Ri = (LAS bf16*)lw_; LAS bf16* Bi = (LAS bf16*)(lw_ + 4608); LAS bf16* Ki = (LAS bf16*)(lw_ + 9216); LAS bf16* Zi = (LAS bf16*)(lw_ + 13824);
    LAS float* Af = (LAS float*)lw_;
    LAS bf16* Tn = (LAS bf16*)lw_; LAS bf16* Tt = (LAS bf16*)(lw_ + 2048);
    LAS bf16* BmL = (LAS bf16*)(lw_ + 4096); LAS bf16* AbL = (LAS bf16*)(lw_ + 6144); LAS bf16* AkL = (LAS bf16*)(lw_ + 8192);
    const bf16* upT = P.upT + (size_t)h * 12288;
    const unsigned rowt = row0 + cl; const bool first_tok = (ch == 0 && cl == 0);
    bf16x8 smw[2], sma[2], smv[2];
    {
        bf16x8 smg[6];
        const bf16* pr = P.PA + rowt * NA + 1536 + 8 * hi; const bf16* pp = pr - NA;
#pragma unroll
        for (int s = 0; s < 12; ++s) {
            if (s >= 10 && !P.has_vres) { smv[s - 10] = (bf16x8){0, 0, 0, 0, 0, 0, 0, 0}; continue; }
            const v4u cu = *(const GAS v4u*)(pr + 16 * s); v4u pv = (v4u){0u, 0u, 0u, 0u};
            if (!first_tok) pv = *(const GAS v4u*)(pp + 16 * s);
            const f32x4 m0 = *(const f32x4*)(P.mu + 1536 + 16 * s + 8 * hi), m1 = *(const f32x4*)(P.mu + 1536 + 16 * s + 8 * hi + 4);
            float xs[8];
            xs[0] = bflo(cu.x) + m0.x * (bflo(pv.x) - bflo(cu.x)); xs[1] = bfhi(cu.x) + m0.y * (bfhi(pv.x) - bfhi(cu.x));
            xs[2] = bflo(cu.y) + m0.z * (bflo(pv.y) - bflo(cu.y)); xs[3] = bfhi(cu.y) + m0.w * (bfhi(pv.y) - bfhi(cu.y));
            xs[4] = bflo(cu.z) + m1.x * (bflo(pv.z) - bflo(cu.z)); xs[5] = bfhi(cu.z) + m1.y * (bfhi(pv.z) - bfhi(cu.z));
            xs[6] = bflo(cu.w) + m1.z * (bflo(pv.w) - bflo(cu.w)); xs[7] = bfhi(cu.w) + m1.w * (bfhi(pv.w) - bfhi(cu.w));
            if (s < 2) {
#pragma unroll
                for (int j = 0; j < 8; ++j) { const float e = __expf(2.0f * xs[j]); xs[j] = 1.0f - 2.0f * __builtin_amdgcn_rcpf(e + 1.0f); }
            } else if (s >= 4 && s < 10) {
#pragma unroll
                for (int j = 0; j < 8; ++j) xs[j] = sigmoidf_(xs[j]);
            }
            v4u p; p.x = cvtpk(xs[0], xs[1]); p.y = cvtpk(xs[2], xs[3]); p.z = cvtpk(xs[4], xs[5]); p.w = cvtpk(xs[6], xs[7]);
            asm volatile("" : "+v"(p) :: "memory");
            const bf16x8 f = __builtin_bit_cast(bf16x8, p);
            if (s < 2) smw[s] = f; else if (s < 4) sma[s - 2] = f; else if (s < 10) smg[s - 4] = f; else smv[s - 10] = f;
            if (s & 1) { asm volatile("" ::: "memory"); __builtin_amdgcn_sched_barrier(0); }
        }
#pragma unroll
        for (int ct = 0; ct < 2; ++ct) {
            f32x16 g = zero16();
#pragma unroll
            for (int s = 0; s < 6; ++s) { const bf16x8 wg = *(const GAS bf16x8*)(upT + 6144 + (32 * ct + cl) * 96 + 16 * s + 8 * hi); g = MFMA32(smg[s], wg, g); }
            st_frag(P.GTF + ((unit * 2 + ct) * 64 + lane) * 8, g);
        }
    }
    float rn[16];
    {
        float nn[16];
#pragma unroll
        for (int r = 0; r < 16; ++r) nn[r] = 0.f;
#pragma unroll
        for (int ct = 0; ct < 2; ++ct) {
            const int hc = h * 64 + 32 * ct + cl; const float mk = P.mu[512 + hc], kkc = P.k_k[hc];
#pragma unroll
            for (int r = 0; r < 16; ++r) { const int t = crow(r, hi); const bf16* pr = P.PA + (row0 + t) * NA + 512 + hc; const float kc = bf2f(pr[0]); const float kp = (ch == 0 && t == 0) ? 0.f : bf2f(pr[-NA]);
                const float kq = (kc + mk * (kp - kc)) * kkc; nn[r] += kq * kq; if ((r & 3) == 3) asm volatile("" : "+v"(nn[r]), "+v"(nn[r - 1]), "+v"(nn[r - 2]), "+v"(nn[r - 3]) :: "memory"); }
        }
#pragma unroll
        for (int r = 0; r < 16; ++r) rn[r] = rsqrtf(fmaxf(half_sum(nn[r], lane), 1e-12f));
    }
    unsigned Khp0[8];
    float bon[16];
#pragma unroll
    for (int r = 0; r < 16; ++r) bon[r] = 0.f;
#pragma unroll
    for (int ct = 0; ct < 2; ++ct) {
        const int hc = h * 64 + 32 * ct + cl;
        f32x16 lwv, av;
        {
            f32x16 d = zero16(), ic = zero16();
#pragma unroll
            for (int s = 0; s < 2; ++s) {
                const bf16x8 wd = *(const GAS bf16x8*)(upT + (32 * ct + cl) * 32 + 16 * s + 8 * hi);
                const bf16x8 wi = *(const GAS bf16x8*)(upT + 2048 + (32 * ct + cl) * 32 + 16 * s + 8 * hi);
                d = MFMA32(smw[s], wd, d); ic = MFMA32(sma[s], wi, ic);
            }
            const float d0 = P.decay0[hc], i0 = P.iclr0[hc];
#pragma unroll
            for (int r = 0; r < 16; ++r) { lwv[r] = -DECAY_SCALE * sigmoidf_(d[r] + d0); av[r] = sigmoidf_(ic[r] + i0); }
        }
        f32x16 cum; float cumL;
        {
            float Gs[4], PGs[4];
#pragma unroll
            for (int g = 0; g < 4; ++g) { Gs[g] = (lwv[4 * g] + lwv[4 * g + 1]) + (lwv[4 * g + 2] + lwv[4 * g + 3]); PGs[g] = shx(Gs[g], 32, lane); }
            float before = 0.f;
#pragma unroll
            for (int g = 0; g < 4; ++g) {
                float run = before + (hi ? PGs[g] : 0.f);
#pragma unroll
                for (int i = 0; i < 4; ++i) { run += lwv[4 * g + i]; cum[4 * g + i] = run; }
                before += Gs[g] + PGs[g];
            }
            cumL = before;
        }
        if (hi == ct) P.PLF[unit * 64 + 32 * ct + cl] = __expf(cumL);
        f32x16 rv, kv, vv;
        {
            const float mr = P.mu[hc], mk = P.mu[512 + hc], mv = P.mu[1024 + hc];
#pragma unroll
            for (int r = 0; r < 16; ++r) {
                const int t = crow(r, hi); const bf16* pr = P.PA + (row0 + t) * NA + hc; const bool ft = (ch == 0 && t == 0);
                const float rc = bf2f(pr[0]), kc = bf2f(pr[512]), vc = bf2f(pr[1024]);
                const float rp = ft ? 0.f : bf2f(pr[-NA]), kp = ft ? 0.f : bf2f(pr[512 - NA]), vp = ft ? 0.f : bf2f(pr[1024 - NA]);
                rv[r] = rc + mr * (rp - rc); kv[r] = kc + mk * (kp - kc); vv[r] = vc + mv * (vp - vc);
                if ((r & 3) == 3) asm volatile("" : "+v"(rv[r]), "+v"(kv[r]), "+v"(vv[r]), "+v"(rv[r - 1]), "+v"(kv[r - 1]), "+v"(vv[r - 1]), "+v"(rv[r - 2]), "+v"(kv[r - 2]), "+v"(vv[r - 2]), "+v"(rv[r - 3]), "+v"(kv[r - 3]), "+v"(vv[r - 3]) :: "memory");
            }
        }
        if (P.has_vres) {
            f32x16 vp = zero16();
#pragma unroll
            for (int s = 0; s < 2; ++s) { const bf16x8 wv = *(const GAS bf16x8*)(upT + 4096 + (32 * ct + cl) * 32 + 16 * s + 8 * hi); vp = MFMA32(smv[s], wv, vp); }
            const float v0 = P.vres0[hc];
            const f32x16 vf = ld_frag(P.VFf + ((unit * 2 + ct) * 64 + lane) * 8);
#pragma unroll
            for (int r = 0; r < 16; ++r) vv[r] = vv[r] + (vf[r] - vv[r]) * sigmoidf_(vp[r] + v0);
        }
        st_frag(P.VFf + ((unit * 2 + ct) * 64 + lane) * 8, vv);
        const float kkc = P.k_k[hc], kac = P.k_a[hc], rkc = P.r_k[hc];
        f32x16 Bh;
#pragma unroll
        for (int r = 0; r < 16; ++r) {
            const int t = crow(r, hi);
            const float kk = kv[r] * kkc * rn[r];
            const float km = kv[r] * (1.0f + (av[r] - 1.0f) * kac);
            bon[r] += rv[r] * km * rkc;
            const float c = cum[r], e1 = __expf(c), e2 = __expf(c - lwv[r]), e3 = __expf(-c), e4 = __expf(cumL - c);
            const float bb = kk * av[r];
            const float zt = -kk * e2;
            Zi[t * RW_SP + 32 * ct + cl] = f2bf(zt); Ri[t * RW_SP + 32 * ct + cl] = f2bf(rv[r] * e1); Bi[t * RW_SP + 32 * ct + cl] = f2bf(bb * e3); Ki[t * RW_SP + 32 * ct + cl] = f2bf(km * e3);
            Bh[r] = bb * e4;
            kv[r] = km * e4;
        }
        st_frag(P.BF + ((unit * 2 + ct) * 64 + lane) * 8, Bh);
        unsigned Khc[8], vvc[8];
#pragma unroll
        for (int q = 0; q < 8; ++q) { Khc[q] = pk2f(kv[2 * q], kv[2 * q + 1]); vvc[q] = pk2f(vv[2 * q], vv[2 * q + 1]); }
        if (ct == 0) {
#pragma unroll
            for (int q = 0; q < 8; ++q) Khp0[q] = Khc[q];
            f32x16 g = zero16();
            g = MFMA32(pkq(Khc, 0), pkq(vvc, 0), g); g = MFMA32(pkq(Khc, 1), pkq(vvc, 1), g);
            st_frag(P.GF + (((unit * 2 + 0) * 2 + 0) * 64 + lane) * 8, g);
        } else {
            unsigned vv0[8];
            { const v4u a = *(const GAS v4u*)(P.VFf + ((unit * 2 + 0) * 64 + lane) * 8), b2 = *(const GAS v4u*)(P.VFf + ((unit * 2 + 0) * 64 + lane) * 8 + 4);
              vv0[0] = a.x; vv0[1] = a.y; vv0[2] = a.z; vv0[3] = a.w; vv0[4] = b2.x; vv0[5] = b2.y; vv0[6] = b2.z; vv0[7] = b2.w; }
            f32x16 g01 = zero16(), g10 = zero16(), g11 = zero16();
#pragma unroll
            for (int s2 = 0; s2 < 2; ++s2) { g01 = MFMA32(pkq(Khp0, s2), pkq(vvc, s2), g01); g10 = MFMA32(pkq(Khc, s2), pkq(vv0, s2), g10); g11 = MFMA32(pkq(Khc, s2), pkq(vvc, s2), g11); }
            st_frag(P.GF + (((unit * 2 + 0) * 2 + 1) * 64 + lane) * 8, g01);
            st_frag(P.GF + (((unit * 2 + 1) * 2 + 0) * 64 + lane) * 8, g10);
            st_frag(P.GF + (((unit * 2 + 1) * 2 + 1) * 64 + lane) * 8, g11);
        }
        asm volatile("" ::: "memory"); __builtin_amdgcn_sched_barrier(0);
    }
#pragma unroll
    for (int r = 0; r < 16; ++r) { const float bo = half_sum(bon[r], lane); if (cl == 0) P.BON[(row0 + crow(r, hi)) * 8 + h] = bo; }
    LDS_WAIT();
    bf16x8 zf[4], rf[4], bfr[4], kf[4];
    unsigned rtT[16];
#pragma unroll
    for (int S = 0; S < 4; ++S) { zf[S] = frag_nat(Zi, RW_SP, cl, S, hi); rf[S] = frag_nat(Ri, RW_SP, cl, S, hi); bfr[S] = frag_nat(Bi, RW_SP, cl, S, hi); kf[S] = frag_nat(Ki, RW_SP, cl, S, hi); }
#pragma unroll
    for (int ct = 0; ct < 2; ++ct)
#pragma unroll
        for (int g = 0; g < 4; ++g) { const v2u w = *(const LAS v2u*)(Ri + cl * RW_SP + 32 * ct + 8 * g + 4 * hi); rtT[ct * 8 + g * 2] = w.x; rtT[ct * 8 + g * 2 + 1] = w.y; }
    LDS_WAIT();
    {
        f32x16 Aa = zero16(), Bm = zero16(), Ab = zero16(), Ak = zero16();
#pragma unroll
        for (int S = 0; S < 4; ++S) { Aa = MFMA32(zf[S], bfr[S], Aa); Bm = MFMA32(zf[S], kf[S], Bm); Ab = MFMA32(rf[S], bfr[S], Ab); Ak = MFMA32(rf[S], kf[S], Ak); }
#pragma unroll
        for (int r = 0; r < 16; ++r) {
            const int t = crow(r, hi); const bool lo = cl < t, le = cl <= t;
            Af[t * 32 + cl] = lo ? Aa[r] : 0.f;
            BmL[t * 32 + cl] = f2bf(lo ? Bm[r] : 0.f); AbL[t * 32 + cl] = f2bf(le ? Ab[r] : 0.f); AkL[t * 32 + cl] = f2bf(le ? Ak[r] : 0.f);
        }
    }
    LDS_WAIT();
    {
        float tc[32];
#pragma unroll
        for (int t = 0; t < 32; ++t) {
            float acc = (t == cl) ? 1.0f : 0.f;
#pragma unroll
            for (int s4 = 0; s4 < t; s4 += 4) {
                const f32x4 a4 = *(const LAS f32x4*)(Af + t * 32 + s4);
                acc += a4.x * tc[s4];
                if (s4 + 1 < t) acc += a4.y * tc[s4 + 1];
                if (s4 + 2 < t) acc += a4.z * tc[s4 + 2];
                if (s4 + 3 < t) acc += a4.w * tc[s4 + 3];
            }
            asm volatile("" : "+v"(acc) :: "memory");
            tc[t] = acc;
        }
        LDS_WAIT();
#pragma unroll
        for (int t = 0; t < 32; ++t) if (hi == 0) Tn[t * 32 + cl] = f2bf(tc[t]);
        if (hi == 0) {
#pragma unroll
            for (int q = 0; q < 4; ++q) { v4u p; p.x = cvtpk(tc[8 * q], tc[8 * q + 1]); p.y = cvtpk(tc[8 * q + 2], tc[8 * q + 3]); p.z = cvtpk(tc[8 * q + 4], tc[8 * q + 5]); p.w = cvtpk(tc[8 * q + 6], tc[8 * q + 7]); *(LAS v4u*)(Tt + cl * 32 + 8 * q) = p; }
        }
    }
    LDS_WAIT();
    bf16x8 tp[2];
    {
        bf16x8 bmp[2], abp[2], akp[2];
#pragma unroll
        for (int s = 0; s < 2; ++s) { bmp[s] = frag_perm(BmL, 32, cl, s, hi); tp[s] = frag_perm(Tn, 32, cl, s, hi); abp[s] = frag_perm(AbL, 32, cl, s, hi); akp[s] = frag_perm(AkL, 32, cl, s, hi); }
#pragma unroll
        for (int vt = 0; vt < 2; ++vt) {
            unsigned vvq[8];
            { const v4u a = *(const GAS v4u*)(P.VFf + ((unit * 2 + vt) * 64 + lane) * 8), b2 = *(const GAS v4u*)(P.VFf + ((unit * 2 + vt) * 64 + lane) * 8 + 4);
              vvq[0] = a.x; vvq[1] = a.y; vvq[2] = a.z; vvq[3] = a.w; vvq[4] = b2.x; vvq[5] = b2.y; vvq[6] = b2.z; vvq[7] = b2.w; }
            f32x16 w0 = zero16(), u0 = zero16(), y0 = zero16();
#pragma unroll
            for (int s = 0; s < 2; ++s) w0 = MFMA32(bmp[s], pkq(vvq, s), w0);
#pragma unroll
            for (int s = 0; s < 2; ++s) u0 = MFMA32(tp[s], pk8(w0, s), u0);
#pragma unroll
            for (int s = 0; s < 2; ++s) { y0 = MFMA32(abp[s], pk8(u0, s), y0); y0 = MFMA32(akp[s], pkq(vvq, s), y0); }
            st_frag(P.U0F + ((unit * 2 + vt) * 64 + lane) * 8, u0);
            st_frag(P.YF + ((unit * 2 + vt) * 64 + lane) * 8, y0);
        }
    }
    f32x16 qT = zero16();
#pragma unroll
    for (int s = 0; s < 2; ++s) qT = MFMA32(frag_nat(Tt, 32, cl, s, hi), frag_nat(AbL, 32, cl, s, hi), qT);
    const bf16x8 qp0 = pk8(qT, 0), qp1 = pk8(qT, 1);
#pragma unroll
    for (int ct = 0; ct < 2; ++ct) {
        f32x16 zh = zero16(), rh;
#pragma unroll
        for (int r = 0; r < 16; ++r) { const unsigned w = rtT[ct * 8 + (r >> 1)]; rh[r] = (r & 1) ? bfhi(w) : bflo(w); }
        unsigned zq[8];
#pragma unroll
        for (int q = 0; q < 8; ++q) { const unsigned lo_ = Zi[crow(2 * q, hi) * RW_SP + 32 * ct + cl], hi_ = Zi[crow(2 * q + 1, hi) * RW_SP + 32 * ct + cl]; zq[q] = lo_ | (hi_ << 16); }
        zh = MFMA32(pkq(zq, 0), tp[0], zh); zh = MFMA32(pkq(zq, 1), tp[1], zh);
        rh = MFMA32(pkq(zq, 0), qp0, rh); rh = MFMA32(pkq(zq, 1), qp1, rh);
        bf16* zrow = P.ZH + (unit * 32 + cl) * 64; bf16* rrow = P.RH + (unit * 32 + cl) * 64;
#pragma unroll
        for (int g = 0; g < 4; ++g) {
            const int pos = 16 * (2 * ct + (g >> 1)) + 8 * hi + 4 * (g & 1);
            v2u a, c2; a.x = cvtpk(zh[4 * g], zh[4 * g + 1]); a.y = cvtpk(zh[4 * g + 2], zh[4 * g + 3]); c2.x = cvtpk(rh[4 * g], rh[4 * g + 1]); c2.y = cvtpk(rh[4 * g + 2], rh[4 * g + 3]);
            *(GAS v2u*)(zrow + pos) = a; *(GAS v2u*)(rrow + pos) = c2;
        }
    }
    LDS_WAIT();
}

DI void rwkv_scan_chain(const RwkvC& P, int b, int h, int vt, int lane) {
    const int cl = lane & 31, hi = lane >> 5;
    f32x16 st[2] = {zero16(), zero16()};
#pragma unroll 1
    for (int ch = 0; ch < RW_NCH; ++ch) {
        const unsigned unit = (unsigned)((b * NH + h) * RW_NCH + ch);
        const bf16* zrow = P.ZH + (unit * 32 + cl) * 64 + 8 * hi; const bf16* rrow = P.RH + (unit * 32 + cl) * 64 + 8 * hi;
        bf16x8 zh[4], rh[4], bt[2][2];
#pragma unroll
        for (int S = 0; S < 4; ++S) { zh[S] = *(const GAS bf16x8*)(zrow + 16 * S); rh[S] = *(const GAS bf16x8*)(rrow + 16 * S); }
#pragma unroll
        for (int ct = 0; ct < 2; ++ct)
#pragma unroll
            for (int s = 0; s < 2; ++s) bt[ct][s] = *(const GAS bf16x8*)(P.BF + ((unit * 2 + ct) * 64 + lane) * 8 + 4 * s);
        f32x16 U = ld_frag(P.U0F + ((unit * 2 + vt) * 64 + lane) * 8), Y = ld_frag(P.YF + ((unit * 2 + vt) * 64 + lane) * 8);
        f32x16 gg[2]; float pl[2][16];
#pragma unroll
        for (int ct = 0; ct < 2; ++ct) {
            gg[ct] = ld_frag(P.GF + (((unit * 2 + ct) * 2 + vt) * 64 + lane) * 8);
#pragma unroll
            for (int g = 0; g < 4; ++g) { const f32x4 p4 = *(const GAS f32x4*)(P.PLF + unit * 64 + 32 * ct + 8 * g + 4 * hi); pl[ct][4 * g] = p4.x; pl[ct][4 * g + 1] = p4.y; pl[ct][4 * g + 2] = p4.z; pl[ct][4 * g + 3] = p4.w; }
        }
#pragma unroll
        for (int ct = 0; ct < 2; ++ct)
#pragma unroll
            for (int s = 0; s < 2; ++s) { const bf16x8 sb = pk8(st[ct], s); U = MFMA32(zh[2 * ct + s], sb, U); Y = MFMA32(rh[2 * ct + s], sb, Y); }
        st_frag(P.YF + ((unit * 2 + vt) * 64 + lane) * 8, Y);
        const bf16x8 ub0 = pk8(U, 0), ub1 = pk8(U, 1);
#pragma unroll
        for (int ct = 0; ct < 2; ++ct) {
            f32x16 ns;
#pragma unroll
            for (int r = 0; r < 16; ++r) ns[r] = pl[ct][r] * st[ct][r] + gg[ct][r];
            ns = MFMA32(bt[ct][0], ub0, ns); ns = MFMA32(bt[ct][1], ub1, ns);
            st[ct] = ns;
        }
    }
}

DI void rwkv_post_unit(const RwkvC& P, int b, int h, int ch, LAS unsigned char* lw_, int lane) {
    const int cl = lane & 31, hi = lane >> 5;
    const unsigned unit = (unsigned)((b * NH + h) * RW_NCH + ch);
    const unsigned row0 = (unsigned)(b * SEQ + ch * RW_L);
    LAS bf16* X1 = (LAS bf16*)lw_;
    f32x16 y[2], gt[2], vv[2];
#pragma unroll
    for (int vt = 0; vt < 2; ++vt) { y[vt] = ld_frag(P.YF + ((unit * 2 + vt) * 64 + lane) * 8); gt[vt] = ld_frag(P.GTF + ((unit * 2 + vt) * 64 + lane) * 8); vv[vt] = ld_frag(P.VFf + ((unit * 2 + vt) * 64 + lane) * 8); }
    const float lg0 = P.lnx_g[h * 64 + cl], lg1 = P.lnx_g[h * 64 + 32 + cl], lb0 = P.lnx_b[h * 64 + cl], lb1 = P.lnx_b[h * 64 + 32 + cl];
    f32x16 o0, o1;
#pragma unroll
    for (int r = 0; r < 16; ++r) {
        const float mean = half_sum(y[0][r] + y[1][r], lane) * (1.f / 64.f);
        const float d0 = y[0][r] - mean, d1 = y[1][r] - mean;
        const float var = half_sum(d0 * d0 + d1 * d1, lane) * (1.f / 64.f);
        const float rs = rsqrtf(var + LNX_EPS);
        const float bo = P.BON[(row0 + crow(r, hi)) * 8 + h];
        o0[r] = (d0 * rs * lg0 + lb0 + bo * vv[0][r]) * gt[0][r];
        o1[r] = (d1 * rs * lg1 + lb1 + bo * vv[1][r]) * gt[1][r];
    }
    stage_n(X1, o0, o1, cl, hi); LDS_WAIT();
#pragma unroll
    for (int i = 0; i < 4; ++i) { const int pc = lane + 64 * i, t = pc >> 3, q = pc & 7;
        const v4u w = *(const LAS v4u*)(X1 + t * RW_SP + 8 * q);
        *(GAS v4u*)(P.ymix + (row0 + t) * D + h * 64 + 8 * q) = w; }
    LDS_WAIT();
}
constexpr int NPHASE = 28;
#ifndef MK_SINGLE
#define MK_SINGLE 1
#endif
struct Args { const float* in[46]; float* out; unsigned char* ws; int ph_lo, ph_hi; };

DI unsigned char* opq(unsigned char* p) { GAS unsigned char* g = (GAS unsigned char*)p; asm volatile("" : "+s"(g)); return (unsigned char*)g; }
DI int opqs(int v) { asm volatile("" : "+s"(v)); return v; }
DI int opqv(int v) { asm volatile("" : "+v"(v)); return v; }
DI const float* inp(int i) { typedef const GAS float* gfp; const __attribute__((address_space(4))) gfp* t = (const __attribute__((address_space(4))) gfp*)__builtin_amdgcn_kernarg_segment_ptr(); asm volatile("" : "+s"(t)); return (const float*)t[i]; }

__global__ void __launch_bounds__(NWAVES * 64, 2) fwd_kernel(Args args) {
    extern __shared__ __attribute__((aligned(16))) unsigned char lds_raw[];
    LAS unsigned char* lds = (LAS unsigned char*)lds_raw;
    volatile LAS unsigned* MISC = (volatile LAS unsigned*)(lds + MISC_OFF);
    const int wave0 = __builtin_amdgcn_readfirstlane((int)threadIdx.x >> 6);
    const int G0 = gridDim.x, blk0 = blockIdx.x;
#define PHV const int lane = opqv(lane_id()), blk = opqs(blk0), G = opqs(G0), wave = opqs(wave0), tid = wave * 64 + lane, gw = blk * NWAVES + wave, NGW = G * NWAVES; (void)tid; (void)lane; (void)gw; (void)NGW; (void)wave
    unsigned char* ws0 = args.ws;
#define ws opq(ws0)
#define ctl ((unsigned*)(ws + WS_CTL))
    for (int u = wave0 * 64 + lane_id(); u < (LDS_BYTES - MISC_OFF) / 4; u += NWAVES * 64) ((LAS unsigned*)(lds + MISC_OFF))[u] = 0u;
    __syncthreads();
#if MK_SINGLE
    constexpr int lo = 0, hi = NPHASE;
#else
    const int lo = args.ph_lo, hi = args.ph_hi;
#endif
    if (hi - lo > 1) (void)xcd_barrier_post(ctl + CW_BAR, MISC + 8, wave0 * 64 + lane_id());
#ifndef PHMASK
#define PHMASK 0xFFFFFFF
#endif
#define IN(k) (((PHMASK >> (k)) & 1) && lo <= (k) && (k) < hi)
#define SEAM(k) do { if (IN(k) && IN((k) + 1)) { XcdBarrier bb_; bb_.bar = ctl + CW_BAR; bb_.x = xb_xcc_id(); bb_.st = MISC + 8; xcd_barrier(bb_, opqs(wave0) * 64 + opqv(lane_id())); } } while (0)

#define B_HN ((bf16*)(ws + WS_HN))
#define B_YMIX ((bf16*)(ws + WS_YMIX))
#define B_VF ((bf16*)(ws + WS_VF))
#define B_PA ((bf16*)(ws + WS_PA))
#define B_PB ((bf16*)(ws + WS_PB))
#define B_Y ((bf16*)(ws + WS_Y))
    float* xo = args.out;
#define x_in inp(0)

    if (IN(0)) { PHV;
        LAS float* scr = (LAS float*)(lds + wave * 16384);
        conv_matrix<1>(inp(2), D, 3232, (bf16*)(ws + WS_WIN0), 1696, scr, gw, NGW, lane);
        conv_matrix<1>(inp(23), D, 3264, (bf16*)(ws + WS_WIN1), 1728, scr, gw, NGW, lane);
        zero_rows((bf16*)(ws + WS_WIN0), D, 1696, NA, gw, NGW, lane);
        zero_rows((bf16*)(ws + WS_WIN1), D, 1728, NA, gw, NGW, lane);
        conv_matrix<0>(inp(15), D, D, (bf16*)(ws + WS_WOUT0), 0, scr, gw, NGW, lane);
        conv_matrix<0>(inp(38), D, D, (bf16*)(ws + WS_WOUT1), 0, scr, gw, NGW, lane);
        conv_matrix<2>(inp(18), D, FF, (bf16*)(ws + WS_WGU0), 0, scr, gw, NGW, lane);
        conv_matrix<3>(inp(19), D, FF, (bf16*)(ws + WS_WGU0), 0, scr, gw, NGW, lane);
        conv_matrix<0>(inp(20), FF, D, (bf16*)(ws + WS_WDN0), 0, scr, gw, NGW, lane);
        phase_norm0(x_in, inp(1), B_HN, gw, NGW, lane);
        {
            bf16* upt = (bf16*)(ws + WS_UPT);
            for (int i = gw * 64 + lane; i < 2 * 8 * 12288; i += NGW * 64) {
                const int l2 = i / (8 * 12288), rem = i % (8 * 12288), hh = rem / 12288, e = rem % 12288;
                float val = 0.f;
                if (e < 2048) { const int c = e >> 5, k = e & 31; val = inp(l2 ? 26 : 5)[k * 512 + hh * 64 + c]; }
                else if (e < 4096) { const int c = (e - 2048) >> 5, k = e & 31; val = inp(l2 ? 28 : 7)[k * 512 + hh * 64 + c]; }
                else if (e < 6144) { const int c = (e - 4096) >> 5, k = e & 31; if (l2) val = inp(31)[k * 512 + hh * 64 + c]; }
                else { const int c = (e - 6144) / 96, k = (e - 6144) % 96; val = inp(l2 ? 29 : 8)[k * 512 + hh * 64 + c]; }
                upt[i] = f2bf(val);
            }
        }
    }
    SEAM(0);

#pragma unroll
    for (int l = 0; l < 2; ++l) {
        const int pb = l ? 10 : 1;
        if (IN(pb)) { PHV;
            pg8::Gemm g{B_HN, (const bf16*)(ws + (l ? WS_WIN1 : WS_WIN0)), M, NPROJ, D}; pg8::StaticOrder S; S.init(M, NPROJ, G, blk);
            pg8::EpiProj E{B_PA, B_PB};
            pg8::gemm_phase<pg8::EpiProj, pg8::StaticOrder, true, true>(lds, g, S, E, tid);
        }
        SEAM(pb);
#define RWKV_SETUP \
            RwkvC P; { const int o = l ? 21 : 0, o2 = l ? 23 : 0; unsigned char* w_ = ws; \
            P.PA = (const bf16*)(w_ + WS_PA); P.mu = inp(3 + o); P.decay0 = inp(4 + o); P.iclr0 = inp(6 + o); P.vres0 = inp(30); \
            P.k_k = inp(9 + o2); P.k_a = inp(10 + o2); P.r_k = inp(11 + o2); P.lnx_g = inp(12 + o2); P.lnx_b = inp(13 + o2); \
            P.upT = (const bf16*)(w_ + WS_UPT) + (size_t)l * 8 * 12288; P.VFf = (unsigned*)(w_ + WS_VF); P.ZH = (bf16*)(w_ + WS_ZH); P.RH = (bf16*)(w_ + WS_RH); \
            P.BF = (unsigned*)(w_ + WS_BF); P.U0F = (unsigned*)(w_ + WS_U0F); P.YF = (unsigned*)(w_ + WS_YF); P.GTF = (unsigned*)(w_ + WS_GTF); P.GF = (unsigned*)(w_ + WS_GF); \
            P.PLF = (float*)(w_ + WS_PLF); P.BON = (float*)(w_ + WS_BON); P.ymix = (bf16*)(w_ + WS_YMIX); P.has_vres = l; }
        if (IN(pb + 1)) { PHV;
            RWKV_SETUP
            for (int u = blk; u < NBATCH * RW_NCH; u += G) rwkv_pre_unit(P, u / RW_NCH, wave, u % RW_NCH, lds + wave * RW_WAVE_LDS, opqv(lane));
        }
        SEAM(pb + 1);
        if (IN(pb + 2)) { PHV;
            const bool split = G >= 128;
            if (!split || blk < 64) {
                if (wave == 0) { RWKV_SETUP
                    for (int cid = blk; cid < 64; cid += G) rwkv_scan_chain(P, cid >> 4, (cid >> 1) & 7, cid & 1, lane); }
            }
            if (!split || blk >= 64) {
                const float* sbg = inp(14 + (l ? 23 : 0));
                const int sbw = split ? G - 64 : G, sbi = split ? blk - 64 : blk;
                for (int u = sbi; u < NBATCH * NH * (SEQ / 256); u += sbw) {
                    const int qb = u & 31, bh = u >> 5;
                    sb_wave(B_PB, B_YMIX, sbg, bh >> 3, bh & 7, qb * 256 + wave * 32, lds + wave * 8192, opqv(lane));
                }
            }
        }
        SEAM(pb + 2);
        if (IN(pb + 3)) { PHV;
            RWKV_SETUP
            for (int u = blk; u < NBATCH * RW_NCH; u += G) rwkv_post_unit(P, u / RW_NCH, wave, u % RW_NCH, lds + wave * RW_WAVE_LDS, opqv(lane));
        }
        SEAM(pb + 3);
        if (IN(pb + 4)) { PHV;
            pg8::Gemm g{B_YMIX, (const bf16*)(ws + (l ? WS_WOUT1 : WS_WOUT0)), M, D, D}; pg8::StaticOrder S; S.init(M, D, G, blk);
            pg8::EpiBf16Plain E{B_Y, D};
            pg8::gemm_phase<pg8::EpiBf16Plain, pg8::StaticOrder, true, true>(lds, g, S, E, tid);
        }
        SEAM(pb + 4);
        if (IN(pb + 5)) { PHV;
            if (l == 0) phase_resnorm<false>(x_in, B_Y, nullptr, inp(16), inp(17), xo, (bf16*)(ws + WS_HNF0), nullptr, nullptr, nullptr, nullptr, gw, NGW, lane);
            else phase_resnorm<false>(xo, B_Y, nullptr, inp(39), inp(40), xo, (bf16*)(ws + WS_HNF1), inp(41), (unsigned*)(ws + WS_SEL), (float*)(ws + WS_GTS), ctl + CW_TOT, gw, NGW, lane);
        }
        SEAM(pb + 5);
    if (l == 0) {
        if (IN(7)) { PHV;
            pg8::Gemm g{(const bf16*)(ws + WS_HNF0), (const bf16*)(ws + WS_WGU0), M, 2 * FF, D}; pg8::StaticOrder S; S.init(M, 2 * FF, G, blk);
            pg8::EpiSwiglu E{(bf16*)(ws + WS_H0), FF, 0};
            pg8::gemm_phase<pg8::EpiSwiglu, pg8::StaticOrder, true, true>(lds, g, S, E, tid);
        }
        SEAM(7);
        if (IN(8)) { PHV;
            pg8::Gemm g{(const bf16*)(ws + WS_H0), (const bf16*)(ws + WS_WDN0), M, D, FF}; pg8::StaticOrder S; S.init(M, D, G, blk);
            pg8::EpiBf16Plain E{(bf16*)(ws + WS_F), D};
            pg8::gemm_phase<pg8::EpiBf16Plain, pg8::StaticOrder, true, true>(lds, g, S, E, tid);
        }
        SEAM(8);
        if (IN(9)) { PHV; phase_resnorm<false>(xo, (const bf16*)(ws + WS_F), nullptr, inp(21), inp(22), xo, B_HN, nullptr, nullptr, nullptr, nullptr, gw, NGW, lane); }
        SEAM(9);
    } else {
        if (IN(16)) { PHV;
            LAS float* scr = (LAS float*)(lds + wave * 16384);
#pragma unroll 1
            for (int e = 0; e < NE; ++e) {
                conv_matrix<2>(inp(42) + (size_t)e * D * FF, D, FF, (bf16*)(ws + WS_WMGU) + (size_t)e * 2 * FF * D, 0, scr, gw, NGW, lane);
                conv_matrix<3>(inp(43) + (size_t)e * D * FF, D, FF, (bf16*)(ws + WS_WMGU) + (size_t)e * 2 * FF * D, 0, scr, gw, NGW, lane);
                conv_matrix<0>(inp(44) + (size_t)e * D * FF, FF, D, (bf16*)(ws + WS_WMDN) + (size_t)e * D * FF, 0, scr, gw, NGW, lane);
            }
            phase_moe_sort((const unsigned*)(ws + WS_SEL), (const float*)(ws + WS_GTS), ctl + CW_TOT, ctl + CW_CUR, (unsigned*)(ws + WS_POS), (float*)(ws + WS_GSORT), (const bf16*)(ws + WS_HNF1), (bf16*)(ws + WS_HS), gw, NGW, lane);
        }
        SEAM(16);
#pragma unroll 1
        for (int p = 0; p < MOE_PARTS; ++p) {
            const int phg = 17 + 2 * p;
            if (IN(phg) || IN(phg + 1)) {
                PHV;
                int mytot; const int myoff = moe_offsets(ctl + CW_TOT, lane, mytot);
                pg8::MoeOrder S;
                const int nTiles = __builtin_amdgcn_readfirstlane(shi(myoff, 8)) >> 8;
                S.ts1 = __builtin_amdgcn_readfirstlane(shi(myoff, 1)) >> 8; S.ts2 = __builtin_amdgcn_readfirstlane(shi(myoff, 2)) >> 8; S.ts3 = __builtin_amdgcn_readfirstlane(shi(myoff, 3)) >> 8;
                S.ts4 = __builtin_amdgcn_readfirstlane(shi(myoff, 4)) >> 8; S.ts5 = __builtin_amdgcn_readfirstlane(shi(myoff, 5)) >> 8; S.ts6 = __builtin_amdgcn_readfirstlane(shi(myoff, 6)) >> 8;
                S.ts7 = __builtin_amdgcn_readfirstlane(shi(myoff, 7)) >> 8;
                const int t0 = p * MOE_PART_TILES; int nT = nTiles - t0; nT = nT < 0 ? 0 : (nT > MOE_PART_TILES ? MOE_PART_TILES : nT);
                S.t0 = t0; S.nT = nT; S.G = G; S.c = blk;
                if (IN(phg)) { PHV;
                    S.nN = 2 * FF / 256; S.nwg = nT * S.nN; S.nNe = 2 * FF / 256; S.arel = 0;
                    pg8::Gemm g{(const bf16*)(ws + WS_HS), (const bf16*)(ws + WS_WMGU), 0, 0, D};
                    pg8::EpiSwiglu E{(bf16*)(ws + WS_HP), FF, -(long)t0 * 256};
                    pg8::gemm_phase<pg8::EpiSwiglu, pg8::MoeOrder, true, true>(lds, g, S, E, tid);
                }
                SEAM(phg);
                if (IN(phg + 1)) { PHV;
                    S.nN = D / 256; S.nwg = nT * S.nN; S.nNe = D / 256; S.arel = 1;
                    pg8::Gemm g{(const bf16*)(ws + WS_HP), (const bf16*)(ws + WS_WMDN), 0, 0, FF};
                    pg8::EpiMoeDown E{(bf16*)(ws + WS_HS), D, (const float*)(ws + WS_GSORT)};
                    pg8::gemm_phase<pg8::EpiMoeDown, pg8::MoeOrder, true, true>(lds, g, S, E, tid);
                }
                SEAM(phg + 1);
            }
        }
        if (IN(27)) { PHV; phase_resnorm<true>(xo, (const bf16*)(ws + WS_HS), (const unsigned*)(ws + WS_POS), inp(45), nullptr, xo, nullptr, nullptr, nullptr, nullptr, nullptr, gw, NGW, lane); }
    }
    }
#undef IN
#undef SEAM
#undef x_in
#undef PHV
#undef ws
#undef ctl
#undef B_HN
#undef B_YMIX
#undef B_VF
#undef B_PA
#undef B_PB
#undef B_Y
}

extern "C" void kernel_launch(void* const* d_in, const int* in_sizes, int n_in, void* d_out, int out_size, void* d_ws, size_t ws_size, hipStream_t stream) {
    static int grid = 0;
    if (grid == 0) {
        if (n_in != 46 || in_sizes[0] != M * D || out_size != M * D || ws_size < WS_END) { fprintf(stderr, "kernel_launch: unexpected problem: n_in %d in0 %d out %d ws %zu (need %zu)\n", n_in, n_in > 0 ? in_sizes[0] : -1, out_size, ws_size, (size_t)WS_END); grid = -1; return; }
        int dev = 0, cus = 0, per_cu = 0;
        if (hipGetDevice(&dev) != hipSuccess || hipDeviceGetAttribute(&cus, hipDeviceAttributeMultiprocessorCount, dev) != hipSuccess) { grid = -1; return; }
        if (hipFuncSetAttribute((const void*)fwd_kernel, hipFuncAttributeMaxDynamicSharedMemorySize, LDS_BYTES) != hipSuccess) { fprintf(stderr, "kernel_launch: hipFuncSetAttribute failed\n"); grid = -1; return; }
        if (hipOccupancyMaxActiveBlocksPerMultiprocessor(&per_cu, (const void*)fwd_kernel, NWAVES * 64, LDS_BYTES) != hipSuccess || per_cu < 1) { fprintf(stderr, "kernel_launch: occupancy query says %d\n", per_cu); }
        (void)hipGetLastError();
        grid = cus;
    }
    if (grid < 0) return;
    (void)hipMemsetAsync((char*)d_ws + WS_CTL, 0, CTL_ZERO_BYTES, stream);
    Args a{};
    for (int i = 0; i < 46; ++i) a.in[i] = (const float*)d_in[i];
    a.out = (float*)d_out; a.ws = (unsigned char*)d_ws;
#if MK_SINGLE
    a.ph_lo = 0; a.ph_hi = NPHASE;
    hipLaunchKernelGGL(fwd_kernel, dim3(grid), dim3(NWAVES * 64), LDS_BYTES, stream, a);
#else
    for (int p = 0; p < NPHASE; ++p) { a.ph_lo = p; a.ph_hi = p + 1; hipLaunchKernelGGL(fwd_kernel, dim3(grid), dim3(NWAVES * 64), LDS_BYTES, stream, a); }
#endif
}
```

```cpp
#include <hip/hip_runtime.h>
#include <cstdio>
#include <cstdint>
namespace pg8 {
#define PG8_LAS __attribute__((address_space(3)))
typedef unsigned short bf16_t;
typedef short bf16x8 __attribute__((ext_vector_type(8)));
typedef float f32x4 __attribute__((ext_vector_type(4)));
typedef unsigned u32x4 __attribute__((ext_vector_type(4)));
constexpr int BM = 256, BK = 64, HALF = 128, HTB = HALF * BK * 2  , STAGE_BYTES = 8 * HTB, NXCD = 8, WGM = 8;

__host__ __device__ __forceinline__ int lds_byte(int r, int c) { const int st = (r >> 4) * 2 + (c >> 5), rr = r & 15, cc = c & 31, ob = rr * 64 + cc * 2; return st * 1024 + (ob ^ (((ob >> 9) & 1) << 5)); }
__host__ __device__ __forceinline__ void stage_rc(int b, int& R, int& C) { const int st = b / 1024, sb = b % 1024, swz = sb ^ (((sb >> 9) & 1) << 5); R = (st >> 1) * 16 + swz / 64; C = (st & 1) * 32 + (swz % 64) / 2; }
__host__ __device__ __forceinline__ int perm32(int rho) { const int n = rho >> 4, i = rho & 15; return 8 * (i >> 2) + 4 * n + (i & 3); }

struct Unit { int pm, pa, pn, po; };
struct Gemm { const bf16_t* A; const bf16_t* Bt; int M, N, K; };

struct StaticOrder {
    int nM, nN, nwg, G, c;
    __host__ __device__ void init(int M, int N, int G_, int c_) { nM = M / BM; nN = N / BM; nwg = nM * nN; G = G_; c = c_; }
    __host__ __device__ bool next(int i, Unit& u) const {
        const long L = (long)i * G + c; if (L >= nwg) return false;
        int wgid = (int)L; { const int q = nwg / NXCD, r = nwg % NXCD, xcd = wgid % NXCD, off = wgid / NXCD; wgid = (xcd < r ? xcd * (q + 1) : r * (q + 1) + (xcd - r) * q) + off; }
        const int nig = WGM * nN, gid = wgid / nig, fm = gid * WGM, gsz = (nM - fm) < WGM ? (nM - fm) : WGM;
        u.pm = fm + ((wgid % nig) % gsz); u.pn = (wgid % nig) / gsz; u.pa = u.pm; u.po = u.pn; return true;
    }
    __device__ __forceinline__ void a_ready(const Unit&) const {}
    __device__ __forceinline__ void done(const Unit&) const {}
};

__device__ __forceinline__ unsigned cvt_pk_bf16(float lo, float hi) { unsigned r; asm volatile("v_cvt_pk_bf16_f32 %0, %1, %2" : "=v"(r) : "v"(lo), "v"(hi)); return r; }
typedef float f32x2 __attribute__((ext_vector_type(2)));

template <class Epi, class Sched, bool ALIGN_EPI = false, bool SP2 = false>
__device__ __forceinline__ void gemm_phase(PG8_LAS unsigned char* lds, const Gemm g, const Sched& S, const Epi& E, int tid_in) {
    int tid_ = tid_in; asm volatile("" : "+v"(tid_));
    const int tid = tid_, wid = __builtin_amdgcn_readfirstlane(tid >> 6), lane = tid & 63, wr = wid >> 2, wc = wid & 3, fr = lane & 15, fq = lane >> 4;
    const int K = g.K, nt = K / BK;
    unsigned voffA[2], voffB[2];
#pragma unroll
    for (int i = 0; i < 2; ++i) { int R, C; stage_rc(tid * 16 + i * 8192, R, C); const int Rb = Epi::PERM ? ((R & ~31) + perm32(R & 31)) : R;
        voffA[i] = (unsigned)(R * K + C) * 2u; voffB[i] = (unsigned)(Rb * K + C) * 2u; }
    const size_t kstep = (size_t)(BK * 2);
    const size_t hstep = (size_t)HALF * K * 2;
    const size_t tstep = 2 * hstep;
    const unsigned ldsw = (unsigned)wid * 1024u;
    const int aoff = lds_byte(wr * 64 + fr, fq * 8), boff = lds_byte(wc * 32 + fr, fq * 8);
#define PG8_SA(b, h) (((b) * 2 + (h)) * HTB)
#define PG8_SB(b, h) ((4 + (b) * 2 + (h)) * HTB)
#define PG8_STAGE(bufoff, gbase, voff) do { _Pragma("unroll") for (int _i = 0; _i < 2; ++_i) \
        __builtin_amdgcn_global_load_lds((const unsigned*)((const char*)(gbase) + (voff)[_i]), (PG8_LAS unsigned*)(lds + (bufoff) + ldsw + _i * 8192), 16, 0, 0); } while (0)
#define PG8_LDA(dst, b, h) do { _Pragma("unroll") for (int m = 0; m < 4; ++m) _Pragma("unroll") for (int k = 0; k < 2; ++k) dst[m][k] = *(const PG8_LAS bf16x8*)(lds + PG8_SA(b, h) + aoff + m * 2048 + k * 1024); } while (0)
#define PG8_LDB(dst, b, h) do { _Pragma("unroll") for (int n = 0; n < 2; ++n) _Pragma("unroll") for (int k = 0; k < 2; ++k) dst[n][k] = *(const PG8_LAS bf16x8*)(lds + PG8_SB(b, h) + boff + n * 2048 + k * 1024); } while (0)
#define PG8_MMA(ai, bj, At, Bt) do { __builtin_amdgcn_s_setprio(1); _Pragma("unroll") for (int m = 0; m < 4; ++m) _Pragma("unroll") for (int n = 0; n < 2; ++n) _Pragma("unroll") for (int k = 0; k < 2; ++k) \
        acc[ai][bj][m][n] = __builtin_amdgcn_mfma_f32_16x16x32_bf16(Bt[n][k], At[m][k], acc[ai][bj][m][n], 0, 0, 0); __builtin_amdgcn_s_setprio(0); } while (0)
#define PG8_WAIT_V(n) asm volatile("s_waitcnt vmcnt(" #n ")" ::: "memory")
#define PG8_WAIT_L(n) asm volatile("s_waitcnt lgkmcnt(" #n ")" ::: "memory")
#define PG8_BAR __builtin_amdgcn_s_barrier()
#define PG8_SCHED __builtin_amdgcn_sched_barrier(0)
    Unit cur, nxt; int ui = 0;
    if (!S.next(0, cur)) return;
    f32x4 acc[2][2][4][2];
#pragma unroll
    for (int a = 0; a < 2; ++a)
#pragma unroll
        for (int b = 0; b < 2; ++b)
#pragma unroll
            for (int m = 0; m < 4; ++m)
#pragma unroll
                for (int n = 0; n < 2; ++n) acc[a][b][m][n] = (f32x4){0.f, 0.f, 0.f, 0.f};
    bf16x8 At[4][2], B0[2][2], B1[2][2];
    const char* cA = (const char*)g.A + (size_t)cur.pa * tstep; const char* cB = (const char*)g.Bt + (size_t)cur.pn * tstep;
    S.a_ready(cur);
    if constexpr (SP2) {
        PG8_STAGE(PG8_SB(0, 0), cB, voffB); PG8_STAGE(PG8_SB(0, 1), cB + hstep, voffB); PG8_STAGE(PG8_SA(0, 0), cA, voffA); PG8_STAGE(PG8_SA(0, 1), cA + hstep, voffA);
        if (wr == 1) PG8_BAR;
        PG8_WAIT_V(2); PG8_BAR;
        PG8_STAGE(PG8_SB(1, 0), cB + kstep, voffB); PG8_STAGE(PG8_SA(1, 0), cA + kstep, voffA); PG8_STAGE(PG8_SB(1, 1), cB + hstep + kstep, voffB);
        PG8_WAIT_V(6); PG8_BAR;
    } else {
        PG8_STAGE(PG8_SB(0, 0), cB, voffB); PG8_STAGE(PG8_SA(0, 0), cA, voffA); PG8_STAGE(PG8_SB(0, 1), cB + hstep, voffB); PG8_STAGE(PG8_SA(0, 1), cA + hstep, voffA);
        if (wr == 1) PG8_BAR;
        PG8_WAIT_V(4); PG8_BAR;
        PG8_STAGE(PG8_SB(1, 0), cB + kstep, voffB); PG8_STAGE(PG8_SA(1, 0), cA + kstep, voffA); PG8_STAGE(PG8_SB(1, 1), cB + hstep + kstep, voffB);
        PG8_WAIT_V(6); PG8_BAR;
    }
    for (;;) {
        const bool has_next = S.next(ui + 1, nxt);
        const char* nA = has_next ? (const char*)g.A + (size_t)nxt.pa * tstep : cA; const char* nB = has_next ? (const char*)g.Bt + (size_t)nxt.pn * tstep : cB;
        for (int t = 0; t < nt; t += 2) {
            const bool last = (t == nt - 2);
            const char* a1 = cA + (size_t)(t + 1) * kstep;
            const char* a2 = last ? nA : cA + (size_t)(t + 2) * kstep; const char* b2 = last ? nB : cB + (size_t)(t + 2) * kstep;
            const char* a3 = a2 + kstep; const char* b3 = b2 + kstep;
            if (last && has_next) S.a_ready(nxt);
            if constexpr (SP2) {
            PG8_LDB(B0, 0, 0); PG8_LDB(B1, 0, 1); PG8_SCHED; PG8_LDA(At, 0, 0); PG8_STAGE(PG8_SA(1, 1), a1 + hstep, voffA);
            PG8_WAIT_V(8); PG8_WAIT_L(0); PG8_BAR; PG8_MMA(0, 0, At, B0); PG8_MMA(0, 1, At, B1); PG8_BAR; PG8_SCHED;
            PG8_LDA(At, 0, 1); PG8_STAGE(PG8_SB(0, 0), b2, voffB); PG8_STAGE(PG8_SB(0, 1), b2 + hstep, voffB); PG8_STAGE(PG8_SA(0, 0), a2, voffA);
            PG8_WAIT_V(8); PG8_WAIT_L(0); PG8_BAR; PG8_MMA(1, 0, At, B0); PG8_MMA(1, 1, At, B1); PG8_BAR; PG8_SCHED;
            PG8_LDB(B0, 1, 0); PG8_LDB(B1, 1, 1); PG8_SCHED; PG8_LDA(At, 1, 0); PG8_STAGE(PG8_SA(0, 1), a2 + hstep, voffA);
            PG8_WAIT_V(8); PG8_WAIT_L(0); PG8_BAR; PG8_MMA(0, 0, At, B0); PG8_MMA(0, 1, At, B1); PG8_BAR; PG8_SCHED;
            PG8_LDA(At, 1, 1); PG8_STAGE(PG8_SB(1, 0), b3, voffB); PG8_STAGE(PG8_SB(1, 1), b3 + hstep, voffB); PG8_STAGE(PG8_SA(1, 0), a3, voffA);
            PG8_WAIT_V(8); PG8_WAIT_L(0); PG8_BAR; PG8_MMA(1, 0, At, B0); PG8_MMA(1, 1, At, B1); PG8_BAR; PG8_SCHED;
            } else {
            PG8_LDB(B0, 0, 0); PG8_SCHED; PG8_LDA(At, 0, 0); PG8_STAGE(PG8_SA(1, 1), a1 + hstep, voffA);
            PG8_WAIT_L(8); PG8_BAR; PG8_WAIT_L(0); PG8_MMA(0, 0, At, B0); PG8_BAR; PG8_SCHED;
            PG8_LDB(B1, 0, 1); PG8_STAGE(PG8_SB(0, 0), b2, voffB);
            PG8_BAR; PG8_WAIT_L(0); PG8_MMA(0, 1, At, B1); PG8_BAR;
            PG8_LDA(At, 0, 1); PG8_STAGE(PG8_SA(0, 0), a2, voffA);
            PG8_BAR; PG8_WAIT_L(0); PG8_MMA(1, 0, At, B0); PG8_BAR; PG8_SCHED;
            PG8_STAGE(PG8_SB(0, 1), b2 + hstep, voffB);
            PG8_WAIT_V(6); PG8_BAR; PG8_MMA(1, 1, At, B1); PG8_BAR;
            PG8_LDB(B0, 1, 0); PG8_SCHED; PG8_LDA(At, 1, 0); PG8_STAGE(PG8_SA(0, 1), a2 + hstep, voffA);
            PG8_WAIT_L(8); PG8_BAR; PG8_WAIT_L(0); PG8_MMA(0, 0, At, B0); PG8_BAR; PG8_SCHED;
            PG8_LDB(B1, 1, 1); PG8_STAGE(PG8_SB(1, 0), b3, voffB);
            PG8_BAR; PG8_WAIT_L(0); PG8_MMA(0, 1, At, B1); PG8_BAR;
            PG8_LDA(At, 1, 1); PG8_STAGE(PG8_SA(1, 0), a3, voffA);
            PG8_BAR; PG8_WAIT_L(0); PG8_MMA(1, 0, At, B0); PG8_BAR; PG8_SCHED;
            PG8_STAGE(PG8_SB(1, 1), b3 + hstep, voffB);
            PG8_WAIT_V(6); PG8_BAR; PG8_MMA(1, 1, At, B1); PG8_BAR;
            }
        }
        if constexpr (ALIGN_EPI) { if (wr == 0) PG8_BAR; }
        if constexpr (!Epi::AFTER_DRAIN) { E(acc, cur, wr, wc, fr, fq); S.done(cur); }
        if (!has_next) break;
#pragma unroll
        for (int a = 0; a < 2; ++a)
#pragma unroll
            for (int b = 0; b < 2; ++b)
#pragma unroll
                for (int m = 0; m < 4; ++m)
#pragma unroll
                    for (int n = 0; n < 2; ++n) acc[a][b][m][n] = (f32x4){0.f, 0.f, 0.f, 0.f};
        cur = nxt; cA = nA; cB = nB; ++ui;
        if constexpr (ALIGN_EPI) { if (wr == 1) PG8_BAR; }
    }
    PG8_WAIT_V(0);
    if constexpr (!ALIGN_EPI) { if (wr == 0) PG8_BAR; }
    PG8_BAR;
    if constexpr (Epi::AFTER_DRAIN) { E.fused(acc, cur, wr, wc, fr, fq, lds, wid, lane); S.done(cur); }
#undef PG8_SA
#undef PG8_SB
#undef PG8_STAGE
#undef PG8_LDA
#undef PG8_LDB
#undef PG8_MMA
#undef PG8_WAIT_V
#undef PG8_WAIT_L
#undef PG8_BAR
#undef PG8_SCHED
}
}
namespace pg8 {
struct EpiProj {
    static constexpr bool PERM = true, AFTER_DRAIN = false;
    bf16_t* PA; bf16_t* PB;
    __device__ __forceinline__ void operator()(const f32x4 (&acc)[2][2][4][2], const Unit& u, int wr, int wc, int fr, int fq) const {
        const int row0 = u.pm * BM + wr * 64 + fr;
        bf16_t* base; int ldc, colt;
        if (u.po < 7) { base = PA; ldc = 1792; colt = u.po * BM; } else { base = PB; ldc = 1536; colt = (u.po - 7) * BM; }
        const int col0 = colt + wc * 32 + 8 * fq;
#pragma unroll
        for (int ai = 0; ai < 2; ++ai)
#pragma unroll
            for (int m = 0; m < 4; ++m) { bf16_t* rowp = base + (size_t)(row0 + ai * HALF + m * 16) * ldc + col0;
#pragma unroll
                for (int bj = 0; bj < 2; ++bj) { const f32x4 v0 = acc[ai][bj][m][0], v1 = acc[ai][bj][m][1];
                    u32x4 w; w.x = cvt_pk_bf16(v0[0], v0[1]); w.y = cvt_pk_bf16(v0[2], v0[3]); w.z = cvt_pk_bf16(v1[0], v1[1]); w.w = cvt_pk_bf16(v1[2], v1[3]);
                    *(u32x4*)(rowp + bj * HALF) = w; } }
    }
};
struct EpiBf16Plain {
    static constexpr bool PERM = true, AFTER_DRAIN = false;
    bf16_t* O; int ldc;
    __device__ __forceinline__ void operator()(const f32x4 (&acc)[2][2][4][2], const Unit& u, int wr, int wc, int fr, int fq) const {
        const int row0 = u.pm * BM + wr * 64 + fr;
        const int col0 = u.po * BM + wc * 32 + 8 * fq;
#pragma unroll
        for (int ai = 0; ai < 2; ++ai)
#pragma unroll
            for (int m = 0; m < 4; ++m) { bf16_t* rowp = O + (size_t)(row0 + ai * HALF + m * 16) * ldc + col0;
#pragma unroll
                for (int bj = 0; bj < 2; ++bj) { const f32x4 v0 = acc[ai][bj][m][0], v1 = acc[ai][bj][m][1];
                    u32x4 w; w.x = cvt_pk_bf16(v0[0], v0[1]); w.y = cvt_pk_bf16(v0[2], v0[3]); w.z = cvt_pk_bf16(v1[0], v1[1]); w.w = cvt_pk_bf16(v1[2], v1[3]);
                    *(u32x4*)(rowp + bj * HALF) = w; } }
    }
};
struct EpiSwiglu {
    static constexpr bool PERM = true, AFTER_DRAIN = false;
    bf16_t* H; int ldc; long rowoff;
    __device__ __forceinline__ void operator()(const f32x4 (&acc)[2][2][4][2], const Unit& u, int wr, int wc, int fr, int fq) const {
        const long row0 = (long)u.pm * BM + wr * 64 + fr + rowoff;
        const int col0 = u.po * HALF + wc * 32 + 8 * fq;
#pragma unroll
        for (int ai = 0; ai < 2; ++ai)
#pragma unroll
            for (int m = 0; m < 4; ++m) { bf16_t* rowp = H + (size_t)(row0 + ai * HALF + m * 16) * ldc + col0;
                float o[8];
#pragma unroll
                for (int n = 0; n < 2; ++n)
#pragma unroll
                    for (int j = 0; j < 4; ++j) { const float g = acc[ai][0][m][n][j], up = acc[ai][1][m][n][j];
                        const float s = g * __builtin_amdgcn_rcpf(1.0f + __builtin_amdgcn_exp2f(-1.4426950408889634f * g)); o[n * 4 + j] = s * up; }
                u32x4 w; w.x = cvt_pk_bf16(o[0], o[1]); w.y = cvt_pk_bf16(o[2], o[3]); w.z = cvt_pk_bf16(o[4], o[5]); w.w = cvt_pk_bf16(o[6], o[7]);
                *(u32x4*)rowp = w; }
    }
};
struct EpiMoeDown {
    static constexpr bool PERM = true, AFTER_DRAIN = false;
    bf16_t* O; int ldc; const float* gs;
    __device__ __forceinline__ void operator()(const f32x4 (&acc)[2][2][4][2], const Unit& u, int wr, int wc, int fr, int fq) const {
        const int row0 = u.pm * BM + wr * 64 + fr;
        const int col0 = u.po * BM + wc * 32 + 8 * fq;
#pragma unroll
        for (int ai = 0; ai < 2; ++ai)
#pragma unroll
            for (int m = 0; m < 4; ++m) { const int row = row0 + ai * HALF + m * 16; const float gt = gs[row]; bf16_t* rowp = O + (size_t)row * ldc + col0;
#pragma unroll
                for (int bj = 0; bj < 2; ++bj) { const f32x4 v0 = acc[ai][bj][m][0] * gt, v1 = acc[ai][bj][m][1] * gt;
                    u32x4 w; w.x = cvt_pk_bf16(v0[0], v0[1]); w.y = cvt_pk_bf16(v0[2], v0[3]); w.z = cvt_pk_bf16(v1[0], v1[1]); w.w = cvt_pk_bf16(v1[2], v1[3]);
                    *(u32x4*)(rowp + bj * HALF) = w; } }
    }
};
struct MoeOrder {
    int t0, nT, nN, nwg, G, c, nNe, arel;
    int ts1, ts2, ts3, ts4, ts5, ts6, ts7;
    __device__ bool next(int i, Unit& u) const {
        const long L = (long)i * G + c; if (L >= nwg) return false;
        int wgid = (int)L; { const int q = nwg / NXCD, r = nwg % NXCD, xcd = wgid % NXCD, off = wgid / NXCD; wgid = (xcd < r ? xcd * (q + 1) : r * (q + 1) + (xcd - r) * q) + off; }
        const int nig = WGM * nN, gid = wgid / nig, fm = gid * WGM, gsz = (nT - fm) < WGM ? (nT - fm) : WGM;
        const int pml = fm + ((wgid % nig) % gsz), pnl = (wgid % nig) / gsz;
        u.pm = t0 + pml; u.pa = arel ? pml : u.pm; u.po = pnl;
        const int e = (u.pm >= ts1) + (u.pm >= ts2) + (u.pm >= ts3) + (u.pm >= ts4) + (u.pm >= ts5) + (u.pm >= ts6) + (u.pm >= ts7);
        u.pn = e * nNe + pnl; return true;
    }
    __device__ __forceinline__ void a_ready(const Unit&) const {}
    __device__ __forceinline__ void done(const Unit&) const {}
};
}
constexpr int NWAVES = 8;
constexpr int NBATCH = 4, SEQ = 8192, M = NBATCH * SEQ, D = 1024, NH = 8, HD = 64;
constexpr int NA = 1792, NPB = 1536, NPROJ = NA + NPB, FF = 3584, NE = 8;
constexpr int MOE_PART_TILES = 64, MOE_PARTS = 5;
constexpr float NORM_EPS = 1e-6f, LNX_EPS = 64e-5f, DECAY_SCALE = 0.6065306597126334f;
constexpr float SB_EXIT = -104.0f;

constexpr size_t MiB = 1u << 20;
constexpr size_t WS_CTL = 0, CTL_ZERO_BYTES = 1 * MiB;
constexpr size_t WS_WIN0 = 1 * MiB, WS_WIN1 = 8 * MiB, WS_WOUT0 = 15 * MiB, WS_WOUT1 = 17 * MiB, WS_WGU0 = 19 * MiB, WS_WDN0 = 33 * MiB;
constexpr size_t WS_SEL = 40 * MiB, WS_GTS = WS_SEL + 128 * 1024, WS_POS = WS_GTS + 256 * 1024, WS_GSORT = WS_POS + 256 * 1024;
constexpr size_t WS_VF = 41 * MiB;
constexpr size_t WS_PA = 73 * MiB;
constexpr size_t WS_YMIX = 73 * MiB;
constexpr size_t WS_PB = 185 * MiB;
constexpr size_t WS_Y = 185 * MiB;
constexpr size_t WS_F = 185 * MiB;
constexpr size_t WS_SCR = 281 * MiB;
constexpr size_t WS_ZH = WS_SCR, WS_RH = WS_SCR + 32 * MiB, WS_BF = WS_SCR + 64 * MiB, WS_U0F = WS_SCR + 96 * MiB, WS_YF = WS_SCR + 128 * MiB, WS_GTF = WS_SCR + 160 * MiB, WS_GF = WS_SCR + 192 * MiB, WS_PLF = WS_SCR + 256 * MiB;
constexpr size_t WS_HN = 281 * MiB;
constexpr size_t WS_HNF0 = 73 * MiB, WS_HNF1 = 41 * MiB;
constexpr size_t WS_H0 = 281 * MiB;
constexpr size_t WS_UPT = 14 * MiB + 512 * 1024;
constexpr size_t WS_BON = 40 * MiB;
constexpr size_t WS_WMGU = 105 * MiB, WS_WMDN = 217 * MiB, WS_HS = 273 * MiB, WS_HP = 405 * MiB, WS_END = 539 * MiB;
static_assert(WS_WIN0 + (size_t)NPROJ * D * 2 <= WS_WIN1 && WS_WIN1 + (size_t)NPROJ * D * 2 <= WS_UPT && WS_UPT + 2 * 8 * 12288 * 2 <= WS_WOUT0 && WS_WGU0 + (size_t)2 * FF * D * 2 <= WS_WDN0, "weights map");
static_assert(WS_GSORT + (size_t)(2 * M + 2048) * 4 <= 41 * MiB, "routing tables");
static_assert(WS_PA + (size_t)M * NA * 2 <= WS_PB && WS_PB + (size_t)M * NPB * 2 <= WS_SCR && WS_PLF + (size_t)8192 * 64 * 4 <= WS_END && WS_H0 + (size_t)M * FF * 2 <= WS_END, "act map");
static_assert(WS_WMGU + (size_t)NE * 2 * FF * D * 2 <= WS_WMDN && WS_WMDN + (size_t)NE * D * FF * 2 <= WS_HS && WS_HS + (size_t)(2 * M + 2048) * D * 2 <= WS_HP && WS_HP + (size_t)MOE_PART_TILES * 256 * FF * 2 <= WS_END, "moe map");
constexpr int CW_BAR = 4096, CW_TOT = 16384, CW_CUR = 16384 + 1024;

constexpr int RING_BYTES = 131072, LDS_BYTES = 163840, MISC_OFF = LDS_BYTES - 512;

#define GAS __attribute__((address_space(1)))
#define LAS __attribute__((address_space(3)))
typedef unsigned short bf16;
typedef unsigned v4u __attribute__((ext_vector_type(4)));
typedef unsigned v2u __attribute__((ext_vector_type(2)));
typedef float f32x4 __attribute__((ext_vector_type(4)));
typedef float f32x16 __attribute__((ext_vector_type(16)));
typedef short bf16x8 __attribute__((ext_vector_type(8)));
typedef short s16x4 __attribute__((ext_vector_type(4)));
typedef float f32x2_t __attribute__((ext_vector_type(2)));
typedef __bf16 bf16x2_t __attribute__((ext_vector_type(2)));
#define RLX_AGENT __ATOMIC_RELAXED, __HIP_MEMORY_SCOPE_AGENT
#define LDS_WAIT() asm volatile("s_waitcnt lgkmcnt(0)" ::: "memory")
#define DI __device__ __forceinline__
#define MFMA32(a, b, c) __builtin_amdgcn_mfma_f32_32x32x16_bf16((a), (b), (c), 0, 0, 0)

DI unsigned cvtpk(float lo, float hi) { f32x2_t v = {lo, hi}; bf16x2_t b = __builtin_convertvector(v, bf16x2_t); return __builtin_bit_cast(unsigned, b); }
DI unsigned short f2bf(float f) { return (unsigned short)(cvtpk(f, 0.f) & 0xffffu); }
DI float bf2f(unsigned short u) { return __uint_as_float((unsigned)u << 16); }
DI float bflo(unsigned u) { return __uint_as_float(u << 16); }
DI float bfhi(unsigned u) { return __uint_as_float(u & 0xffff0000u); }
DI int lane_id() { int l; asm volatile("v_mbcnt_lo_u32_b32 %0, -1, 0\n\tv_mbcnt_hi_u32_b32 %0, -1, %0" : "=v"(l)); return l; }
DI float shx(float v, int o, int lane) { return __builtin_bit_cast(float, __builtin_amdgcn_ds_bpermute((lane ^ o) << 2, __builtin_bit_cast(int, v))); }
DI int shi(int v, int src) { return __builtin_amdgcn_ds_bpermute(src << 2, v); }
DI float wave_sum(float v, int lane) {
#pragma unroll
    for (int o = 1; o < 64; o <<= 1) v += shx(v, o, lane);
    return v;
}
DI float sigmoidf_(float x) { return __builtin_amdgcn_rcpf(1.0f + __expf(-x)); }
DI int crow(int r, int hi) { return (r & 3) + 8 * (r >> 2) + 4 * hi; }

#define XB_TMO      128
#define XB_XCNT(j)  (256  + 64 * (j))
#define XB_XSUB(j)  (1280 + 64 * (j))
#define XB_XGEN(j)  (2304 + 64 * (j))
#define XB_TOP      3328
#define XB_TOPGEN   3392
#define XCD_BAR_WORDS 3456
#define XB_SPIN_CAP (1u << 22)
DI unsigned xb_ld(unsigned* p)              { return __hip_atomic_load(p, __ATOMIC_RELAXED, __HIP_MEMORY_SCOPE_AGENT); }
DI unsigned xb_add(unsigned* p, unsigned v) { return __hip_atomic_fetch_add(p, v, __ATOMIC_RELAXED, __HIP_MEMORY_SCOPE_AGENT); }
DI unsigned xb_xcc_id() { return (unsigned)__builtin_amdgcn_s_getreg((3 << 11) | 20) & 0xFu; }
#define XB_SPIN(cond, bar) do { unsigned _sp = 0; while (cond) { __builtin_amdgcn_s_sleep(1); \
    if ((++_sp & 255u) == 0u) { if (xb_ld(&(bar)[XB_TMO])) break; if (_sp > XB_SPIN_CAP) { atomicAdd(&(bar)[XB_TMO], 1u); break; } } } } while (0)
struct XcdBarrier { unsigned* bar; unsigned x; volatile LAS unsigned* st; };
DI XcdBarrier xcd_barrier_post(unsigned* bar, volatile LAS unsigned* st, int tid) {
    XcdBarrier b; b.bar = bar; b.x = xb_xcc_id(); b.st = st;
    if (tid == 0) (void)xb_add(&bar[XB_XCNT(b.x)], 1u);
    return b;
}
DI void xcd_barrier_complete(unsigned* bar, unsigned x, unsigned& nloc, unsigned& nx) {
    const unsigned G = gridDim.x * gridDim.y * gridDim.z;
    unsigned sum, cnt, mine, sp = 0u;
    for (;;) {
        sum = 0u; cnt = 0u; mine = 0u;
#pragma unroll
        for (unsigned j = 0; j < 16; ++j) { const unsigned c = xb_ld(&bar[XB_XCNT(j)]); sum += c; cnt += (c > 0u) ? 1u : 0u; mine = (j == x) ? c : mine; }
        if (sum == G) break;
        __builtin_amdgcn_s_sleep(1);
        if ((++sp & 255u) == 0u) { if (xb_ld(&bar[XB_TMO])) break; if (sp > XB_SPIN_CAP) { atomicAdd(&bar[XB_TMO], 1u); break; } }
    }
    nloc = mine > 0u ? mine : 1u; nx = cnt > 0u ? cnt : 1u;
}
DI void xcd_barrier(const XcdBarrier& b, int tid) {
    asm volatile("s_waitcnt vmcnt(0)" ::: "memory");
    __syncthreads();
    if (tid == 0) {
        unsigned* bar = b.bar; const unsigned bx = b.x;
        __builtin_amdgcn_s_waitcnt(0);
        unsigned nloc = b.st[0], nx = b.st[1];
        if (nloc == 0u) { xcd_barrier_complete(bar, bx, nloc, nx); b.st[0] = nloc; b.st[1] = nx; }
        const unsigned old = xb_add(&bar[XB_XSUB(bx)], 1u);
        const unsigned gen = old / nloc;
        if (old + 1u == (gen + 1u) * nloc) {
            __builtin_amdgcn_fence(__ATOMIC_RELEASE, "agent");
            asm volatile("s_waitcnt vmcnt(0)" ::: "memory");
            const unsigned og = xb_add(&bar[XB_TOP], 1u);
            const unsigned tg = og / nx;
            if (og + 1u == (tg + 1u) * nx) xb_add(&bar[XB_TOPGEN], 1u);
            else XB_SPIN(xb_ld(&bar[XB_TOPGEN]) == tg, bar);
            __builtin_amdgcn_fence(__ATOMIC_ACQUIRE, "agent");
            xb_add(&bar[XB_XGEN(bx)], 1u);
            asm volatile("s_waitcnt vmcnt(0)" ::: "memory");
        } else {
            XB_SPIN(xb_ld(&bar[XB_XGEN(bx)]) == gen, bar);
            __builtin_amdgcn_fence(__ATOMIC_ACQUIRE, "agent");
            asm volatile("s_waitcnt vmcnt(0)" ::: "memory");
        }
    }
    __syncthreads();
}

DI void transpose_item(const float* W, int N, int k0, int n0, bf16* WT, int Kt, int drow0, LAS float* scr, int lane) {
#pragma unroll 8
    for (int i = 0; i < 32; ++i) { const int kk = 2 * i + (lane >> 5); scr[kk * 33 + (lane & 31)] = W[(size_t)(k0 + kk) * N + n0 + (lane & 31)]; }
    LDS_WAIT(); asm volatile("" ::: "memory");
    const int c = lane & 7;
#pragma unroll
    for (int j = 0; j < 4; ++j) { const int n = (lane >> 3) + 8 * j; const LAS float* s = scr + (8 * c) * 33 + n;
        v4u o; o.x = cvtpk(s[0 * 33], s[1 * 33]); o.y = cvtpk(s[2 * 33], s[3 * 33]); o.z = cvtpk(s[4 * 33], s[5 * 33]); o.w = cvtpk(s[6 * 33], s[7 * 33]);
        *(GAS v4u*)(WT + (size_t)(drow0 + n) * Kt + k0 + 8 * c) = o; }
    LDS_WAIT(); asm volatile("" ::: "memory");
}
template <int MODE>
DI void conv_matrix(const float* W, int K, int N, bf16* WT, int nrw, LAS float* scr, int gw, int NGW, int lane) {
    const int nblk = N / 32, nitems = (K / 64) * nblk;
    for (int it = gw; it < nitems; it += NGW) {
        const int kb = it / nblk, nb = it % nblk, n0 = nb * 32;
        int drow0;
        if (MODE == 0) drow0 = n0;
        else if (MODE == 1) drow0 = n0 < nrw ? n0 : NA + (n0 - nrw);
        else if (MODE == 2) drow0 = (n0 >> 7) * 256 + (n0 & 127);
        else drow0 = (n0 >> 7) * 256 + 128 + (n0 & 127);
        transpose_item(W, N, kb * 64, n0, WT, K, drow0, scr, lane);
    }
}
DI void zero_rows(bf16* WT, int Kt, int r0, int r1, int gw, int NGW, int lane) {
    const int per = Kt / 8;
    const long total = (long)(r1 - r0) * per;
    for (long i = (long)gw * 64 + lane; i < total; i += (long)NGW * 64) *(GAS v4u*)(WT + (size_t)r0 * Kt + i * 8) = (v4u){0u, 0u, 0u, 0u};
}

DI float dot4(f32x4 a) { return (a.x * a.x + a.y * a.y) + (a.z * a.z + a.w * a.w); }
DI f32x4 ld_bf16x4(const bf16* p) { const v2u u = *(const GAS v2u*)p; return (f32x4){bflo(u.x), bfhi(u.x), bflo(u.y), bfhi(u.y)}; }
DI void st_bf16x4(bf16* p, f32x4 v) { v2u u; u.x = cvtpk(v.x, v.y); u.y = cvtpk(v.z, v.w); *(GAS v2u*)p = u; }

DI void phase_norm0(const float* x, const float* g, bf16* hn, int gw, int NGW, int lane) {
    f32x4 gv[4];
#pragma unroll
    for (int j = 0; j < 4; ++j) gv[j] = *(const f32x4*)(g + 4 * lane + 256 * j);
    for (int m = gw; m < M; m += NGW) {
        f32x4 v[4]; float s = 0.f;
#pragma unroll
        for (int j = 0; j < 4; ++j) { v[j] = *(const GAS f32x4*)(x + (size_t)m * D + 4 * lane + 256 * j); s += dot4(v[j]); }
        const float rs = rsqrtf(wave_sum(s, lane) * (1.f / D) + NORM_EPS);
#pragma unroll
        for (int j = 0; j < 4; ++j) st_bf16x4(hn + (size_t)m * D + 4 * lane + 256 * j, v[j] * rs * gv[j]);
    }
}
template <bool MOEF>
DI void phase_resnorm(const float* xin, const bf16* y, const unsigned* pos, const float* g1, const float* g2, float* xout, bf16* hn,
                      const float* rt, unsigned* sel, float* gts, unsigned* totals, int gw, int NGW, int lane) {
    f32x4 g1v[4], g2v[4];
#pragma unroll
    for (int j = 0; j < 4; ++j) { g1v[j] = *(const f32x4*)(g1 + 4 * lane + 256 * j); g2v[j] = g2 ? *(const f32x4*)(g2 + 4 * lane + 256 * j) : (f32x4){0.f, 0.f, 0.f, 0.f}; }
    unsigned mycnt = 0;
    for (int m = gw; m < M; m += NGW) {
        f32x4 v[4], yv[4]; float s = 0.f;
        if (MOEF) {
            const unsigned p0 = __hip_atomic_load(pos + 2 * m, RLX_AGENT), p1 = __hip_atomic_load(pos + 2 * m + 1, RLX_AGENT);
#pragma unroll
            for (int j = 0; j < 4; ++j) yv[j] = ld_bf16x4(y + (size_t)p0 * D + 4 * lane + 256 * j) + ld_bf16x4(y + (size_t)p1 * D + 4 * lane + 256 * j);
        } else {
#pragma unroll
            for (int j = 0; j < 4; ++j) yv[j] = ld_bf16x4(y + (size_t)m * D + 4 * lane + 256 * j);
        }
#pragma unroll
        for (int j = 0; j < 4; ++j) { v[j] = *(const GAS f32x4*)(xin + (size_t)m * D + 4 * lane + 256 * j); s += dot4(yv[j]); }
        const float rsy = rsqrtf(wave_sum(s, lane) * (1.f / D) + NORM_EPS);
        float s2 = 0.f;
#pragma unroll
        for (int j = 0; j < 4; ++j) { v[j] = v[j] + yv[j] * rsy * g1v[j]; s2 += dot4(v[j]); *(GAS f32x4*)(xout + (size_t)m * D + 4 * lane + 256 * j) = v[j]; }
        if (g2) {
            const float rsx = rsqrtf(wave_sum(s2, lane) * (1.f / D) + NORM_EPS);
#pragma unroll
            for (int j = 0; j < 4; ++j) { v[j] = v[j] * rsx * g2v[j]; st_bf16x4(hn + (size_t)m * D + 4 * lane + 256 * j, v[j]); }
            if (rt) {
                float pe[8];
#pragma unroll
                for (int e = 0; e < 8; ++e) pe[e] = 0.f;
#pragma unroll
                for (int j = 0; j < 4; ++j)
#pragma unroll
                    for (int i = 0; i < 4; ++i) { const float hv = v[j][i]; const float* rp = rt + (size_t)(4 * lane + 256 * j + i) * 8;
                        const f32x4 ra = *(const f32x4*)rp, rb = *(const f32x4*)(rp + 4);
                        pe[0] += hv * ra.x; pe[1] += hv * ra.y; pe[2] += hv * ra.z; pe[3] += hv * ra.w; pe[4] += hv * rb.x; pe[5] += hv * rb.y; pe[6] += hv * rb.z; pe[7] += hv * rb.w; }
                float v0 = -3.0e38f, v1 = -3.0e38f; int e0 = 0, e1 = 0;
#pragma unroll
                for (int e = 0; e < 8; ++e) { const float lg = wave_sum(pe[e], lane); if (lg > v0) { v1 = v0; e1 = e0; v0 = lg; e0 = e; } else if (lg > v1) { v1 = lg; e1 = e; } }
                const float ga = 1.0f / (1.0f + __expf(v1 - v0)), gb = 1.0f - ga;
                if (lane == 0) { sel[m] = (unsigned)e0 | ((unsigned)e1 << 8); gts[2 * m] = ga; gts[2 * m + 1] = gb; }
                if (lane == e0 || lane == e1) ++mycnt;
            }
        }
    }
    if (rt && lane < 8 && mycnt) __hip_atomic_fetch_add(totals + 64 * lane, mycnt, RLX_AGENT);
}

DI int moe_offsets(unsigned* totals, int lane, int& mytot) {
    int off = 0; mytot = 0;
#pragma unroll
    for (int e = 0; e < 8; ++e) { const int t = (int)__hip_atomic_load(totals + 64 * e, RLX_AGENT); if (e < lane) off += (t + 255) & ~255; if (e == lane) mytot = t; }
    return off;
}

DI void phase_moe_sort(const unsigned* sel, const float* gts, unsigned* totals, unsigned* cursor, unsigned* pos, float* gsort, const bf16* hn, bf16* hs, int gw, int NGW, int lane) {
    int mytot; const int myoff = moe_offsets(totals, lane, mytot);
    unsigned mycnt = 0;
    for (int m = gw; m < M; m += NGW) { const unsigned s = __hip_atomic_load(sel + m, RLX_AGENT); const int e0 = s & 255, e1 = (s >> 8) & 255; if (lane == e0 || lane == e1) ++mycnt; }
    unsigned mybase = 0;
    if (lane < 8 && mycnt) mybase = __hip_atomic_fetch_add(cursor + 64 * lane, mycnt, RLX_AGENT);
    unsigned mypos = (unsigned)myoff + mybase;
    for (int m = gw; m < M; m += NGW) {
        const unsigned s = __hip_atomic_load(sel + m, RLX_AGENT); const int e0 = s & 255, e1 = (s >> 8) & 255;
        const unsigned p0 = (unsigned)shi((int)mypos, e0), p1 = (unsigned)shi((int)mypos, e1);
        if (lane == e0 || lane == e1) ++mypos;
        if (lane == 0) { pos[2 * m] = p0; pos[2 * m + 1] = p1; gsort[p0] = __hip_atomic_load(gts + 2 * m, RLX_AGENT); gsort[p1] = __hip_atomic_load(gts + 2 * m + 1, RLX_AGENT); }
        const v4u a = *(const GAS v4u*)(hn + (size_t)m * D + 8 * lane), b = *(const GAS v4u*)(hn + (size_t)m * D + 512 + 8 * lane);
        *(GAS v4u*)(hs + (size_t)p0 * D + 8 * lane) = a; *(GAS v4u*)(hs + (size_t)p0 * D + 512 + 8 * lane) = b;
        *(GAS v4u*)(hs + (size_t)p1 * D + 8 * lane) = a; *(GAS v4u*)(hs + (size_t)p1 * D + 512 + 8 * lane) = b;
    }
#pragma unroll 1
    for (int e = 0; e < 8; ++e) {
        const int r0 = shi(myoff + mytot, e), r1 = shi(myoff + ((mytot + 255) & ~255), e);
        for (int r = r0 + gw; r < r1; r += NGW) { *(GAS v4u*)(hs + (size_t)r * D + 8 * lane) = (v4u){0u, 0u, 0u, 0u}; *(GAS v4u*)(hs + (size_t)r * D + 512 + 8 * lane) = (v4u){0u, 0u, 0u, 0u}; if (lane == 0) gsort[r] = 0.f; }
    }
}
constexpr int SB_VP = 40;
DI void sb_wave(const bf16* PB, bf16* ymix, const float* sb_g, int b, int h, int q0, LAS unsigned char* vtb, int lane) {
    const int qi = lane & 31, hh = lane >> 5;
    LAS bf16* vt = (LAS bf16*)vtb;
    const size_t rowb = (size_t)b * SEQ;
    bf16x8 qf[4];
#pragma unroll
    for (int s = 0; s < 4; ++s) qf[s] = *(const GAS bf16x8*)(PB + (rowb + q0 + qi) * NPB + h * 64 + 16 * s + 8 * hh);
    f32x16 o0, o1;
#pragma unroll
    for (int r = 0; r < 16; ++r) { o0[r] = 0.f; o1[r] = 0.f; }
    float carry = 0.f;
    const int q = q0 + qi;
#pragma unroll 1
    for (int kt = q0 / 32; kt >= 0; --kt) {
        const int kb = kt * 32;
        bf16x8 kf[4], vv[4];
#pragma unroll
        for (int s = 0; s < 4; ++s) kf[s] = *(const GAS bf16x8*)(PB + (rowb + kb + qi) * NPB + 512 + h * 64 + 16 * s + 8 * hh);
#pragma unroll
        for (int i = 0; i < 4; ++i) vv[i] = *(const GAS bf16x8*)(PB + (rowb + kb + qi) * NPB + 1024 + h * 64 + 32 * hh + 8 * i);
#pragma unroll
        for (int i = 0; i < 4; ++i)
#pragma unroll
            for (int e = 0; e < 8; ++e) vt[(32 * hh + 8 * i + e) * SB_VP + qi] = (bf16)vv[i][e];
        f32x16 sc;
#pragma unroll
        for (int r = 0; r < 16; ++r) sc[r] = 0.f;
#pragma unroll
        for (int s = 0; s < 4; ++s) sc = MFMA32(kf[s], qf[s], sc);
        float c[16], ls[16];
        const bool diag = (kb == q0);
#pragma unroll
        for (int r = 0; r < 16; ++r) {
            const float z = sc[r] * 0.125f;
            const float sp = fmaxf(z, 0.f) + __logf(1.0f + __expf(-fabsf(z)));
            const bool valid = !diag || (kb + crow(r, hh) < q);
            c[r] = valid ? -sp : 0.f;
            ls[r] = valid ? z - sp : -1.0e30f;
        }
        float G[4], PG[4];
#pragma unroll
        for (int g = 0; g < 4; ++g) { G[g] = (c[4 * g] + c[4 * g + 1]) + (c[4 * g + 2] + c[4 * g + 3]); PG[g] = shx(G[g], 32, lane); }
        float att[16];
        float after = carry;
#pragma unroll
        for (int g = 3; g >= 0; --g) {
            float sfx = after + (hh == 0 ? PG[g] : 0.f);
#pragma unroll
            for (int i = 3; i >= 0; --i) { att[4 * g + i] = __expf(ls[4 * g + i] + sfx); sfx += c[4 * g + i]; }
            after += G[g] + PG[g];
        }
        carry = after;
        bf16x8 pf[2];
#pragma unroll
        for (int s = 0; s < 2; ++s) { v4u p; p.x = cvtpk(att[8 * s], att[8 * s + 1]); p.y = cvtpk(att[8 * s + 2], att[8 * s + 3]); p.z = cvtpk(att[8 * s + 4], att[8 * s + 5]); p.w = cvtpk(att[8 * s + 6], att[8 * s + 7]); pf[s] = __builtin_bit_cast(bf16x8, p); }
        LDS_WAIT();
#pragma unroll
        for (int s = 0; s < 2; ++s) {
            const s16x4 a0 = *(const LAS s16x4*)(vt + qi * SB_VP + 16 * s + 4 * hh), a1 = *(const LAS s16x4*)(vt + qi * SB_VP + 16 * s + 8 + 4 * hh);
            const s16x4 b0 = *(const LAS s16x4*)(vt + (32 + qi) * SB_VP + 16 * s + 4 * hh), b1 = *(const LAS s16x4*)(vt + (32 + qi) * SB_VP + 16 * s + 8 + 4 * hh);
            const bf16x8 va = __builtin_shufflevector(a0, a1, 0, 1, 2, 3, 4, 5, 6, 7), vb = __builtin_shufflevector(b0, b1, 0, 1, 2, 3, 4, 5, 6, 7);
            o0 = MFMA32(va, pf[s], o0);
            o1 = MFMA32(vb, pf[s], o1);
        }
        LDS_WAIT();
        if (__all(carry < SB_EXIT)) break;
    }
    float ss = 0.f;
#pragma unroll
    for (int r = 0; r < 16; ++r) ss += o0[r] * o0[r] + o1[r] * o1[r];
    ss += shx(ss, 32, lane);
    const float scl = rsqrtf(ss * (1.f / 64.f) + NORM_EPS);
    bf16* orow = ymix + (rowb + q) * D + 512 + h * 64;
#pragma unroll
    for (int g = 0; g < 4; ++g) {
        const int d0 = 8 * g + 4 * hh;
        const f32x4 g0 = *(const f32x4*)(sb_g + h * 64 + d0), g1 = *(const f32x4*)(sb_g + h * 64 + 32 + d0);
        v2u w0, w1;
        w0.x = cvtpk(o0[4 * g] * scl * g0.x, o0[4 * g + 1] * scl * g0.y); w0.y = cvtpk(o0[4 * g + 2] * scl * g0.z, o0[4 * g + 3] * scl * g0.w);
        w1.x = cvtpk(o1[4 * g] * scl * g1.x, o1[4 * g + 1] * scl * g1.y); w1.y = cvtpk(o1[4 * g + 2] * scl * g1.z, o1[4 * g + 3] * scl * g1.w);
        *(GAS v2u*)(orow + d0) = w0; *(GAS v2u*)(orow + 32 + d0) = w1;
    }
}
constexpr int RW_L = 32, RW_NCH = SEQ / RW_L;
constexpr size_t RW_UNITS = (size_t)NBATCH * NH * RW_NCH;
struct RwkvC {
    const bf16* PA; const float* mu; const float *decay0, *iclr0, *vres0, *k_k, *k_a, *r_k, *lnx_g, *lnx_b;
    const bf16* upT;
    unsigned* VFf;
    bf16* ZH; bf16* RH;
    unsigned* BF;
    unsigned* U0F; unsigned* YF;
    unsigned* GTF;
    unsigned* GF;
    float* PLF;
    float* BON;
    bf16* ymix;
    int has_vres;
};
DI bf16x8 pk8(const f32x16& x, int s) { v4u p; p.x = cvtpk(x[8 * s], x[8 * s + 1]); p.y = cvtpk(x[8 * s + 2], x[8 * s + 3]); p.z = cvtpk(x[8 * s + 4], x[8 * s + 5]); p.w = cvtpk(x[8 * s + 6], x[8 * s + 7]); return __builtin_bit_cast(bf16x8, p); }
DI void st_frag(unsigned* p, const f32x16& x) {
    v4u a, b; a.x = cvtpk(x[0], x[1]); a.y = cvtpk(x[2], x[3]); a.z = cvtpk(x[4], x[5]); a.w = cvtpk(x[6], x[7]);
    b.x = cvtpk(x[8], x[9]); b.y = cvtpk(x[10], x[11]); b.z = cvtpk(x[12], x[13]); b.w = cvtpk(x[14], x[15]);
    *(GAS v4u*)p = a; *(GAS v4u*)(p + 4) = b;
}
DI f32x16 ld_frag(const unsigned* p) {
    const v4u a = *(const GAS v4u*)p, b = *(const GAS v4u*)(p + 4); f32x16 x;
    x[0] = bflo(a.x); x[1] = bfhi(a.x); x[2] = bflo(a.y); x[3] = bfhi(a.y); x[4] = bflo(a.z); x[5] = bfhi(a.z); x[6] = bflo(a.w); x[7] = bfhi(a.w);
    x[8] = bflo(b.x); x[9] = bfhi(b.x); x[10] = bflo(b.y); x[11] = bfhi(b.y); x[12] = bflo(b.z); x[13] = bfhi(b.z); x[14] = bflo(b.w); x[15] = bfhi(b.w);
    return x;
}
DI f32x16 zero16() { f32x16 z;
#pragma unroll
    for (int i = 0; i < 16; ++i) z[i] = 0.f;
    return z; }
DI float half_sum(float v, int lane) {
#pragma unroll
    for (int o = 1; o < 32; o <<= 1) v += shx(v, o, lane);
    return v;
}
constexpr int RW_SP = 72;
DI void stage_n(LAS bf16* img, const f32x16& x0, const f32x16& x1, int cl, int hi) {
#pragma unroll
    for (int r = 0; r < 16; ++r) { img[crow(r, hi) * RW_SP + cl] = f2bf(x0[r]); img[crow(r, hi) * RW_SP + 32 + cl] = f2bf(x1[r]); }
}
DI bf16x8 frag_nat(const LAS bf16* img, int pitch, int row, int S, int hh) { return *(const LAS bf16x8*)(img + row * pitch + 16 * S + 8 * hh); }
DI bf16x8 frag_perm(const LAS bf16* img, int pitch, int row, int S, int hh) {
    const s16x4 a = *(const LAS s16x4*)(img + row * pitch + 16 * S + 4 * hh), b = *(const LAS s16x4*)(img + row * pitch + 16 * S + 8 + 4 * hh);
    return __builtin_shufflevector(a, b, 0, 1, 2, 3, 4, 5, 6, 7);
}

constexpr int RW_WAVE_LDS = 19456;
DI unsigned pk2f(float a, float b) { return cvtpk(a, b); }
DI bf16x8 pkq(const unsigned (&p)[8], int s) { v4u q; q.x = p[4 * s]; q.y = p[4 * s + 1]; q.z = p[4 * s + 2]; q.w = p[4 * s + 3]; return __builtin_bit_cast(bf16x8, q); }
DI void rwkv_pre_unit(const RwkvC& P, int b, int h, int ch, LAS unsigned char* lw_, int lane) {
    const int cl = lane & 31, hi = lane >> 5;
    const unsigned unit = (unsigned)((b * NH + h) * RW_NCH + ch);
    const unsigned row0 = (unsigned)(b * SEQ + ch * RW_L);
    LAS bf16* Ri = (LAS bf16*)lw_; LAS bf16* Bi = (LAS bf16*)(lw_ + 4608); LAS bf16* Ki = (LAS bf16*)(lw_ + 9216); LAS bf16* Zi = (LAS bf16*)(lw_ + 13824);
    LAS float* Af = (LAS float*)lw_;
    LAS bf16* Tn = (LAS bf16*)lw_; LAS bf16* Tt = (LAS bf16*)(lw_ + 2048);
    LAS bf16* BmL = (LAS bf16*)(lw_ + 4096); LAS bf16* AbL = (LAS bf16*)(lw_ + 6144); LAS bf16* AkL = (LAS bf16*)(lw_ + 8192);
    const bf16* upT = P.upT + (size_t)h * 12288;
    const unsigned rowt = row0 + cl; const bool first_tok = (ch == 0 && cl == 0);
    bf16x8 smw[2], sma[2], smv[2];
    {
        bf16x8 smg[6];
        const bf16* pr = P.PA + rowt * NA + 1536 + 8 * hi; const bf16* pp = pr - NA;
#pragma unroll
        for (int s = 0; s < 12; ++s) {
            if (s >= 10 && !P.has_vres) { smv[s - 10] = (bf16x8){0, 0, 0, 0, 0, 0, 0, 0}; continue; }
            const v4u cu = *(const GAS v4u*)(pr + 16 * s); v4u pv = (v4u){0u, 0u, 0u, 0u};
            if (!first_tok) pv = *(const GAS v4u*)(pp + 16 * s);
            const f32x4 m0 = *(const f32x4*)(P.mu + 1536 + 16 * s + 8 * hi), m1 = *(const f32x4*)(P.mu + 1536 + 16 * s + 8 * hi + 4);
            float xs[8];
            xs[0] = bflo(cu.x) + m0.x * (bflo(pv.x) - bflo(cu.x)); xs[1] = bfhi(cu.x) + m0.y * (bfhi(pv.x) - bfhi(cu.x));
            xs[2] = bflo(cu.y) + m0.z * (bflo(pv.y) - bflo(cu.y)); xs[3] = bfhi(cu.y) + m0.w * (bfhi(pv.y) - bfhi(cu.y));
            xs[4] = bflo(cu.z) + m1.x * (bflo(pv.z) - bflo(cu.z)); xs[5] = bfhi(cu.z) + m1.y * (bfhi(pv.z) - bfhi(cu.z));
            xs[6] = bflo(cu.w) + m1.z * (bflo(pv.w) - bflo(cu.w)); xs[7] = bfhi(cu.w) + m1.w * (bfhi(pv.w) - bfhi(cu.w));
            if (s < 2) {
#pragma unroll
                for (int j = 0; j < 8; ++j) { const float e = __expf(2.0f * xs[j]); xs[j] = 1.0f - 2.0f * __builtin_amdgcn_rcpf(e + 1.0f); }
            } else if (s >= 4 && s < 10) {
#pragma unroll
                for (int j = 0; j < 8; ++j) xs[j] = sigmoidf_(xs[j]);
            }
            v4u p; p.x = cvtpk(xs[0], xs[1]); p.y = cvtpk(xs[2], xs[3]); p.z = cvtpk(xs[4], xs[5]); p.w = cvtpk(xs[6], xs[7]);
            asm volatile("" : "+v"(p) :: "memory");
            const bf16x8 f = __builtin_bit_cast(bf16x8, p);
            if (s < 2) smw[s] = f; else if (s < 4) sma[s - 2] = f; else if (s < 10) smg[s - 4] = f; else smv[s - 10] = f;
            if (s & 1) { asm volatile("" ::: "memory"); __builtin_amdgcn_sched_barrier(0); }
        }
#pragma unroll
        for (int ct = 0; ct < 2; ++ct) {
            f32x16 g = zero16();
#pragma unroll
            for (int s = 0; s < 6; ++s) { const bf16x8 wg = *(const GAS bf16x8*)(upT + 6144 + (32 * ct + cl) * 96 + 16 * s + 8 * hi); g = MFMA32(smg[s], wg, g); }
            st_frag(P.GTF + ((unit * 2 + ct) * 64 + lane) * 8, g);
        }
    }
    float rn[16];
    {
        float nn[16];
#pragma unroll
        for (int r = 0; r < 16; ++r) nn[r] = 0.f;
#pragma unroll
        for (int ct = 0; ct < 2; ++ct) {
            const int hc = h * 64 + 32 * ct + cl; const float mk = P.mu[512 + hc], kkc = P.k_k[hc];
#pragma unroll
            for (int r = 0; r < 16; ++r) { const int t = crow(r, hi); const bf16* pr = P.PA + (row0 + t) * NA + 512 + hc; const float kc = bf2f(pr[0]); const float kp = (ch == 0 && t == 0) ? 0.f : bf2f(pr[-NA]);
                const float kq = (kc + mk * (kp - kc)) * kkc; nn[r] += kq * kq; if ((r & 3) == 3) asm volatile("" : "+v"(nn[r]), "+v"(nn[r - 1]), "+v"(nn[r - 2]), "+v"(nn[r - 3]) :: "memory"); }
        }
#pragma unroll
        for (int r = 0; r < 16; ++r) rn[r] = rsqrtf(fmaxf(half_sum(nn[r], lane), 1e-12f));
    }
    unsigned Khp0[8];
    float bon[16];
#pragma unroll
    for (int r = 0; r < 16; ++r) bon[r] = 0.f;
#pragma unroll
    for (int ct = 0; ct < 2; ++ct) {
        const int hc = h * 64 + 32 * ct + cl;
        f32x16 lwv, av;
        {
            f32x16 d = zero16(), ic = zero16();
#pragma unroll
            for (int s = 0; s < 2; ++s) {
                const bf16x8 wd = *(const GAS bf16x8*)(upT + (32 * ct + cl) * 32 + 16 * s + 8 * hi);
                const bf16x8 wi = *(const GAS bf16x8*)(upT + 2048 + (32 * ct + cl) * 32 + 16 * s + 8 * hi);
                d = MFMA32(smw[s], wd, d); ic = MFMA32(sma[s], wi, ic);
            }
            const float d0 = P.decay0[hc], i0 = P.iclr0[hc];
#pragma unroll
            for (int r = 0; r < 16; ++r) { lwv[r] = -DECAY_SCALE * sigmoidf_(d[r] + d0); av[r] = sigmoidf_(ic[r] + i0); }
        }
        f32x16 cum; float cumL;
        {
            float Gs[4], PGs[4];
#pragma unroll
            for (int g = 0; g < 4; ++g) { Gs[g] = (lwv[4 * g] + lwv[4 * g + 1]) + (lwv[4 * g + 2] + lwv[4 * g + 3]); PGs[g] = shx(Gs[g], 32, lane); }
            float before = 0.f;
#pragma unroll
            for (int g = 0; g < 4; ++g) {
                float run = before + (hi ? PGs[g] : 0.f);
#pragma unroll
                for (int i = 0; i < 4; ++i) { run += lwv[4 * g + i]; cum[4 * g + i] = run; }
                before += Gs[g] + PGs[g];
            }
            cumL = before;
        }
        if (hi == ct) P.PLF[unit * 64 + 32 * ct + cl] = __expf(cumL);
        f32x16 rv, kv, vv;
        {
            const float mr = P.mu[hc], mk = P.mu[512 + hc], mv = P.mu[1024 + hc];
#pragma unroll
            for (int r = 0; r < 16; ++r) {
                const int t = crow(r, hi); const bf16* pr = P.PA + (row0 + t) * NA + hc; const bool ft = (ch == 0 && t == 0);
                const float rc = bf2f(pr[0]), kc = bf2f(pr[512]), vc = bf2f(pr[1024]);
                const float rp = ft ? 0.f : bf2f(pr[-NA]), kp = ft ? 0.f : bf2f(pr[512 - NA]), vp = ft ? 0.f : bf2f(pr[1024 - NA]);
                rv[r] = rc + mr * (rp - rc); kv[r] = kc + mk * (kp - kc); vv[r] = vc + mv * (vp - vc);
                if ((r & 3) == 3) asm volatile("" : "+v"(rv[r]), "+v"(kv[r]), "+v"(vv[r]), "+v"(rv[r - 1]), "+v"(kv[r - 1]), "+v"(vv[r - 1]), "+v"(rv[r - 2]), "+v"(kv[r - 2]), "+v"(vv[r - 2]), "+v"(rv[r - 3]), "+v"(kv[r - 3]), "+v"(vv[r - 3]) :: "memory");
            }
        }
        if (P.has_vres) {
            f32x16 vp = zero16();
#pragma unroll
            for (int s = 0; s < 2; ++s) { const bf16x8 wv = *(const GAS bf16x8*)(upT + 4096 + (32 * ct + cl) * 32 + 16 * s + 8 * hi); vp = MFMA32(smv[s], wv, vp); }
            const float v0 = P.vres0[hc];
            const f32x16 vf = ld_frag(P.VFf + ((unit * 2 + ct) * 64 + lane) * 8);
#pragma unroll
            for (int r = 0; r < 16; ++r) vv[r] = vv[r] + (vf[r] - vv[r]) * sigmoidf_(vp[r] + v0);
        }
        st_frag(P.VFf + ((unit * 2 + ct) * 64 + lane) * 8, vv);
        const float kkc = P.k_k[hc], kac = P.k_a[hc], rkc = P.r_k[hc];
        f32x16 Bh;
#pragma unroll
        for (int r = 0; r < 16; ++r) {
            const int t = crow(r, hi);
            const float kk = kv[r] * kkc * rn[r];
            const float km = kv[r] * (1.0f + (av[r] - 1.0f) * kac);
            bon[r] += rv[r] * km * rkc;
            const float c = cum[r], e1 = __expf(c), e2 = __expf(c - lwv[r]), e3 = __expf(-c), e4 = __expf(cumL - c);
            const float bb = kk * av[r];
            const float zt = -kk * e2;
            Zi[t * RW_SP + 32 * ct + cl] = f2bf(zt); Ri[t * RW_SP + 32 * ct + cl] = f2bf(rv[r] * e1); Bi[t * RW_SP + 32 * ct + cl] = f2bf(bb * e3); Ki[t * RW_SP + 32 * ct + cl] = f2bf(km * e3);
            Bh[r] = bb * e4;
            kv[r] = km * e4;
        }
        st_frag(P.BF + ((unit * 2 + ct) * 64 + lane) * 8, Bh);
        unsigned Khc[8], vvc[8];
#pragma unroll
        for (int q = 0; q < 8; ++q) { Khc[q] = pk2f(kv[2 * q], kv[2 * q + 1]); vvc[q] = pk2f(vv[2 * q], vv[2 * q + 1]); }
        if (ct == 0) {
#pragma unroll
            for (int q = 0; q < 8; ++q) Khp0[q] = Khc[q];
            f32x16 g = zero16();
            g = MFMA32(pkq(Khc, 0), pkq(vvc, 0), g); g = MFMA32(pkq(Khc, 1), pkq(vvc, 1), g);
            st_frag(P.GF + (((unit * 2 + 0) * 2 + 0) * 64 + lane) * 8, g);
        } else {
            unsigned vv0[8];
            { const v4u a = *(const GAS v4u*)(P.VFf + ((unit * 2 + 0) * 64 + lane) * 8), b2 = *(const GAS v4u*)(P.VFf + ((unit * 2 + 0) * 64 + lane) * 8 + 4);
              vv0[0] = a.x; vv0[1] = a.y; vv0[2] = a.z; vv0[3] = a.w; vv0[4] = b2.x; vv0[5] = b2.y; vv0[6] = b2.z; vv0[7] = b2.w; }
            f32x16 g01 = zero16(), g10 = zero16(), g11 = zero16();
#pragma unroll
            for (int s2 = 0; s2 < 2; ++s2) { g01 = MFMA32(pkq(Khp0, s2), pkq(vvc, s2), g01); g10 = MFMA32(pkq(Khc, s2), pkq(vv0, s2), g10); g11 = MFMA32(pkq(Khc, s2), pkq(vvc, s2), g11); }
            st_frag(P.GF + (((unit * 2 + 0) * 2 + 1) * 64 + lane) * 8, g01);
            st_frag(P.GF + (((unit * 2 + 1) * 2 + 0) * 64 + lane) * 8, g10);
            st_frag(P.GF + (((unit * 2 + 1) * 2 + 1) * 64 + lane) * 8, g11);
        }
        asm volatile("" ::: "memory"); __builtin_amdgcn_sched_barrier(0);
    }
#pragma unroll
    for (int r = 0; r < 16; ++r) { const float bo = half_sum(bon[r], lane); if (cl == 0) P.BON[(row0 + crow(r, hi)) * 8 + h] = bo; }
    LDS_WAIT();
    bf16x8 zf[4], rf[4], bfr[4], kf[4];
    unsigned rtT[16];
#pragma unroll
    for (int S = 0; S < 4; ++S) { zf[S] = frag_nat(Zi, RW_SP, cl, S, hi); rf[S] = frag_nat(Ri, RW_SP, cl, S, hi); bfr[S] = frag_nat(Bi, RW_SP, cl, S, hi); kf[S] = frag_nat(Ki, RW_SP, cl, S, hi); }
#pragma unroll
    for (int ct = 0; ct < 2; ++ct)
#pragma unroll
        for (int g = 0; g < 4; ++g) { const v2u w = *(const LAS v2u*)(Ri + cl * RW_SP + 32 * ct + 8 * g + 4 * hi); rtT[ct * 8 + g * 2] = w.x; rtT[ct * 8 + g * 2 + 1] = w.y; }
    LDS_WAIT();
    {
        f32x16 Aa = zero16(), Bm = zero16(), Ab = zero16(), Ak = zero16();
#pragma unroll
        for (int S = 0; S < 4; ++S) { Aa = MFMA32(zf[S], bfr[S], Aa); Bm = MFMA32(zf[S], kf[S], Bm); Ab = MFMA32(rf[S], bfr[S], Ab); Ak = MFMA32(rf[S], kf[S], Ak); }
#pragma unroll
        for (int r = 0; r < 16; ++r) {
            const int t = crow(r, hi); const bool lo = cl < t, le = cl <= t;
            Af[t * 32 + cl] = lo ? Aa[r] : 0.f;
            BmL[t * 32 + cl] = f2bf(lo ? Bm[r] : 0.f); AbL[t * 32 + cl] = f2bf(le ? Ab[r] : 0.f); AkL[t * 32 + cl] = f2bf(le ? Ak[r] : 0.f);
        }
    }
    LDS_WAIT();
    {
        float tc[32];
#pragma unroll
        for (int t = 0; t < 32; ++t) {
            float acc = (t == cl) ? 1.0f : 0.f;
#pragma unroll
            for (int s4 = 0; s4 < t; s4 += 4) {
                const f32x4 a4 = *(const LAS f32x4*)(Af + t * 32 + s4);
                acc += a4.x * tc[s4];
                if (s4 + 1 < t) acc += a4.y * tc[s4 + 1];
                if (s4 + 2 < t) acc += a4.z * tc[s4 + 2];
                if (s4 + 3 < t) acc += a4.w * tc[s4 + 3];
            }
            asm volatile("" : "+v"(acc) :: "memory");
            tc[t] = acc;
        }
        LDS_WAIT();
#pragma unroll
        for (int t = 0; t < 32; ++t) if (hi == 0) Tn[t * 32 + cl] = f2bf(tc[t]);
        if (hi == 0) {
#pragma unroll
            for (int q = 0; q < 4; ++q) { v4u p; p.x = cvtpk(tc[8 * q], tc[8 * q + 1]); p.y = cvtpk(tc[8 * q + 2], tc[8 * q + 3]); p.z = cvtpk(tc[8 * q + 4], tc[8 * q + 5]); p.w = cvtpk(tc[8 * q + 6], tc[8 * q + 7]); *(LAS v4u*)(Tt + cl * 32 + 8 * q) = p; }
        }
    }
    LDS_WAIT();
    bf16x8 tp[2];
    {
        bf16x8 bmp[2], abp[2], akp[2];
#pragma unroll
        for (int s = 0; s < 2; ++s) { bmp[s] = frag_perm(BmL, 32, cl, s, hi); tp[s] = frag_perm(Tn, 32, cl, s, hi); abp[s] = frag_perm(AbL, 32, cl, s, hi); akp[s] = frag_perm(AkL, 32, cl, s, hi); }
#pragma unroll
        for (int vt = 0; vt < 2; ++vt) {
            unsigned vvq[8];
            { const v4u a = *(const GAS v4u*)(P.VFf + ((unit * 2 + vt) * 64 + lane) * 8), b2 = *(const GAS v4u*)(P.VFf + ((unit * 2 + vt) * 64 + lane) * 8 + 4);
              vvq[0] = a.x; vvq[1] = a.y; vvq[2] = a.z; vvq[3] = a.w; vvq[4] = b2.x; vvq[5] = b2.y; vvq[6] = b2.z; vvq[7] = b2.w; }
            f32x16 w0 = zero16(), u0 = zero16(), y0 = zero16();
#pragma unroll
            for (int s = 0; s < 2; ++s) w0 = MFMA32(bmp[s], pkq(vvq, s), w0);
#pragma unroll
            for (int s = 0; s < 2; ++s) u0 = MFMA32(tp[s], pk8(w0, s), u0);
#pragma unroll
            for (int s = 0; s < 2; ++s) { y0 = MFMA32(abp[s], pk8(u0, s), y0); y0 = MFMA32(akp[s], pkq(vvq, s), y0); }
            st_frag(P.U0F + ((unit * 2 + vt) * 64 + lane) * 8, u0);
            st_frag(P.YF + ((unit * 2 + vt) * 64 + lane) * 8, y0);
        }
    }
    f32x16 qT = zero16();
#pragma unroll
    for (int s = 0; s < 2; ++s) qT = MFMA32(frag_nat(Tt, 32, cl, s, hi), frag_nat(AbL, 32, cl, s, hi), qT);
    const bf16x8 qp0 = pk8(qT, 0), qp1 = pk8(qT, 1);
#pragma unroll
    for (int ct = 0; ct < 2; ++ct) {
        f32x16 zh = zero16(), rh;
#pragma unroll
        for (int r = 0; r < 16; ++r) { const unsigned w = rtT[ct * 8 + (r >> 1)]; rh[r] = (r & 1) ? bfhi(w) : bflo(w); }
        unsigned zq[8];
#pragma unroll
        for (int q = 0; q < 8; ++q) { const unsigned lo_ = Zi[crow(2 * q, hi) * RW_SP + 32 * ct + cl], hi_ = Zi[crow(2 * q + 1, hi) * RW_SP + 32 * ct + cl]; zq[q] = lo_ | (hi_ << 16); }
        zh = MFMA32(pkq(zq, 0), tp[0], zh); zh = MFMA32(pkq(zq, 1), tp[1], zh);
        rh = MFMA32(pkq(zq, 0), qp0, rh); rh = MFMA32(pkq(zq, 1), qp1, rh);
        bf16* zrow = P.ZH + (unit * 32 + cl) * 64; bf16* rrow = P.RH + (unit * 32 + cl) * 64;
#pragma unroll
        for (int g = 0; g < 4; ++g) {
            const int pos = 16 * (2 * ct + (g >> 1)) + 8 * hi + 4 * (g & 1);
            v2u a, c2; a.x = cvtpk(zh[4 * g], zh[4 * g + 1]); a.y = cvtpk(zh[4 * g + 2], zh[4 * g + 3]); c2.x = cvtpk(rh[4 * g], rh[4 * g + 1]); c2.y = cvtpk(rh[4 * g + 2], rh[4 * g + 3]);
            *(GAS v2u*)(zrow + pos) = a; *(GAS v2u*)(rrow + pos) = c2;
        }
    }
    LDS_WAIT();
}

constexpr int SC_SLOTS = 5, SC_PIECES = 28, SC_SLOT_BYTES = SC_PIECES * 1024, SC_FLAGS = SC_SLOTS * SC_SLOT_BYTES;
DI void rwkv_scan_wg(const RwkvC& P, int b, int h, int vt, LAS unsigned char* lds, int wave, int lane) {
    const int cl = lane & 31, hi = lane >> 5; (void)cl;
    volatile LAS unsigned* flg = (volatile LAS unsigned*)(lds + SC_FLAGS);
    if (wave == 0 && lane < 8) flg[lane] = 0u;
    __syncthreads();
    const unsigned unit0 = (unsigned)((b * NH + h) * RW_NCH);
    if (wave >= 1 && wave <= SC_SLOTS) {
        LAS unsigned char* slot = lds + (wave - 1) * SC_SLOT_BYTES + lane * 16;
#pragma unroll 1
        for (int ch = wave - 1; ch < RW_NCH; ch += SC_SLOTS) {
            const unsigned unit = unit0 + ch;
            v4u pc[SC_PIECES];
            const bf16* zrow = P.ZH + (unit * 32 + (lane & 31)) * 64 + 8 * hi; const bf16* rrow = P.RH + (unit * 32 + (lane & 31)) * 64 + 8 * hi;
#pragma unroll
            for (int S = 0; S < 4; ++S) { pc[S] = *(const GAS v4u*)(zrow + 16 * S); pc[4 + S] = *(const GAS v4u*)(rrow + 16 * S); }
#pragma unroll
            for (int ct = 0; ct < 2; ++ct)
#pragma unroll
                for (int s2 = 0; s2 < 2; ++s2) pc[8 + ct * 2 + s2] = *(const GAS v4u*)(P.BF + ((unit * 2 + ct) * 64 + lane) * 8 + 4 * s2);
#pragma unroll
            for (int s2 = 0; s2 < 2; ++s2) { pc[12 + s2] = *(const GAS v4u*)(P.U0F + ((unit * 2 + vt) * 64 + lane) * 8 + 4 * s2); pc[14 + s2] = *(const GAS v4u*)(P.YF + ((unit * 2 + vt) * 64 + lane) * 8 + 4 * s2); }
#pragma unroll
            for (int ct = 0; ct < 2; ++ct)
#pragma unroll
                for (int s2 = 0; s2 < 2; ++s2) pc[16 + ct * 2 + s2] = *(const GAS v4u*)(P.GF + (((unit * 2 + ct) * 2 + vt) * 64 + lane) * 8 + 4 * s2);
#pragma unroll
            for (int ct = 0; ct < 2; ++ct)
#pragma unroll
                for (int g = 0; g < 4; ++g) pc[20 + ct * 4 + g] = *(const GAS v4u*)(P.PLF + unit * 64 + 32 * ct + 8 * g + 4 * hi);
            while ((int)flg[SC_SLOTS] < ch - SC_SLOTS + 1) __builtin_amdgcn_s_sleep(1);
#pragma unroll
            for (int p = 0; p < SC_PIECES; ++p) *(LAS v4u*)(slot + p * 1024) = pc[p];
            LDS_WAIT();
            if (lane == 0) flg[wave - 1] = (unsigned)(ch + 1);
        }
    } else if (wave == 0) {
        f32x16 st[2] = {zero16(), zero16()};
#pragma unroll 1
        for (int ch = 0; ch < RW_NCH; ++ch) {
            const unsigned unit = unit0 + ch;
            const int sl = ch % SC_SLOTS;
            const LAS unsigned char* slot = lds + sl * SC_SLOT_BYTES + lane * 16;
            while (flg[sl] != (unsigned)(ch + 1)) __builtin_amdgcn_s_sleep(1);
            v4u pc[SC_PIECES];
#pragma unroll
            for (int p = 0; p < SC_PIECES; ++p) pc[p] = *(const LAS v4u*)(slot + p * 1024);
            LDS_WAIT();
            if (lane == 0) flg[SC_SLOTS] = (unsigned)(ch + 1);
            f32x16 U, Y, gg[2];
#pragma unroll
            for (int q = 0; q < 4; ++q) { U[2 * q] = bflo(pc[12][q]); U[2 * q + 1] = bfhi(pc[12][q]); U[8 + 2 * q] = bflo(pc[13][q]); U[8 + 2 * q + 1] = bfhi(pc[13][q]);
                                          Y[2 * q] = bflo(pc[14][q]); Y[2 * q + 1] = bfhi(pc[14][q]); Y[8 + 2 * q] = bflo(pc[15][q]); Y[8 + 2 * q + 1] = bfhi(pc[15][q]); }
#pragma unroll
            for (int ct = 0; ct < 2; ++ct)
#pragma unroll
                for (int q = 0; q < 4; ++q) { gg[ct][2 * q] = bflo(pc[16 + 2 * ct][q]); gg[ct][2 * q + 1] = bfhi(pc[16 + 2 * ct][q]); gg[ct][8 + 2 * q] = bflo(pc[17 + 2 * ct][q]); gg[ct][8 + 2 * q + 1] = bfhi(pc[17 + 2 * ct][q]); }
#pragma unroll
            for (int ct = 0; ct < 2; ++ct)
#pragma unroll
                for (int s2 = 0; s2 < 2; ++s2) { const bf16x8 sb = pk8(st[ct], s2); U = MFMA32(__builtin_bit_cast(bf16x8, pc[2 * ct + s2]), sb, U); Y = MFMA32(__builtin_bit_cast(bf16x8, pc[4 + 2 * ct + s2]), sb, Y); }
            st_frag(P.YF + ((unit * 2 + vt) * 64 + lane) * 8, Y);
            const bf16x8 ub0 = pk8(U, 0), ub1 = pk8(U, 1);
#pragma unroll
            for (int ct = 0; ct < 2; ++ct) {
                f32x16 ns;
#pragma unroll
                for (int g = 0; g < 4; ++g) { const v4u pw = pc[20 + ct * 4 + g];
                    ns[4 * g] = __uint_as_float(pw.x) * st[ct][4 * g] + gg[ct][4 * g]; ns[4 * g + 1] = __uint_as_float(pw.y) * st[ct][4 * g + 1] + gg[ct][4 * g + 1];
                    ns[4 * g + 2] = __uint_as_float(pw.z) * st[ct][4 * g + 2] + gg[ct][4 * g + 2]; ns[4 * g + 3] = __uint_as_float(pw.w) * st[ct][4 * g + 3] + gg[ct][4 * g + 3]; }
                ns = MFMA32(__builtin_bit_cast(bf16x8, pc[8 + 2 * ct]), ub0, ns); ns = MFMA32(__builtin_bit_cast(bf16x8, pc[8 + 2 * ct + 1]), ub1, ns);
                st[ct] = ns;
            }
        }
    }
    __syncthreads();
}

DI void rwkv_post_unit(const RwkvC& P, int b, int h, int ch, LAS unsigned char* lw_, int lane) {
    const int cl = lane & 31, hi = lane >> 5;
    const unsigned unit = (unsigned)((b * NH + h) * RW_NCH + ch);
    const unsigned row0 = (unsigned)(b * SEQ + ch * RW_L);
    LAS bf16* X1 = (LAS bf16*)lw_;
    f32x16 y[2], gt[2], vv[2];
#pragma unroll
    for (int vt = 0; vt < 2; ++vt) { y[vt] = ld_frag(P.YF + ((unit * 2 + vt) * 64 + lane) * 8); gt[vt] = ld_frag(P.GTF + ((unit * 2 + vt) * 64 + lane) * 8); vv[vt] = ld_frag(P.VFf + ((unit * 2 + vt) * 64 + lane) * 8); }
    const float lg0 = P.lnx_g[h * 64 + cl], lg1 = P.lnx_g[h * 64 + 32 + cl], lb0 = P.lnx_b[h * 64 + cl], lb1 = P.lnx_b[h * 64 + 32 + cl];
    f32x16 o0, o1;
#pragma unroll
    for (int r = 0; r < 16; ++r) {
        const float mean = half_sum(y[0][r] + y[1][r], lane) * (1.f / 64.f);
        const float d0 = y[0][r] - mean, d1 = y[1][r] - mean;
        const float var = half_sum(d0 * d0 + d1 * d1, lane) * (1.f / 64.f);
        const float rs = rsqrtf(var + LNX_EPS);
        const float bo = P.BON[(row0 + crow(r, hi)) * 8 + h];
        o0[r] = (d0 * rs * lg0 + lb0 + bo * vv[0][r]) * gt[0][r];
        o1[r] = (d1 * rs * lg1 + lb1 + bo * vv[1][r]) * gt[1][r];
    }
    stage_n(X1, o0, o1, cl, hi); LDS_WAIT();
#pragma unroll
    for (int i = 0; i < 4; ++i) { const int pc = lane + 64 * i, t = pc >> 3, q = pc & 7;
        const v4u w = *(const LAS v4u*)(X1 + t * RW_SP + 8 * q);
        *(GAS v4u*)(P.ymix + (row0 + t) * D + h * 64 + 8 * q) = w; }
    LDS_WAIT();
}
constexpr int NPHASE = 28;
#ifndef MK_SINGLE
#define MK_SINGLE 1
#endif
struct Args { const float* in[46]; float* out; unsigned char* ws; int ph_lo, ph_hi; };

DI unsigned char* opq(unsigned char* p) { GAS unsigned char* g = (GAS unsigned char*)p; asm volatile("" : "+s"(g)); return (unsigned char*)g; }
DI int opqs(int v) { asm volatile("" : "+s"(v)); return v; }
DI int opqv(int v) { asm volatile("" : "+v"(v)); return v; }
DI const float* inp(int i) { typedef const GAS float* gfp; const __attribute__((address_space(4))) gfp* t = (const __attribute__((address_space(4))) gfp*)__builtin_amdgcn_kernarg_segment_ptr(); asm volatile("" : "+s"(t)); return (const float*)t[i]; }

__global__ void __launch_bounds__(NWAVES * 64, 2) fwd_kernel(Args args) {
    extern __shared__ __attribute__((aligned(16))) unsigned char lds_raw[];
    LAS unsigned char* lds = (LAS unsigned char*)lds_raw;
    volatile LAS unsigned* MISC = (volatile LAS unsigned*)(lds + MISC_OFF);
    const int wave0 = __builtin_amdgcn_readfirstlane((int)threadIdx.x >> 6);
    const int G0 = gridDim.x, blk0 = blockIdx.x;
#define PHV const int lane = opqv(lane_id()), blk = opqs(blk0), G = opqs(G0), wave = opqs(wave0), tid = wave * 64 + lane, gw = blk * NWAVES + wave, NGW = G * NWAVES; (void)tid; (void)lane; (void)gw; (void)NGW; (void)wave
    unsigned char* ws0 = args.ws;
#define ws opq(ws0)
#define ctl ((unsigned*)(ws + WS_CTL))
    for (int u = wave0 * 64 + lane_id(); u < (LDS_BYTES - MISC_OFF) / 4; u += NWAVES * 64) ((LAS unsigned*)(lds + MISC_OFF))[u] = 0u;
    __syncthreads();
#if MK_SINGLE
    constexpr int lo = 0, hi = NPHASE;
#else
    const int lo = args.ph_lo, hi = args.ph_hi;
#endif
    if (hi - lo > 1) (void)xcd_barrier_post(ctl + CW_BAR, MISC + 8, wave0 * 64 + lane_id());
#ifndef PHMASK
#define PHMASK 0xFFFFFFF
#endif
#define IN(k) (((PHMASK >> (k)) & 1) && lo <= (k) && (k) < hi)
#ifndef GEMM_REP
#define GEMM_REP 1
#endif
#define GRID_BAR() do { XcdBarrier bb_; bb_.bar = ctl + CW_BAR; bb_.x = xb_xcc_id(); bb_.st = MISC + 8; xcd_barrier(bb_, opqs(wave0) * 64 + opqv(lane_id())); } while (0)
#define GEMM_RUN(...) do { __VA_ARGS__; if (GEMM_REP > 1) { GRID_BAR(); __VA_ARGS__; } } while (0)
#ifndef PROBE_MASK
#define PROBE_MASK 0u
#endif
    unsigned long long tph_ = PROBE_MASK ? __builtin_amdgcn_s_memrealtime() : 0ull;
#define SEAM(k) do { if (IN(k) && IN((k) + 1)) { XcdBarrier bb_; bb_.bar = ctl + CW_BAR; bb_.x = xb_xcc_id(); bb_.st = MISC + 8; xcd_barrier(bb_, opqs(wave0) * 64 + opqv(lane_id())); \
        if (PROBE_MASK) { const unsigned long long t1_ = __builtin_amdgcn_s_memrealtime(); if ((PROBE_MASK >> (k)) & 1u) { while (__builtin_amdgcn_s_memrealtime() - t1_ < t1_ - tph_) __builtin_amdgcn_s_sleep(8); } tph_ = __builtin_amdgcn_s_memrealtime(); } } } while (0)

#define B_HN ((bf16*)(ws + WS_HN))
#define B_YMIX ((bf16*)(ws + WS_YMIX))
#define B_VF ((bf16*)(ws + WS_VF))
#define B_PA ((bf16*)(ws + WS_PA))
#define B_PB ((bf16*)(ws + WS_PB))
#define B_Y ((bf16*)(ws + WS_Y))
    float* xo = args.out;
#define x_in inp(0)

    if (IN(0)) { PHV;
        LAS float* scr = (LAS float*)(lds + wave * 16384);
        conv_matrix<1>(inp(2), D, 3232, (bf16*)(ws + WS_WIN0), 1696, scr, gw, NGW, lane);
        conv_matrix<1>(inp(23), D, 3264, (bf16*)(ws + WS_WIN1), 1728, scr, gw, NGW, lane);
        zero_rows((bf16*)(ws + WS_WIN0), D, 1696, NA, gw, NGW, lane);
        zero_rows((bf16*)(ws + WS_WIN1), D, 1728, NA, gw, NGW, lane);
        conv_matrix<0>(inp(15), D, D, (bf16*)(ws + WS_WOUT0), 0, scr, gw, NGW, lane);
        conv_matrix<0>(inp(38), D, D, (bf16*)(ws + WS_WOUT1), 0, scr, gw, NGW, lane);
        conv_matrix<2>(inp(18), D, FF, (bf16*)(ws + WS_WGU0), 0, scr, gw, NGW, lane);
        conv_matrix<3>(inp(19), D, FF, (bf16*)(ws + WS_WGU0), 0, scr, gw, NGW, lane);
        conv_matrix<0>(inp(20), FF, D, (bf16*)(ws + WS_WDN0), 0, scr, gw, NGW, lane);
        phase_norm0(x_in, inp(1), B_HN, gw, NGW, lane);
        {
            bf16* upt = (bf16*)(ws + WS_UPT);
            for (int i = gw * 64 + lane; i < 2 * 8 * 12288; i += NGW * 64) {
                const int l2 = i / (8 * 12288), rem = i % (8 * 12288), hh = rem / 12288, e = rem % 12288;
                float val = 0.f;
                if (e < 2048) { const int c = e >> 5, k = e & 31; val = inp(l2 ? 26 : 5)[k * 512 + hh * 64 + c]; }
                else if (e < 4096) { const int c = (e - 2048) >> 5, k = e & 31; val = inp(l2 ? 28 : 7)[k * 512 + hh * 64 + c]; }
                else if (e < 6144) { const int c = (e - 4096) >> 5, k = e & 31; if (l2) val = inp(31)[k * 512 + hh * 64 + c]; }
                else { const int c = (e - 6144) / 96, k = (e - 6144) % 96; val = inp(l2 ? 29 : 8)[k * 512 + hh * 64 + c]; }
                upt[i] = f2bf(val);
            }
        }
    }
    SEAM(0);

#pragma unroll
    for (int l = 0; l < 2; ++l) {
        const int pb = l ? 10 : 1;
        if (IN(pb)) { PHV;
            pg8::Gemm g{B_HN, (const bf16*)(ws + (l ? WS_WIN1 : WS_WIN0)), M, NPROJ, D}; pg8::StaticOrder S; S.init(M, NPROJ, G, blk);
            pg8::EpiProj E{B_PA, B_PB};
            GEMM_RUN(pg8::gemm_phase<pg8::EpiProj, pg8::StaticOrder, true, true>(lds, g, S, E, tid));
        }
        SEAM(pb);
#define RWKV_SETUP \
            RwkvC P; { const int o = l ? 21 : 0, o2 = l ? 23 : 0; unsigned char* w_ = ws; \
            P.PA = (const bf16*)(w_ + WS_PA); P.mu = inp(3 + o); P.decay0 = inp(4 + o); P.iclr0 = inp(6 + o); P.vres0 = inp(30); \
            P.k_k = inp(9 + o2); P.k_a = inp(10 + o2); P.r_k = inp(11 + o2); P.lnx_g = inp(12 + o2); P.lnx_b = inp(13 + o2); \
            P.upT = (const bf16*)(w_ + WS_UPT) + (size_t)l * 8 * 12288; P.VFf = (unsigned*)(w_ + WS_VF); P.ZH = (bf16*)(w_ + WS_ZH); P.RH = (bf16*)(w_ + WS_RH); \
            P.BF = (unsigned*)(w_ + WS_BF); P.U0F = (unsigned*)(w_ + WS_U0F); P.YF = (unsigned*)(w_ + WS_YF); P.GTF = (unsigned*)(w_ + WS_GTF); P.GF = (unsigned*)(w_ + WS_GF); \
            P.PLF = (float*)(w_ + WS_PLF); P.BON = (float*)(w_ + WS_BON); P.ymix = (bf16*)(w_ + WS_YMIX); P.has_vres = l; }
        if (IN(pb + 1)) { PHV;
            RWKV_SETUP
            for (int u = blk; u < NBATCH * RW_NCH; u += G) rwkv_pre_unit(P, u / RW_NCH, wave, u % RW_NCH, lds + wave * RW_WAVE_LDS, lane_id());
        }
        SEAM(pb + 1);
        if (IN(pb + 2)) { PHV;
            const bool split = G >= 128;
            if (!split || blk < 64) {
                { RWKV_SETUP
                    for (int cid = blk; cid < 64; cid += G) rwkv_scan_wg(P, cid >> 4, (cid >> 1) & 7, cid & 1, lds, wave, lane); }
            }
            if (!split || blk >= 64) {
                const float* sbg = inp(14 + (l ? 23 : 0));
                const int sbw = split ? G - 64 : G, sbi = split ? blk - 64 : blk;
                for (int u = sbi; u < NBATCH * NH * (SEQ / 256); u += sbw) {
                    const int qb = u & 31, bh = u >> 5;
                    sb_wave(B_PB, B_YMIX, sbg, bh >> 3, bh & 7, qb * 256 + wave * 32, lds + wave * 8192, lane_id());
                }
            }
        }
        SEAM(pb + 2);
        if (IN(pb + 3)) { PHV;
            RWKV_SETUP
            for (int u = blk; u < NBATCH * RW_NCH; u += G) rwkv_post_unit(P, u / RW_NCH, wave, u % RW_NCH, lds + wave * RW_WAVE_LDS, lane_id());
        }
        SEAM(pb + 3);
        if (IN(pb + 4)) { PHV;
            pg8::Gemm g{B_YMIX, (const bf16*)(ws + (l ? WS_WOUT1 : WS_WOUT0)), M, D, D}; pg8::StaticOrder S; S.init(M, D, G, blk);
            pg8::EpiBf16Plain E{B_Y, D};
            GEMM_RUN(pg8::gemm_phase<pg8::EpiBf16Plain, pg8::StaticOrder, true, true>(lds, g, S, E, tid));
        }
        SEAM(pb + 4);
        if (IN(pb + 5)) { PHV;
            if (l == 0) phase_resnorm<false>(x_in, B_Y, nullptr, inp(16), inp(17), xo, (bf16*)(ws + WS_HNF0), nullptr, nullptr, nullptr, nullptr, gw, NGW, lane);
            else phase_resnorm<false>(xo, B_Y, nullptr, inp(39), inp(40), xo, (bf16*)(ws + WS_HNF1), inp(41), (unsigned*)(ws + WS_SEL), (float*)(ws + WS_GTS), ctl + CW_TOT, gw, NGW, lane);
        }
        SEAM(pb + 5);
    if (l == 0) {
        if (IN(7)) { PHV;
            pg8::Gemm g{(const bf16*)(ws + WS_HNF0), (const bf16*)(ws + WS_WGU0), M, 2 * FF, D}; pg8::StaticOrder S; S.init(M, 2 * FF, G, blk);
            pg8::EpiSwiglu E{(bf16*)(ws + WS_H0), FF, 0};
            GEMM_RUN(pg8::gemm_phase<pg8::EpiSwiglu, pg8::StaticOrder, true, true>(lds, g, S, E, tid));
        }
        SEAM(7);
        if (IN(8)) { PHV;
            pg8::Gemm g{(const bf16*)(ws + WS_H0), (const bf16*)(ws + WS_WDN0), M, D, FF}; pg8::StaticOrder S; S.init(M, D, G, blk);
            pg8::EpiBf16Plain E{(bf16*)(ws + WS_F), D};
            GEMM_RUN(pg8::gemm_phase<pg8::EpiBf16Plain, pg8::StaticOrder, true, true>(lds, g, S, E, tid));
        }
        SEAM(8);
        if (IN(9)) { PHV; phase_resnorm<false>(xo, (const bf16*)(ws + WS_F), nullptr, inp(21), inp(22), xo, B_HN, nullptr, nullptr, nullptr, nullptr, gw, NGW, lane); }
        SEAM(9);
    } else {
        if (IN(16)) { PHV;
            LAS float* scr = (LAS float*)(lds + wave * 16384);
#pragma unroll 1
            for (int e = 0; e < NE; ++e) {
                conv_matrix<2>(inp(42) + (size_t)e * D * FF, D, FF, (bf16*)(ws + WS_WMGU) + (size_t)e * 2 * FF * D, 0, scr, gw, NGW, lane);
                conv_matrix<3>(inp(43) + (size_t)e * D * FF, D, FF, (bf16*)(ws + WS_WMGU) + (size_t)e * 2 * FF * D, 0, scr, gw, NGW, lane);
                conv_matrix<0>(inp(44) + (size_t)e * D * FF, FF, D, (bf16*)(ws + WS_WMDN) + (size_t)e * D * FF, 0, scr, gw, NGW, lane);
            }
            phase_moe_sort((const unsigned*)(ws + WS_SEL), (const float*)(ws + WS_GTS), ctl + CW_TOT, ctl + CW_CUR, (unsigned*)(ws + WS_POS), (float*)(ws + WS_GSORT), (const bf16*)(ws + WS_HNF1), (bf16*)(ws + WS_HS), gw, NGW, lane);
        }
        SEAM(16);
#pragma unroll 1
        for (int p = 0; p < MOE_PARTS; ++p) {
            const int phg = 17 + 2 * p;
            if (IN(phg) || IN(phg + 1)) {
                PHV;
                int mytot; const int myoff = moe_offsets(ctl + CW_TOT, lane, mytot);
                pg8::MoeOrder S;
                const int nTiles = __builtin_amdgcn_readfirstlane(shi(myoff, 8)) >> 8;
                S.ts1 = __builtin_amdgcn_readfirstlane(shi(myoff, 1)) >> 8; S.ts2 = __builtin_amdgcn_readfirstlane(shi(myoff, 2)) >> 8; S.ts3 = __builtin_amdgcn_readfirstlane(shi(myoff, 3)) >> 8;
                S.ts4 = __builtin_amdgcn_readfirstlane(shi(myoff, 4)) >> 8; S.ts5 = __builtin_amdgcn_readfirstlane(shi(myoff, 5)) >> 8; S.ts6 = __builtin_amdgcn_readfirstlane(shi(myoff, 6)) >> 8;
                S.ts7 = __builtin_amdgcn_readfirstlane(shi(myoff, 7)) >> 8;
                const int t0 = p * MOE_PART_TILES; int nT = nTiles - t0; nT = nT < 0 ? 0 : (nT > MOE_PART_TILES ? MOE_PART_TILES : nT);
                S.t0 = t0; S.nT = nT; S.G = G; S.c = blk;
                if (IN(phg)) { PHV;
                    S.nN = 2 * FF / 256; S.nwg = nT * S.nN; S.nNe = 2 * FF / 256; S.arel = 0;
                    pg8::Gemm g{(const bf16*)(ws + WS_HS), (const bf16*)(ws + WS_WMGU), 0, 0, D};
                    pg8::EpiSwiglu E{(bf16*)(ws + WS_HP), FF, -(long)t0 * 256};
                    GEMM_RUN(pg8::gemm_phase<pg8::EpiSwiglu, pg8::MoeOrder, true, true>(lds, g, S, E, tid));
                }
                SEAM(phg);
                if (IN(phg + 1)) { PHV;
                    S.nN = D / 256; S.nwg = nT * S.nN; S.nNe = D / 256; S.arel = 1;
                    pg8::Gemm g{(const bf16*)(ws + WS_HP), (const bf16*)(ws + WS_WMDN), 0, 0, FF};
                    pg8::EpiMoeDown E{(bf16*)(ws + WS_HS), D, (const float*)(ws + WS_GSORT)};
                    GEMM_RUN(pg8::gemm_phase<pg8::EpiMoeDown, pg8::MoeOrder, true, true>(lds, g, S, E, tid));
                }
                SEAM(phg + 1);
            }
        }
        if (IN(27)) { PHV; phase_resnorm<true>(xo, (const bf16*)(ws + WS_HS), (const unsigned*)(ws + WS_POS), inp(45), nullptr, xo, nullptr, nullptr, nullptr, nullptr, nullptr, gw, NGW, lane); }
    }
    }
#undef IN
#undef SEAM
#undef x_in
#undef PHV
#undef ws
#undef ctl
#undef B_HN
#undef B_YMIX
#undef B_VF
#undef B_PA
#undef B_PB
#undef B_Y
}

extern "C" void kernel_launch(void* const* d_in, const int* in_sizes, int n_in, void* d_out, int out_size, void* d_ws, size_t ws_size, hipStream_t stream) {
    static int grid = 0;
    if (grid == 0) {
        if (n_in != 46 || in_sizes[0] != M * D || out_size != M * D || ws_size < WS_END) { fprintf(stderr, "kernel_launch: unexpected problem: n_in %d in0 %d out %d ws %zu (need %zu)\n", n_in, n_in > 0 ? in_sizes[0] : -1, out_size, ws_size, (size_t)WS_END); grid = -1; return; }
        int dev = 0, cus = 0, per_cu = 0;
        if (hipGetDevice(&dev) != hipSuccess || hipDeviceGetAttribute(&cus, hipDeviceAttributeMultiprocessorCount, dev) != hipSuccess) { grid = -1; return; }
        if (hipFuncSetAttribute((const void*)fwd_kernel, hipFuncAttributeMaxDynamicSharedMemorySize, LDS_BYTES) != hipSuccess) { fprintf(stderr, "kernel_launch: hipFuncSetAttribute failed\n"); grid = -1; return; }
        if (hipOccupancyMaxActiveBlocksPerMultiprocessor(&per_cu, (const void*)fwd_kernel, NWAVES * 64, LDS_BYTES) != hipSuccess || per_cu < 1) { fprintf(stderr, "kernel_launch: occupancy query says %d\n", per_cu); }
        (void)hipGetLastError();
        grid = cus;
    }
    if (grid < 0) return;
    (void)hipMemsetAsync((char*)d_ws + WS_CTL, 0, CTL_ZERO_BYTES, stream);
    Args a{};
    for (int i = 0; i < 46; ++i) a.in[i] = (const float*)d_in[i];
    a.out = (float*)d_out; a.ws = (unsigned char*)d_ws;
#if MK_SINGLE
    a.ph_lo = 0; a.ph_hi = NPHASE;
    hipLaunchKernelGGL(fwd_kernel, dim3(grid), dim3(NWAVES * 64), LDS_BYTES, stream, a);
#else
    for (int p = 0; p < NPHASE; ++p) { a.ph_lo = p; a.ph_hi = p + 1; hipLaunchKernelGGL(fwd_kernel, dim3(grid), dim3(NWAVES * 64), LDS_BYTES, stream, a); }
#endif
}
```

```cpp
#include <hip/hip_runtime.h>
#include <cstdio>
#include <cstdint>
namespace pg8 {
#define PG8_LAS __attribute__((address_space(3)))
typedef unsigned short bf16_t;
typedef short bf16x8 __attribute__((ext_vector_type(8)));
typedef float f32x4 __attribute__((ext_vector_type(4)));
typedef unsigned u32x4 __attribute__((ext_vector_type(4)));
constexpr int BM = 256, BK = 64, HALF = 128, HTB = HALF * BK * 2  , STAGE_BYTES = 8 * HTB, NXCD = 8, WGM = 8;

__host__ __device__ __forceinline__ int lds_byte(int r, int c) { const int st = (r >> 4) * 2 + (c >> 5), rr = r & 15, cc = c & 31, ob = rr * 64 + cc * 2; return st * 1024 + (ob ^ (((ob >> 9) & 1) << 5)); }
__host__ __device__ __forceinline__ void stage_rc(int b, int& R, int& C) { const int st = b / 1024, sb = b % 1024, swz = sb ^ (((sb >> 9) & 1) << 5); R = (st >> 1) * 16 + swz / 64; C = (st & 1) * 32 + (swz % 64) / 2; }
__host__ __device__ __forceinline__ int perm32(int rho) { const int n = rho >> 4, i = rho & 15; return 8 * (i >> 2) + 4 * n + (i & 3); }

struct Unit { int pm, pa, pn, po; };
struct Gemm { const bf16_t* A; const bf16_t* Bt; int M, N, K; };

struct StaticOrder {
    int nM, nN, nwg, G, c;
    __host__ __device__ void init(int M, int N, int G_, int c_) { nM = M / BM; nN = N / BM; nwg = nM * nN; G = G_; c = c_; }
    __host__ __device__ bool next(int i, Unit& u) const {
        const long L = (long)i * G + c; if (L >= nwg) return false;
        int wgid = (int)L; { const int q = nwg / NXCD, r = nwg % NXCD, xcd = wgid % NXCD, off = wgid / NXCD; wgid = (xcd < r ? xcd * (q + 1) : r * (q + 1) + (xcd - r) * q) + off; }
        const int nig = WGM * nN, gid = wgid / nig, fm = gid * WGM, gsz = (nM - fm) < WGM ? (nM - fm) : WGM;
        u.pm = fm + ((wgid % nig) % gsz); u.pn = (wgid % nig) / gsz; u.pa = u.pm; u.po = u.pn; return true;
    }
    __device__ __forceinline__ void a_ready(const Unit&) const {}
    __device__ __forceinline__ void done(const Unit&) const {}
};

__device__ __forceinline__ unsigned cvt_pk_bf16(float lo, float hi) { unsigned r; asm volatile("v_cvt_pk_bf16_f32 %0, %1, %2" : "=v"(r) : "v"(lo), "v"(hi)); return r; }
typedef float f32x2 __attribute__((ext_vector_type(2)));

template <class Epi, class Sched, bool ALIGN_EPI = false, bool SP2 = false, bool SWAP = false>
__device__ __forceinline__ void gemm_phase(PG8_LAS unsigned char* lds, const Gemm g, const Sched& S, const Epi& E, int tid_in) {
    int tid_ = tid_in; asm volatile("" : "+v"(tid_));
    const int tid = tid_, wid = __builtin_amdgcn_readfirstlane(tid >> 6), lane = tid & 63, wr = wid >> 2, wc = wid & 3, fr = lane & 15, fq = lane >> 4;
    const int K = g.K, nt = K / BK;
    unsigned voffA[2], voffB[2];
#pragma unroll
    for (int i = 0; i < 2; ++i) { int R, C; stage_rc(tid * 16 + i * 8192, R, C); const int Rb = Epi::PERM ? ((R & ~31) + perm32(R & 31)) : R;
        voffA[i] = (unsigned)(R * K + C) * 2u; voffB[i] = (unsigned)(Rb * K + C) * 2u; }
    const size_t kstep = (size_t)(BK * 2);
    const size_t hstep = (size_t)HALF * K * 2;
    const size_t tstep = 2 * hstep;
    const unsigned ldsw = (unsigned)wid * 1024u;
    const int aoff = lds_byte(wr * 64 + fr, fq * 8), boff = lds_byte(wc * 32 + fr, fq * 8);
#define PG8_SA(b, h) (((b) * 2 + (h)) * HTB)
#define PG8_SB(b, h) ((4 + (b) * 2 + (h)) * HTB)
#define PG8_STAGE(bufoff, gbase, voff) do { _Pragma("unroll") for (int _i = 0; _i < 2; ++_i) \
        __builtin_amdgcn_global_load_lds((const unsigned*)((const char*)(gbase) + (voff)[_i]), (PG8_LAS unsigned*)(lds + (bufoff) + ldsw + _i * 8192), 16, 0, 0); } while (0)
#define PG8_LDA(dst, b, h) do { _Pragma("unroll") for (int m = 0; m < 4; ++m) _Pragma("unroll") for (int k = 0; k < 2; ++k) dst[m][k] = *(const PG8_LAS bf16x8*)(lds + PG8_SA(b, h) + aoff + m * 2048 + k * 1024); } while (0)
#define PG8_LDB(dst, b, h) do { _Pragma("unroll") for (int n = 0; n < 2; ++n) _Pragma("unroll") for (int k = 0; k < 2; ++k) dst[n][k] = *(const PG8_LAS bf16x8*)(lds + PG8_SB(b, h) + boff + n * 2048 + k * 1024); } while (0)
#define PG8_MMA(ai, bj, At, Bt) do { __builtin_amdgcn_s_setprio(1); _Pragma("unroll") for (int m = 0; m < 4; ++m) _Pragma("unroll") for (int n = 0; n < 2; ++n) _Pragma("unroll") for (int k = 0; k < 2; ++k) \
        acc[ai][bj][m][n] = SWAP ? __builtin_amdgcn_mfma_f32_16x16x32_bf16(At[m][k], Bt[n][k], acc[ai][bj][m][n], 0, 0, 0) : __builtin_amdgcn_mfma_f32_16x16x32_bf16(Bt[n][k], At[m][k], acc[ai][bj][m][n], 0, 0, 0); __builtin_amdgcn_s_setprio(0); } while (0)
#define PG8_WAIT_V(n) asm volatile("s_waitcnt vmcnt(" #n ")" ::: "memory")
#define PG8_WAIT_L(n) asm volatile("s_waitcnt lgkmcnt(" #n ")" ::: "memory")
#define PG8_BAR __builtin_amdgcn_s_barrier()
#define PG8_SCHED __builtin_amdgcn_sched_barrier(0)
    Unit cur, nxt; int ui = 0;
    if (!S.next(0, cur)) return;
    f32x4 acc[2][2][4][2];
#pragma unroll
    for (int a = 0; a < 2; ++a)
#pragma unroll
        for (int b = 0; b < 2; ++b)
#pragma unroll
            for (int m = 0; m < 4; ++m)
#pragma unroll
                for (int n = 0; n < 2; ++n) acc[a][b][m][n] = (f32x4){0.f, 0.f, 0.f, 0.f};
    bf16x8 At[4][2], B0[2][2], B1[2][2];
    const char* cA = (const char*)g.A + (size_t)cur.pa * tstep; const char* cB = (const char*)g.Bt + (size_t)cur.pn * tstep;
    S.a_ready(cur);
    if constexpr (SP2) {
        PG8_STAGE(PG8_SB(0, 0), cB, voffB); PG8_STAGE(PG8_SB(0, 1), cB + hstep, voffB); PG8_STAGE(PG8_SA(0, 0), cA, voffA); PG8_STAGE(PG8_SA(0, 1), cA + hstep, voffA);
        if (wr == 1) PG8_BAR;
        PG8_WAIT_V(2); PG8_BAR;
        PG8_STAGE(PG8_SB(1, 0), cB + kstep, voffB); PG8_STAGE(PG8_SA(1, 0), cA + kstep, voffA); PG8_STAGE(PG8_SB(1, 1), cB + hstep + kstep, voffB);
        PG8_WAIT_V(6); PG8_BAR;
    } else {
        PG8_STAGE(PG8_SB(0, 0), cB, voffB); PG8_STAGE(PG8_SA(0, 0), cA, voffA); PG8_STAGE(PG8_SB(0, 1), cB + hstep, voffB); PG8_STAGE(PG8_SA(0, 1), cA + hstep, voffA);
        if (wr == 1) PG8_BAR;
        PG8_WAIT_V(4); PG8_BAR;
        PG8_STAGE(PG8_SB(1, 0), cB + kstep, voffB); PG8_STAGE(PG8_SA(1, 0), cA + kstep, voffA); PG8_STAGE(PG8_SB(1, 1), cB + hstep + kstep, voffB);
        PG8_WAIT_V(6); PG8_BAR;
    }
    for (;;) {
        const bool has_next = S.next(ui + 1, nxt);
        const char* nA = has_next ? (const char*)g.A + (size_t)nxt.pa * tstep : cA; const char* nB = has_next ? (const char*)g.Bt + (size_t)nxt.pn * tstep : cB;
        for (int t = 0; t < nt; t += 2) {
            const bool last = (t == nt - 2);
            const char* a1 = cA + (size_t)(t + 1) * kstep;
            const char* a2 = last ? nA : cA + (size_t)(t + 2) * kstep; const char* b2 = last ? nB : cB + (size_t)(t + 2) * kstep;
            const char* a3 = a2 + kstep; const char* b3 = b2 + kstep;
            if (last && has_next) S.a_ready(nxt);
            if constexpr (SP2) {
            PG8_LDB(B0, 0, 0); PG8_LDB(B1, 0, 1); PG8_SCHED; PG8_LDA(At, 0, 0); PG8_STAGE(PG8_SA(1, 1), a1 + hstep, voffA);
            PG8_WAIT_V(8); PG8_WAIT_L(0); PG8_BAR; PG8_MMA(0, 0, At, B0); PG8_MMA(0, 1, At, B1); PG8_BAR; PG8_SCHED;
            PG8_LDA(At, 0, 1); PG8_STAGE(PG8_SB(0, 0), b2, voffB); PG8_STAGE(PG8_SB(0, 1), b2 + hstep, voffB); PG8_STAGE(PG8_SA(0, 0), a2, voffA);
            PG8_WAIT_V(8); PG8_WAIT_L(0); PG8_BAR; PG8_MMA(1, 0, At, B0); PG8_MMA(1, 1, At, B1); PG8_BAR; PG8_SCHED;
            PG8_LDB(B0, 1, 0); PG8_LDB(B1, 1, 1); PG8_SCHED; PG8_LDA(At, 1, 0); PG8_STAGE(PG8_SA(0, 1), a2 + hstep, voffA);
            PG8_WAIT_V(8); PG8_WAIT_L(0); PG8_BAR; PG8_MMA(0, 0, At, B0); PG8_MMA(0, 1, At, B1); PG8_BAR; PG8_SCHED;
            PG8_LDA(At, 1, 1); PG8_STAGE(PG8_SB(1, 0), b3, voffB); PG8_STAGE(PG8_SB(1, 1), b3 + hstep, voffB); PG8_STAGE(PG8_SA(1, 0), a3, voffA);
            PG8_WAIT_V(8); PG8_WAIT_L(0); PG8_BAR; PG8_MMA(1, 0, At, B0); PG8_MMA(1, 1, At, B1); PG8_BAR; PG8_SCHED;
            } else {
            PG8_LDB(B0, 0, 0); PG8_SCHED; PG8_LDA(At, 0, 0); PG8_STAGE(PG8_SA(1, 1), a1 + hstep, voffA);
            PG8_WAIT_L(8); PG8_BAR; PG8_WAIT_L(0); PG8_MMA(0, 0, At, B0); PG8_BAR; PG8_SCHED;
            PG8_LDB(B1, 0, 1); PG8_STAGE(PG8_SB(0, 0), b2, voffB);
            PG8_BAR; PG8_WAIT_L(0); PG8_MMA(0, 1, At, B1); PG8_BAR;
            PG8_LDA(At, 0, 1); PG8_STAGE(PG8_SA(0, 0), a2, voffA);
            PG8_BAR; PG8_WAIT_L(0); PG8_MMA(1, 0, At, B0); PG8_BAR; PG8_SCHED;
            PG8_STAGE(PG8_SB(0, 1), b2 + hstep, voffB);
            PG8_WAIT_V(6); PG8_BAR; PG8_MMA(1, 1, At, B1); PG8_BAR;
            PG8_LDB(B0, 1, 0); PG8_SCHED; PG8_LDA(At, 1, 0); PG8_STAGE(PG8_SA(0, 1), a2 + hstep, voffA);
            PG8_WAIT_L(8); PG8_BAR; PG8_WAIT_L(0); PG8_MMA(0, 0, At, B0); PG8_BAR; PG8_SCHED;
            PG8_LDB(B1, 1, 1); PG8_STAGE(PG8_SB(1, 0), b3, voffB);
            PG8_BAR; PG8_WAIT_L(0); PG8_MMA(0, 1, At, B1); PG8_BAR;
            PG8_LDA(At, 1, 1); PG8_STAGE(PG8_SA(1, 0), a3, voffA);
            PG8_BAR; PG8_WAIT_L(0); PG8_MMA(1, 0, At, B0); PG8_BAR; PG8_SCHED;
            PG8_STAGE(PG8_SB(1, 1), b3 + hstep, voffB);
            PG8_WAIT_V(6); PG8_BAR; PG8_MMA(1, 1, At, B1); PG8_BAR;
            }
        }
        if constexpr (ALIGN_EPI) { if (wr == 0) PG8_BAR; }
        if constexpr (!Epi::AFTER_DRAIN) { E(acc, cur, wr, wc, fr, fq); S.done(cur); }
        if (!has_next) break;
#pragma unroll
        for (int a = 0; a < 2; ++a)
#pragma unroll
            for (int b = 0; b < 2; ++b)
#pragma unroll
                for (int m = 0; m < 4; ++m)
#pragma unroll
                    for (int n = 0; n < 2; ++n) acc[a][b][m][n] = (f32x4){0.f, 0.f, 0.f, 0.f};
        cur = nxt; cA = nA; cB = nB; ++ui;
        if constexpr (ALIGN_EPI) { if (wr == 1) PG8_BAR; }
    }
    PG8_WAIT_V(0);
    if constexpr (!ALIGN_EPI) { if (wr == 0) PG8_BAR; }
    PG8_BAR;
    if constexpr (Epi::AFTER_DRAIN) { E.fused(acc, cur, wr, wc, fr, fq, lds, wid, lane); S.done(cur); }
#undef PG8_SA
#undef PG8_SB
#undef PG8_STAGE
#undef PG8_LDA
#undef PG8_LDB
#undef PG8_MMA
#undef PG8_WAIT_V
#undef PG8_WAIT_L
#undef PG8_BAR
#undef PG8_SCHED
}
}
namespace pg8 {
struct EpiProjT {
    static constexpr bool PERM = false, AFTER_DRAIN = false;
    bf16_t* PAT;
    __device__ __forceinline__ void operator()(const f32x4 (&acc)[2][2][4][2], const Unit& u, int wr, int wc, int fr, int fq) const {
        const unsigned row0 = (unsigned)(u.pm * BM + wr * 64 + 4 * fq), col0 = (unsigned)(u.po * BM + wc * 32 + fr);
#pragma unroll
        for (int ai = 0; ai < 2; ++ai)
#pragma unroll
            for (int m = 0; m < 4; ++m) { const unsigned t0 = row0 + ai * HALF + m * 16;
#pragma unroll
                for (int bj = 0; bj < 2; ++bj)
#pragma unroll
                    for (int n = 0; n < 2; ++n) { const unsigned nc = col0 + bj * HALF + n * 16; const f32x4 v = acc[ai][bj][m][n];
                        typedef unsigned u32x2 __attribute__((ext_vector_type(2))); u32x2 w; w.x = cvt_pk_bf16(v[0], v[1]); w.y = cvt_pk_bf16(v[2], v[3]);
                        *(u32x2*)(PAT + (((t0 >> 5) * 1536u + nc) * 32u + (t0 & 31u))) = w; } }
    }
};
struct EpiProj {
    static constexpr bool PERM = true, AFTER_DRAIN = false;
    bf16_t* PAS; bf16_t* PB;
    __device__ __forceinline__ void operator()(const f32x4 (&acc)[2][2][4][2], const Unit& u, int wr, int wc, int fr, int fq) const {
        const int row0 = u.pm * BM + wr * 64 + fr;
        bf16_t* base; int ldc, colt;
        if (u.po < 1) { base = PAS; ldc = 256; colt = 0; } else { base = PB; ldc = 1536; colt = (u.po - 1) * BM; }
        const int col0 = colt + wc * 32 + 8 * fq;
#pragma unroll
        for (int ai = 0; ai < 2; ++ai)
#pragma unroll
            for (int m = 0; m < 4; ++m) { bf16_t* rowp = base + (size_t)(row0 + ai * HALF + m * 16) * ldc + col0;
#pragma unroll
                for (int bj = 0; bj < 2; ++bj) { const f32x4 v0 = acc[ai][bj][m][0], v1 = acc[ai][bj][m][1];
                    u32x4 w; w.x = cvt_pk_bf16(v0[0], v0[1]); w.y = cvt_pk_bf16(v0[2], v0[3]); w.z = cvt_pk_bf16(v1[0], v1[1]); w.w = cvt_pk_bf16(v1[2], v1[3]);
                    *(u32x4*)(rowp + bj * HALF) = w; } }
    }
};
struct EpiBf16Plain {
    static constexpr bool PERM = true, AFTER_DRAIN = false;
    bf16_t* O; int ldc;
    __device__ __forceinline__ void operator()(const f32x4 (&acc)[2][2][4][2], const Unit& u, int wr, int wc, int fr, int fq) const {
        const int row0 = u.pm * BM + wr * 64 + fr;
        const int col0 = u.po * BM + wc * 32 + 8 * fq;
#pragma unroll
        for (int ai = 0; ai < 2; ++ai)
#pragma unroll
            for (int m = 0; m < 4; ++m) { bf16_t* rowp = O + (size_t)(row0 + ai * HALF + m * 16) * ldc + col0;
#pragma unroll
                for (int bj = 0; bj < 2; ++bj) { const f32x4 v0 = acc[ai][bj][m][0], v1 = acc[ai][bj][m][1];
                    u32x4 w; w.x = cvt_pk_bf16(v0[0], v0[1]); w.y = cvt_pk_bf16(v0[2], v0[3]); w.z = cvt_pk_bf16(v1[0], v1[1]); w.w = cvt_pk_bf16(v1[2], v1[3]);
                    *(u32x4*)(rowp + bj * HALF) = w; } }
    }
};
struct EpiSwiglu {
    static constexpr bool PERM = true, AFTER_DRAIN = false;
    bf16_t* H; int ldc; long rowoff;
    __device__ __forceinline__ void operator()(const f32x4 (&acc)[2][2][4][2], const Unit& u, int wr, int wc, int fr, int fq) const {
        const long row0 = (long)u.pm * BM + wr * 64 + fr + rowoff;
        const int col0 = u.po * HALF + wc * 32 + 8 * fq;
#pragma unroll
        for (int ai = 0; ai < 2; ++ai)
#pragma unroll
            for (int m = 0; m < 4; ++m) { bf16_t* rowp = H + (size_t)(row0 + ai * HALF + m * 16) * ldc + col0;
                float o[8];
#pragma unroll
                for (int n = 0; n < 2; ++n)
#pragma unroll
                    for (int j = 0; j < 4; ++j) { const float g = acc[ai][0][m][n][j], up = acc[ai][1][m][n][j];
                        const float s = g * __builtin_amdgcn_rcpf(1.0f + __builtin_amdgcn_exp2f(-1.4426950408889634f * g)); o[n * 4 + j] = s * up; }
                u32x4 w; w.x = cvt_pk_bf16(o[0], o[1]); w.y = cvt_pk_bf16(o[2], o[3]); w.z = cvt_pk_bf16(o[4], o[5]); w.w = cvt_pk_bf16(o[6], o[7]);
                *(u32x4*)rowp = w; }
    }
};
struct EpiMoeDown {
    static constexpr bool PERM = true, AFTER_DRAIN = false;
    bf16_t* O; int ldc; const float* gs;
    __device__ __forceinline__ void operator()(const f32x4 (&acc)[2][2][4][2], const Unit& u, int wr, int wc, int fr, int fq) const {
        const int row0 = u.pm * BM + wr * 64 + fr;
        const int col0 = u.po * BM + wc * 32 + 8 * fq;
#pragma unroll
        for (int ai = 0; ai < 2; ++ai)
#pragma unroll
            for (int m = 0; m < 4; ++m) { const int row = row0 + ai * HALF + m * 16; const float gt = gs[row]; bf16_t* rowp = O + (size_t)row * ldc + col0;
#pragma unroll
                for (int bj = 0; bj < 2; ++bj) { const f32x4 v0 = acc[ai][bj][m][0] * gt, v1 = acc[ai][bj][m][1] * gt;
                    u32x4 w; w.x = cvt_pk_bf16(v0[0], v0[1]); w.y = cvt_pk_bf16(v0[2], v0[3]); w.z = cvt_pk_bf16(v1[0], v1[1]); w.w = cvt_pk_bf16(v1[2], v1[3]);
                    *(u32x4*)(rowp + bj * HALF) = w; } }
    }
};
struct MoeOrder {
    int t0, nT, nN, nwg, G, c, nNe, arel;
    int ts1, ts2, ts3, ts4, ts5, ts6, ts7;
    __device__ bool next(int i, Unit& u) const {
        const long L = (long)i * G + c; if (L >= nwg) return false;
        int wgid = (int)L; { const int q = nwg / NXCD, r = nwg % NXCD, xcd = wgid % NXCD, off = wgid / NXCD; wgid = (xcd < r ? xcd * (q + 1) : r * (q + 1) + (xcd - r) * q) + off; }
        const int nig = WGM * nN, gid = wgid / nig, fm = gid * WGM, gsz = (nT - fm) < WGM ? (nT - fm) : WGM;
        const int pml = fm + ((wgid % nig) % gsz), pnl = (wgid % nig) / gsz;
        u.pm = t0 + pml; u.pa = arel ? pml : u.pm; u.po = pnl;
        const int e = (u.pm >= ts1) + (u.pm >= ts2) + (u.pm >= ts3) + (u.pm >= ts4) + (u.pm >= ts5) + (u.pm >= ts6) + (u.pm >= ts7);
        u.pn = e * nNe + pnl; return true;
    }
    __device__ __forceinline__ void a_ready(const Unit&) const {}
    __device__ __forceinline__ void done(const Unit&) const {}
};
}
constexpr int NWAVES = 8;
constexpr int NBATCH = 4, SEQ = 8192, M = NBATCH * SEQ, D = 1024, NH = 8, HD = 64;
constexpr int NA = 1792, NPB = 1536, NPROJ = NA + NPB, FF = 3584, NE = 8;
constexpr int MOE_PART_TILES = 64, MOE_PARTS = 5;
constexpr float NORM_EPS = 1e-6f, LNX_EPS = 64e-5f, DECAY_SCALE = 0.6065306597126334f;
constexpr float SB_EXIT = -104.0f;

constexpr size_t MiB = 1u << 20;
constexpr size_t WS_CTL = 0, CTL_ZERO_BYTES = 1 * MiB;
constexpr size_t WS_WIN0 = 1 * MiB, WS_WIN1 = 8 * MiB, WS_WOUT0 = 15 * MiB, WS_WOUT1 = 17 * MiB, WS_WGU0 = 19 * MiB, WS_WDN0 = 33 * MiB;
constexpr size_t WS_SEL = 40 * MiB, WS_GTS = WS_SEL + 128 * 1024, WS_POS = WS_GTS + 256 * 1024, WS_GSORT = WS_POS + 256 * 1024;
constexpr size_t WS_VF = 41 * MiB;
constexpr size_t WS_PA = 73 * MiB;
constexpr size_t WS_PAS = 169 * MiB;
constexpr size_t WS_YMIX = 73 * MiB;
constexpr size_t WS_PB = 185 * MiB;
constexpr size_t WS_Y = 185 * MiB;
constexpr size_t WS_F = 185 * MiB;
constexpr size_t WS_SCR = 281 * MiB;
constexpr size_t WS_ZH = WS_SCR, WS_RH = WS_SCR + 32 * MiB, WS_BF = WS_SCR + 64 * MiB, WS_U0F = WS_SCR + 96 * MiB, WS_YF = WS_SCR + 128 * MiB, WS_GTF = WS_SCR + 160 * MiB, WS_GF = WS_SCR + 192 * MiB, WS_PLF = WS_SCR + 256 * MiB;
constexpr size_t WS_HN = 281 * MiB;
constexpr size_t WS_HNF0 = 73 * MiB, WS_HNF1 = 41 * MiB;
constexpr size_t WS_H0 = 281 * MiB;
constexpr size_t WS_UPT = 14 * MiB + 512 * 1024;
constexpr size_t WS_BON = 40 * MiB;
constexpr size_t WS_WMGU = 105 * MiB, WS_WMDN = 217 * MiB, WS_HS = 273 * MiB, WS_HP = 405 * MiB, WS_END = 539 * MiB;
static_assert(WS_WIN0 + (size_t)NPROJ * D * 2 <= WS_WIN1 && WS_WIN1 + (size_t)NPROJ * D * 2 <= WS_UPT && WS_UPT + 2 * 8 * 12288 * 2 <= WS_WOUT0 && WS_WGU0 + (size_t)2 * FF * D * 2 <= WS_WDN0, "weights map");
static_assert(WS_GSORT + (size_t)(2 * M + 2048) * 4 <= 41 * MiB, "routing tables");
static_assert(WS_PA + (size_t)M * NA * 2 <= WS_PB && WS_PB + (size_t)M * NPB * 2 <= WS_SCR && WS_PLF + (size_t)8192 * 64 * 4 <= WS_END && WS_H0 + (size_t)M * FF * 2 <= WS_END, "act map");
static_assert(WS_WMGU + (size_t)NE * 2 * FF * D * 2 <= WS_WMDN && WS_WMDN + (size_t)NE * D * FF * 2 <= WS_HS && WS_HS + (size_t)(2 * M + 2048) * D * 2 <= WS_HP && WS_HP + (size_t)MOE_PART_TILES * 256 * FF * 2 <= WS_END, "moe map");
constexpr int CW_BAR = 4096, CW_TOT = 16384, CW_CUR = 16384 + 1024;

constexpr int RING_BYTES = 131072, LDS_BYTES = 163840, MISC_OFF = LDS_BYTES - 512;

#define GAS __attribute__((address_space(1)))
#define LAS __attribute__((address_space(3)))
typedef unsigned short bf16;
typedef unsigned v4u __attribute__((ext_vector_type(4)));
typedef unsigned v2u __attribute__((ext_vector_type(2)));
typedef float f32x4 __attribute__((ext_vector_type(4)));
typedef float f32x16 __attribute__((ext_vector_type(16)));
typedef short bf16x8 __attribute__((ext_vector_type(8)));
typedef short s16x4 __attribute__((ext_vector_type(4)));
typedef float f32x2_t __attribute__((ext_vector_type(2)));
typedef __bf16 bf16x2_t __attribute__((ext_vector_type(2)));
#define RLX_AGENT __ATOMIC_RELAXED, __HIP_MEMORY_SCOPE_AGENT
#define LDS_WAIT() asm volatile("s_waitcnt lgkmcnt(0)" ::: "memory")
#define DI __device__ __forceinline__
#define MFMA32(a, b, c) __builtin_amdgcn_mfma_f32_32x32x16_bf16((a), (b), (c), 0, 0, 0)

DI unsigned cvtpk(float lo, float hi) { f32x2_t v = {lo, hi}; bf16x2_t b = __builtin_convertvector(v, bf16x2_t); return __builtin_bit_cast(unsigned, b); }
DI unsigned short f2bf(float f) { return (unsigned short)(cvtpk(f, 0.f) & 0xffffu); }
DI float bf2f(unsigned short u) { return __uint_as_float((unsigned)u << 16); }
DI float bflo(unsigned u) { return __uint_as_float(u << 16); }
DI float bfhi(unsigned u) { return __uint_as_float(u & 0xffff0000u); }
DI int lane_id() { int l; asm volatile("v_mbcnt_lo_u32_b32 %0, -1, 0\n\tv_mbcnt_hi_u32_b32 %0, -1, %0" : "=v"(l)); return l; }
DI float shx(float v, int o, int lane) { return __builtin_bit_cast(float, __builtin_amdgcn_ds_bpermute((lane ^ o) << 2, __builtin_bit_cast(int, v))); }
DI int shi(int v, int src) { return __builtin_amdgcn_ds_bpermute(src << 2, v); }
DI float wave_sum(float v, int lane) {
#pragma unroll
    for (int o = 1; o < 64; o <<= 1) v += shx(v, o, lane);
    return v;
}
DI float sigmoidf_(float x) { return __builtin_amdgcn_rcpf(1.0f + __expf(-x)); }
DI int crow(int r, int hi) { return (r & 3) + 8 * (r >> 2) + 4 * hi; }

#define XB_TMO      128
#define XB_XCNT(j)  (256  + 64 * (j))
#define XB_XSUB(j)  (1280 + 64 * (j))
#define XB_XGEN(j)  (2304 + 64 * (j))
#define XB_TOP      3328
#define XB_TOPGEN   3392
#define XCD_BAR_WORDS 3456
#define XB_SPIN_CAP (1u << 22)
DI unsigned xb_ld(unsigned* p)              { return __hip_atomic_load(p, __ATOMIC_RELAXED, __HIP_MEMORY_SCOPE_AGENT); }
DI unsigned xb_add(unsigned* p, unsigned v) { return __hip_atomic_fetch_add(p, v, __ATOMIC_RELAXED, __HIP_MEMORY_SCOPE_AGENT); }
DI unsigned xb_xcc_id() { return (unsigned)__builtin_amdgcn_s_getreg((3 << 11) | 20) & 0xFu; }
#define XB_SPIN(cond, bar) do { unsigned _sp = 0; while (cond) { __builtin_amdgcn_s_sleep(1); \
    if ((++_sp & 255u) == 0u) { if (xb_ld(&(bar)[XB_TMO])) break; if (_sp > XB_SPIN_CAP) { atomicAdd(&(bar)[XB_TMO], 1u); break; } } } } while (0)
struct XcdBarrier { unsigned* bar; unsigned x; volatile LAS unsigned* st; };
DI XcdBarrier xcd_barrier_post(unsigned* bar, volatile LAS unsigned* st, int tid) {
    XcdBarrier b; b.bar = bar; b.x = xb_xcc_id(); b.st = st;
    if (tid == 0) (void)xb_add(&bar[XB_XCNT(b.x)], 1u);
    return b;
}
DI void xcd_barrier_complete(unsigned* bar, unsigned x, unsigned& nloc, unsigned& nx) {
    const unsigned G = gridDim.x * gridDim.y * gridDim.z;
    unsigned sum, cnt, mine, sp = 0u;
    for (;;) {
        sum = 0u; cnt = 0u; mine = 0u;
#pragma unroll
        for (unsigned j = 0; j < 16; ++j) { const unsigned c = xb_ld(&bar[XB_XCNT(j)]); sum += c; cnt += (c > 0u) ? 1u : 0u; mine = (j == x) ? c : mine; }
        if (sum == G) break;
        __builtin_amdgcn_s_sleep(1);
        if ((++sp & 255u) == 0u) { if (xb_ld(&bar[XB_TMO])) break; if (sp > XB_SPIN_CAP) { atomicAdd(&bar[XB_TMO], 1u); break; } }
    }
    nloc = mine > 0u ? mine : 1u; nx = cnt > 0u ? cnt : 1u;
}
DI void xcd_barrier(const XcdBarrier& b, int tid) {
    asm volatile("s_waitcnt vmcnt(0)" ::: "memory");
    __syncthreads();
    if (tid == 0) {
        unsigned* bar = b.bar; const unsigned bx = b.x;
        __builtin_amdgcn_s_waitcnt(0);
        unsigned nloc = b.st[0], nx = b.st[1];
        if (nloc == 0u) { xcd_barrier_complete(bar, bx, nloc, nx); b.st[0] = nloc; b.st[1] = nx; }
        const unsigned old = xb_add(&bar[XB_XSUB(bx)], 1u);
        const unsigned gen = old / nloc;
        if (old + 1u == (gen + 1u) * nloc) {
            __builtin_amdgcn_fence(__ATOMIC_RELEASE, "agent");
            asm volatile("s_waitcnt vmcnt(0)" ::: "memory");
            const unsigned og = xb_add(&bar[XB_TOP], 1u);
            const unsigned tg = og / nx;
            if (og + 1u == (tg + 1u) * nx) xb_add(&bar[XB_TOPGEN], 1u);
            else XB_SPIN(xb_ld(&bar[XB_TOPGEN]) == tg, bar);
            __builtin_amdgcn_fence(__ATOMIC_ACQUIRE, "agent");
            xb_add(&bar[XB_XGEN(bx)], 1u);
            asm volatile("s_waitcnt vmcnt(0)" ::: "memory");
        } else {
            XB_SPIN(xb_ld(&bar[XB_XGEN(bx)]) == gen, bar);
            __builtin_amdgcn_fence(__ATOMIC_ACQUIRE, "agent");
            asm volatile("s_waitcnt vmcnt(0)" ::: "memory");
        }
    }
    __syncthreads();
}

DI void transpose_item(const float* W, int N, int k0, int n0, bf16* WT, int Kt, int drow0, LAS float* scr, int lane) {
#pragma unroll 8
    for (int i = 0; i < 32; ++i) { const int kk = 2 * i + (lane >> 5); scr[kk * 33 + (lane & 31)] = W[(size_t)(k0 + kk) * N + n0 + (lane & 31)]; }
    LDS_WAIT(); asm volatile("" ::: "memory");
    const int c = lane & 7;
#pragma unroll
    for (int j = 0; j < 4; ++j) { const int n = (lane >> 3) + 8 * j; const LAS float* s = scr + (8 * c) * 33 + n;
        v4u o; o.x = cvtpk(s[0 * 33], s[1 * 33]); o.y = cvtpk(s[2 * 33], s[3 * 33]); o.z = cvtpk(s[4 * 33], s[5 * 33]); o.w = cvtpk(s[6 * 33], s[7 * 33]);
        *(GAS v4u*)(WT + (size_t)(drow0 + n) * Kt + k0 + 8 * c) = o; }
    LDS_WAIT(); asm volatile("" ::: "memory");
}
template <int MODE>
DI void conv_matrix(const float* W, int K, int N, bf16* WT, int nrw, LAS float* scr, int gw, int NGW, int lane) {
    const int nblk = N / 32, nitems = (K / 64) * nblk;
    for (int it = gw; it < nitems; it += NGW) {
        const int kb = it / nblk, nb = it % nblk, n0 = nb * 32;
        int drow0;
        if (MODE == 0) drow0 = n0;
        else if (MODE == 1) drow0 = n0 < nrw ? n0 : NA + (n0 - nrw);
        else if (MODE == 2) drow0 = (n0 >> 7) * 256 + (n0 & 127);
        else drow0 = (n0 >> 7) * 256 + 128 + (n0 & 127);
        transpose_item(W, N, kb * 64, n0, WT, K, drow0, scr, lane);
    }
}
DI void zero_rows(bf16* WT, int Kt, int r0, int r1, int gw, int NGW, int lane) {
    const int per = Kt / 8;
    const long total = (long)(r1 - r0) * per;
    for (long i = (long)gw * 64 + lane; i < total; i += (long)NGW * 64) *(GAS v4u*)(WT + (size_t)r0 * Kt + i * 8) = (v4u){0u, 0u, 0u, 0u};
}

DI float dot4(f32x4 a) { return (a.x * a.x + a.y * a.y) + (a.z * a.z + a.w * a.w); }
DI f32x4 ld_bf16x4(const bf16* p) { const v2u u = *(const GAS v2u*)p; return (f32x4){bflo(u.x), bfhi(u.x), bflo(u.y), bfhi(u.y)}; }
DI void st_bf16x4(bf16* p, f32x4 v) { v2u u; u.x = cvtpk(v.x, v.y); u.y = cvtpk(v.z, v.w); *(GAS v2u*)p = u; }

DI void phase_norm0(const float* x, const float* g, bf16* hn, int gw, int NGW, int lane) {
    f32x4 gv[4];
#pragma unroll
    for (int j = 0; j < 4; ++j) gv[j] = *(const f32x4*)(g + 4 * lane + 256 * j);
    for (int m = gw; m < M; m += NGW) {
        f32x4 v[4]; float s = 0.f;
#pragma unroll
        for (int j = 0; j < 4; ++j) { v[j] = *(const GAS f32x4*)(x + (size_t)m * D + 4 * lane + 256 * j); s += dot4(v[j]); }
        const float rs = rsqrtf(wave_sum(s, lane) * (1.f / D) + NORM_EPS);
#pragma unroll
        for (int j = 0; j < 4; ++j) st_bf16x4(hn + (size_t)m * D + 4 * lane + 256 * j, v[j] * rs * gv[j]);
    }
}
template <bool MOEF>
DI void phase_resnorm(const float* xin, const bf16* y, const unsigned* pos, const float* g1, const float* g2, float* xout, bf16* hn,
                      const float* rt, unsigned* sel, float* gts, unsigned* totals, int gw, int NGW, int lane) {
    f32x4 g1v[4], g2v[4];
#pragma unroll
    for (int j = 0; j < 4; ++j) { g1v[j] = *(const f32x4*)(g1 + 4 * lane + 256 * j); g2v[j] = g2 ? *(const f32x4*)(g2 + 4 * lane + 256 * j) : (f32x4){0.f, 0.f, 0.f, 0.f}; }
    unsigned mycnt = 0;
    for (int m = gw; m < M; m += NGW) {
        f32x4 v[4], yv[4]; float s = 0.f;
        if (MOEF) {
            const unsigned p0 = __hip_atomic_load(pos + 2 * m, RLX_AGENT), p1 = __hip_atomic_load(pos + 2 * m + 1, RLX_AGENT);
#pragma unroll
            for (int j = 0; j < 4; ++j) yv[j] = ld_bf16x4(y + (size_t)p0 * D + 4 * lane + 256 * j) + ld_bf16x4(y + (size_t)p1 * D + 4 * lane + 256 * j);
        } else {
#pragma unroll
            for (int j = 0; j < 4; ++j) yv[j] = ld_bf16x4(y + (size_t)m * D + 4 * lane + 256 * j);
        }
#pragma unroll
        for (int j = 0; j < 4; ++j) { v[j] = *(const GAS f32x4*)(xin + (size_t)m * D + 4 * lane + 256 * j); s += dot4(yv[j]); }
        const float rsy = rsqrtf(wave_sum(s, lane) * (1.f / D) + NORM_EPS);
        float s2 = 0.f;
#pragma unroll
        for (int j = 0; j < 4; ++j) { v[j] = v[j] + yv[j] * rsy * g1v[j]; s2 += dot4(v[j]); *(GAS f32x4*)(xout + (size_t)m * D + 4 * lane + 256 * j) = v[j]; }
        if (g2) {
            const float rsx = rsqrtf(wave_sum(s2, lane) * (1.f / D) + NORM_EPS);
#pragma unroll
            for (int j = 0; j < 4; ++j) { v[j] = v[j] * rsx * g2v[j]; st_bf16x4(hn + (size_t)m * D + 4 * lane + 256 * j, v[j]); }
            if (rt) {
                float pe[8];
#pragma unroll
                for (int e = 0; e < 8; ++e) pe[e] = 0.f;
#pragma unroll
                for (int j = 0; j < 4; ++j)
#pragma unroll
                    for (int i = 0; i < 4; ++i) { const float hv = v[j][i]; const float* rp = rt + (size_t)(4 * lane + 256 * j + i) * 8;
                        const f32x4 ra = *(const f32x4*)rp, rb = *(const f32x4*)(rp + 4);
                        pe[0] += hv * ra.x; pe[1] += hv * ra.y; pe[2] += hv * ra.z; pe[3] += hv * ra.w; pe[4] += hv * rb.x; pe[5] += hv * rb.y; pe[6] += hv * rb.z; pe[7] += hv * rb.w; }
                float v0 = -3.0e38f, v1 = -3.0e38f; int e0 = 0, e1 = 0;
#pragma unroll
                for (int e = 0; e < 8; ++e) { const float lg = wave_sum(pe[e], lane); if (lg > v0) { v1 = v0; e1 = e0; v0 = lg; e0 = e; } else if (lg > v1) { v1 = lg; e1 = e; } }
                const float ga = 1.0f / (1.0f + __expf(v1 - v0)), gb = 1.0f - ga;
                if (lane == 0) { sel[m] = (unsigned)e0 | ((unsigned)e1 << 8); gts[2 * m] = ga; gts[2 * m + 1] = gb; }
                if (lane == e0 || lane == e1) ++mycnt;
            }
        }
    }
    if (rt && lane < 8 && mycnt) __hip_atomic_fetch_add(totals + 64 * lane, mycnt, RLX_AGENT);
}

DI int moe_offsets(unsigned* totals, int lane, int& mytot) {
    int off = 0; mytot = 0;
#pragma unroll
    for (int e = 0; e < 8; ++e) { const int t = (int)__hip_atomic_load(totals + 64 * e, RLX_AGENT); if (e < lane) off += (t + 255) & ~255; if (e == lane) mytot = t; }
    return off;
}

DI void phase_moe_sort(const unsigned* sel, const float* gts, unsigned* totals, unsigned* cursor, unsigned* pos, float* gsort, const bf16* hn, bf16* hs, int gw, int NGW, int lane) {
    int mytot; const int myoff = moe_offsets(totals, lane, mytot);
    unsigned mycnt = 0;
    for (int m = gw; m < M; m += NGW) { const unsigned s = __hip_atomic_load(sel + m, RLX_AGENT); const int e0 = s & 255, e1 = (s >> 8) & 255; if (lane == e0 || lane == e1) ++mycnt; }
    unsigned mybase = 0;
    if (lane < 8 && mycnt) mybase = __hip_atomic_fetch_add(cursor + 64 * lane, mycnt, RLX_AGENT);
    unsigned mypos = (unsigned)myoff + mybase;
    for (int m = gw; m < M; m += NGW) {
        const unsigned s = __hip_atomic_load(sel + m, RLX_AGENT); const int e0 = s & 255, e1 = (s >> 8) & 255;
        const unsigned p0 = (unsigned)shi((int)mypos, e0), p1 = (unsigned)shi((int)mypos, e1);
        if (lane == e0 || lane == e1) ++mypos;
        if (lane == 0) { pos[2 * m] = p0; pos[2 * m + 1] = p1; gsort[p0] = __hip_atomic_load(gts + 2 * m, RLX_AGENT); gsort[p1] = __hip_atomic_load(gts + 2 * m + 1, RLX_AGENT); }
        const v4u a = *(const GAS v4u*)(hn + (size_t)m * D + 8 * lane), b = *(const GAS v4u*)(hn + (size_t)m * D + 512 + 8 * lane);
        *(GAS v4u*)(hs + (size_t)p0 * D + 8 * lane) = a; *(GAS v4u*)(hs + (size_t)p0 * D + 512 + 8 * lane) = b;
        *(GAS v4u*)(hs + (size_t)p1 * D + 8 * lane) = a; *(GAS v4u*)(hs + (size_t)p1 * D + 512 + 8 * lane) = b;
    }
#pragma unroll 1
    for (int e = 0; e < 8; ++e) {
        const int r0 = shi(myoff + mytot, e), r1 = shi(myoff + ((mytot + 255) & ~255), e);
        for (int r = r0 + gw; r < r1; r += NGW) { *(GAS v4u*)(hs + (size_t)r * D + 8 * lane) = (v4u){0u, 0u, 0u, 0u}; *(GAS v4u*)(hs + (size_t)r * D + 512 + 8 * lane) = (v4u){0u, 0u, 0u, 0u}; if (lane == 0) gsort[r] = 0.f; }
    }
}
constexpr int SB_VP = 40;
DI void sb_wave(const bf16* PB, bf16* ymix, const float* sb_g, int b, int h, int q0, LAS unsigned char* vtb, int lane) {
    const int qi = lane & 31, hh = lane >> 5;
    LAS bf16* vt = (LAS bf16*)vtb;
    const size_t rowb = (size_t)b * SEQ;
    bf16x8 qf[4];
#pragma unroll
    for (int s = 0; s < 4; ++s) qf[s] = *(const GAS bf16x8*)(PB + (rowb + q0 + qi) * NPB + h * 64 + 16 * s + 8 * hh);
    f32x16 o0, o1;
#pragma unroll
    for (int r = 0; r < 16; ++r) { o0[r] = 0.f; o1[r] = 0.f; }
    float carry = 0.f;
    const int q = q0 + qi;
#pragma unroll 1
    for (int kt = q0 / 32; kt >= 0; --kt) {
        const int kb = kt * 32;
        bf16x8 kf[4], vv[4];
#pragma unroll
        for (int s = 0; s < 4; ++s) kf[s] = *(const GAS bf16x8*)(PB + (rowb + kb + qi) * NPB + 512 + h * 64 + 16 * s + 8 * hh);
#pragma unroll
        for (int i = 0; i < 4; ++i) vv[i] = *(const GAS bf16x8*)(PB + (rowb + kb + qi) * NPB + 1024 + h * 64 + 32 * hh + 8 * i);
#pragma unroll
        for (int i = 0; i < 4; ++i)
#pragma unroll
            for (int e = 0; e < 8; ++e) vt[(32 * hh + 8 * i + e) * SB_VP + qi] = (bf16)vv[i][e];
        f32x16 sc;
#pragma unroll
        for (int r = 0; r < 16; ++r) sc[r] = 0.f;
#pragma unroll
        for (int s = 0; s < 4; ++s) sc = MFMA32(kf[s], qf[s], sc);
        float c[16], ls[16];
        const bool diag = (kb == q0);
#pragma unroll
        for (int r = 0; r < 16; ++r) {
            const float z = sc[r] * 0.125f;
            const float sp = fmaxf(z, 0.f) + __logf(1.0f + __expf(-fabsf(z)));
            const bool valid = !diag || (kb + crow(r, hh) < q);
            c[r] = valid ? -sp : 0.f;
            ls[r] = valid ? z - sp : -1.0e30f;
        }
        float G[4], PG[4];
#pragma unroll
        for (int g = 0; g < 4; ++g) { G[g] = (c[4 * g] + c[4 * g + 1]) + (c[4 * g + 2] + c[4 * g + 3]); PG[g] = shx(G[g], 32, lane); }
        float att[16];
        float after = carry;
#pragma unroll
        for (int g = 3; g >= 0; --g) {
            float sfx = after + (hh == 0 ? PG[g] : 0.f);
#pragma unroll
            for (int i = 3; i >= 0; --i) { att[4 * g + i] = __expf(ls[4 * g + i] + sfx); sfx += c[4 * g + i]; }
            after += G[g] + PG[g];
        }
        carry = after;
        bf16x8 pf[2];
#pragma unroll
        for (int s = 0; s < 2; ++s) { v4u p; p.x = cvtpk(att[8 * s], att[8 * s + 1]); p.y = cvtpk(att[8 * s + 2], att[8 * s + 3]); p.z = cvtpk(att[8 * s + 4], att[8 * s + 5]); p.w = cvtpk(att[8 * s + 6], att[8 * s + 7]); pf[s] = __builtin_bit_cast(bf16x8, p); }
        LDS_WAIT();
#pragma unroll
        for (int s = 0; s < 2; ++s) {
            const s16x4 a0 = *(const LAS s16x4*)(vt + qi * SB_VP + 16 * s + 4 * hh), a1 = *(const LAS s16x4*)(vt + qi * SB_VP + 16 * s + 8 + 4 * hh);
            const s16x4 b0 = *(const LAS s16x4*)(vt + (32 + qi) * SB_VP + 16 * s + 4 * hh), b1 = *(const LAS s16x4*)(vt + (32 + qi) * SB_VP + 16 * s + 8 + 4 * hh);
            const bf16x8 va = __builtin_shufflevector(a0, a1, 0, 1, 2, 3, 4, 5, 6, 7), vb = __builtin_shufflevector(b0, b1, 0, 1, 2, 3, 4, 5, 6, 7);
            o0 = MFMA32(va, pf[s], o0);
            o1 = MFMA32(vb, pf[s], o1);
        }
        LDS_WAIT();
        if (__all(carry < SB_EXIT)) break;
    }
    float ss = 0.f;
#pragma unroll
    for (int r = 0; r < 16; ++r) ss += o0[r] * o0[r] + o1[r] * o1[r];
    ss += shx(ss, 32, lane);
    const float scl = rsqrtf(ss * (1.f / 64.f) + NORM_EPS);
    bf16* orow = ymix + (rowb + q) * D + 512 + h * 64;
#pragma unroll
    for (int g = 0; g < 4; ++g) {
        const int d0 = 8 * g + 4 * hh;
        const f32x4 g0 = *(const f32x4*)(sb_g + h * 64 + d0), g1 = *(const f32x4*)(sb_g + h * 64 + 32 + d0);
        v2u w0, w1;
        w0.x = cvtpk(o0[4 * g] * scl * g0.x, o0[4 * g + 1] * scl * g0.y); w0.y = cvtpk(o0[4 * g + 2] * scl * g0.z, o0[4 * g + 3] * scl * g0.w);
        w1.x = cvtpk(o1[4 * g] * scl * g1.x, o1[4 * g + 1] * scl * g1.y); w1.y = cvtpk(o1[4 * g + 2] * scl * g1.z, o1[4 * g + 3] * scl * g1.w);
        *(GAS v2u*)(orow + d0) = w0; *(GAS v2u*)(orow + 32 + d0) = w1;
    }
}
constexpr int RW_L = 32, RW_NCH = SEQ / RW_L;
constexpr size_t RW_UNITS = (size_t)NBATCH * NH * RW_NCH;
struct RwkvC {
    const bf16* PAT; const bf16* PAS; const float* mu; const float *decay0, *iclr0, *vres0, *k_k, *k_a, *r_k, *lnx_g, *lnx_b;
    const bf16* upT;
    unsigned* VFf;
    bf16* ZH; bf16* RH;
    unsigned* BF;
    unsigned* U0F; unsigned* YF;
    unsigned* GTF;
    unsigned* GF;
    float* PLF;
    float* BON;
    bf16* ymix;
    int has_vres;
};
DI bf16x8 pk8(const f32x16& x, int s) { v4u p; p.x = cvtpk(x[8 * s], x[8 * s + 1]); p.y = cvtpk(x[8 * s + 2], x[8 * s + 3]); p.z = cvtpk(x[8 * s + 4], x[8 * s + 5]); p.w = cvtpk(x[8 * s + 6], x[8 * s + 7]); return __builtin_bit_cast(bf16x8, p); }
DI void st_frag(unsigned* p, const f32x16& x) {
    v4u a, b; a.x = cvtpk(x[0], x[1]); a.y = cvtpk(x[2], x[3]); a.z = cvtpk(x[4], x[5]); a.w = cvtpk(x[6], x[7]);
    b.x = cvtpk(x[8], x[9]); b.y = cvtpk(x[10], x[11]); b.z = cvtpk(x[12], x[13]); b.w = cvtpk(x[14], x[15]);
    *(GAS v4u*)p = a; *(GAS v4u*)(p + 4) = b;
}
DI f32x16 ld_frag(const unsigned* p) {
    const v4u a = *(const GAS v4u*)p, b = *(const GAS v4u*)(p + 4); f32x16 x;
    x[0] = bflo(a.x); x[1] = bfhi(a.x); x[2] = bflo(a.y); x[3] = bfhi(a.y); x[4] = bflo(a.z); x[5] = bfhi(a.z); x[6] = bflo(a.w); x[7] = bfhi(a.w);
    x[8] = bflo(b.x); x[9] = bfhi(b.x); x[10] = bflo(b.y); x[11] = bfhi(b.y); x[12] = bflo(b.z); x[13] = bfhi(b.z); x[14] = bflo(b.w); x[15] = bfhi(b.w);
    return x;
}
DI f32x16 zero16() { f32x16 z;
#pragma unroll
    for (int i = 0; i < 16; ++i) z[i] = 0.f;
    return z; }
DI float half_sum(float v, int lane) {
#pragma unroll
    for (int o = 1; o < 32; o <<= 1) v += shx(v, o, lane);
    return v;
}
constexpr int RW_SP = 72;
DI void stage_n(LAS bf16* img, const f32x16& x0, const f32x16& x1, int cl, int hi) {
#pragma unroll
    for (int r = 0; r < 16; ++r) { img[crow(r, hi) * RW_SP + cl] = f2bf(x0[r]); img[crow(r, hi) * RW_SP + 32 + cl] = f2bf(x1[r]); }
}
DI bf16x8 frag_nat(const LAS bf16* img, int pitch, int row, int S, int hh) { return *(const LAS bf16x8*)(img + row * pitch + 16 * S + 8 * hh); }
DI bf16x8 frag_perm(const LAS bf16* img, int pitch, int row, int S, int hh) {
    const s16x4 a = *(const LAS s16x4*)(img + row * pitch + 16 * S + 4 * hh), b = *(const LAS s16x4*)(img + row * pitch + 16 * S + 8 + 4 * hh);
    return __builtin_shufflevector(a, b, 0, 1, 2, 3, 4, 5, 6, 7);
}

DI void ld_col(const bf16* PAT, unsigned cg, unsigned n, int hi, bool first_chunk, f32x16& cur, f32x16& prv) {
    const unsigned base = ((cg * 1536u + n) << 5) + 4u * (unsigned)hi;
    const unsigned pbase = (((cg - 1u) * 1536u + n) << 5) + 31u;
#pragma unroll
    for (int g = 0; g < 4; ++g) {
        const v2u w = *(const GAS v2u*)(PAT + base + 8 * g);
        cur[4 * g] = bflo(w.x); cur[4 * g + 1] = bfhi(w.x); cur[4 * g + 2] = bflo(w.y); cur[4 * g + 3] = bfhi(w.y);
        float p0;
        if (g == 0) { const bool wrap = (hi == 0); const unsigned off = wrap ? (first_chunk ? base : pbase) : base - 1u; const float pv = bf2f(*(const GAS bf16*)(PAT + off)); p0 = (wrap && first_chunk) ? 0.f : pv; }
        else p0 = bf2f(*(const GAS bf16*)(PAT + base + 8 * g - 1));
        prv[4 * g] = p0; prv[4 * g + 1] = cur[4 * g]; prv[4 * g + 2] = cur[4 * g + 1]; prv[4 * g + 3] = cur[4 * g + 2];
    }
}
constexpr int RW_WAVE_LDS = 19456;
DI unsigned pk2f(float a, float b) { return cvtpk(a, b); }
DI bf16x8 pkq(const unsigned (&p)[8], int s) { v4u q; q.x = p[4 * s]; q.y = p[4 * s + 1]; q.z = p[4 * s + 2]; q.w = p[4 * s + 3]; return __builtin_bit_cast(bf16x8, q); }
DI void rwkv_pre_unit(const RwkvC& P, int b, int h, int ch, LAS unsigned char* lw_, int lane) {
    const int cl = lane & 31, hi = lane >> 5;
    const unsigned unit = (unsigned)((b * NH + h) * RW_NCH + ch);
    const unsigned row0 = (unsigned)(b * SEQ + ch * RW_L);
    const unsigned cg = (unsigned)(b * RW_NCH + ch);
    LAS bf16* Ri = (LAS bf16*)lw_; LAS bf16* Bi = (LAS bf16*)(lw_ + 4608); LAS bf16* Ki = (LAS bf16*)(lw_ + 9216); LAS bf16* Zi = (LAS bf16*)(lw_ + 13824);
    LAS float* Af = (LAS float*)lw_;
    LAS bf16* Tn = (LAS bf16*)lw_; LAS bf16* Tt = (LAS bf16*)(lw_ + 2048);
    LAS bf16* BmL = (LAS bf16*)(lw_ + 4096); LAS bf16* AbL = (LAS bf16*)(lw_ + 6144); LAS bf16* AkL = (LAS bf16*)(lw_ + 8192);
    const bf16* upT = P.upT + (size_t)h * 12288;
    const unsigned rowt = row0 + cl; const bool first_tok = (ch == 0 && cl == 0);
    bf16x8 smw[2], sma[2], smv[2];
    {
        bf16x8 smg[6];
        const bf16* pr = P.PAS + rowt * 256 + 8 * hi; const bf16* pp = pr - 256;
        v4u cu[12], pv[12];
#pragma unroll
        for (int s = 0; s < 12; ++s) { cu[s] = (v4u){0u, 0u, 0u, 0u}; pv[s] = (v4u){0u, 0u, 0u, 0u}; }
#pragma unroll
        for (int s = 0; s < 12; ++s) if (s < 10 || P.has_vres) { cu[s] = *(const GAS v4u*)(pr + 16 * s); if (!first_tok) pv[s] = *(const GAS v4u*)(pp + 16 * s); }
#pragma unroll
        for (int s = 0; s < 12; ++s) {
            f32x4 m0 = (f32x4){0.f, 0.f, 0.f, 0.f}, m1 = m0;
            if (s < 10 || P.has_vres) { m0 = *(const f32x4*)(P.mu + 1536 + 16 * s + 8 * hi); m1 = *(const f32x4*)(P.mu + 1536 + 16 * s + 8 * hi + 4); }
            float xs[8];
            xs[0] = bflo(cu[s].x) + m0.x * (bflo(pv[s].x) - bflo(cu[s].x)); xs[1] = bfhi(cu[s].x) + m0.y * (bfhi(pv[s].x) - bfhi(cu[s].x));
            xs[2] = bflo(cu[s].y) + m0.z * (bflo(pv[s].y) - bflo(cu[s].y)); xs[3] = bfhi(cu[s].y) + m0.w * (bfhi(pv[s].y) - bfhi(cu[s].y));
            xs[4] = bflo(cu[s].z) + m1.x * (bflo(pv[s].z) - bflo(cu[s].z)); xs[5] = bfhi(cu[s].z) + m1.y * (bfhi(pv[s].z) - bfhi(cu[s].z));
            xs[6] = bflo(cu[s].w) + m1.z * (bflo(pv[s].w) - bflo(cu[s].w)); xs[7] = bfhi(cu[s].w) + m1.w * (bfhi(pv[s].w) - bfhi(cu[s].w));
            if (s < 2) {
#pragma unroll
                for (int j = 0; j < 8; ++j) { const float e = __expf(2.0f * xs[j]); xs[j] = 1.0f - 2.0f * __builtin_amdgcn_rcpf(e + 1.0f); }
            } else if (s >= 4 && s < 10) {
#pragma unroll
                for (int j = 0; j < 8; ++j) xs[j] = sigmoidf_(xs[j]);
            }
            v4u p; p.x = cvtpk(xs[0], xs[1]); p.y = cvtpk(xs[2], xs[3]); p.z = cvtpk(xs[4], xs[5]); p.w = cvtpk(xs[6], xs[7]);
            const bf16x8 f = __builtin_bit_cast(bf16x8, p);
            if (s < 2) smw[s] = f; else if (s < 4) sma[s - 2] = f; else if (s < 10) smg[s - 4] = f; else smv[s - 10] = f;
        }
#pragma unroll
        for (int ct = 0; ct < 2; ++ct) {
            f32x16 g = zero16();
#pragma unroll
            for (int s = 0; s < 6; ++s) { const bf16x8 wg = *(const GAS bf16x8*)(upT + 6144 + (32 * ct + cl) * 96 + 16 * s + 8 * hi); g = MFMA32(smg[s], wg, g); }
            st_frag(P.GTF + ((unit * 2 + ct) * 64 + lane) * 8, g);
        }
    }
    float rn[16];
    {
        float nn[16];
#pragma unroll
        for (int r = 0; r < 16; ++r) nn[r] = 0.f;
#pragma unroll
        for (int ct = 0; ct < 2; ++ct) {
            const int hc = h * 64 + 32 * ct + cl; const float mk = P.mu[512 + hc], kkc = P.k_k[hc];
            f32x16 kc, kp; ld_col(P.PAT, cg, 512u + (unsigned)hc, hi, ch == 0, kc, kp);
#pragma unroll
            for (int r = 0; r < 16; ++r) { const float kq = (kc[r] + mk * (kp[r] - kc[r])) * kkc; nn[r] += kq * kq; }
        }
#pragma unroll
        for (int r = 0; r < 16; ++r) rn[r] = rsqrtf(fmaxf(half_sum(nn[r], lane), 1e-12f));
    }
    unsigned Khp0[8];
    float bon[16];
#pragma unroll
    for (int r = 0; r < 16; ++r) bon[r] = 0.f;
#pragma unroll
    for (int ct = 0; ct < 2; ++ct) {
        const int hc = h * 64 + 32 * ct + cl;
        f32x16 lwv, av;
        {
            f32x16 d = zero16(), ic = zero16();
#pragma unroll
            for (int s = 0; s < 2; ++s) {
                const bf16x8 wd = *(const GAS bf16x8*)(upT + (32 * ct + cl) * 32 + 16 * s + 8 * hi);
                const bf16x8 wi = *(const GAS bf16x8*)(upT + 2048 + (32 * ct + cl) * 32 + 16 * s + 8 * hi);
                d = MFMA32(smw[s], wd, d); ic = MFMA32(sma[s], wi, ic);
            }
            const float d0 = P.decay0[hc], i0 = P.iclr0[hc];
#pragma unroll
            for (int r = 0; r < 16; ++r) { lwv[r] = -DECAY_SCALE * sigmoidf_(d[r] + d0); av[r] = sigmoidf_(ic[r] + i0); }
        }
        f32x16 cum; float cumL;
        {
            float Gs[4], PGs[4];
#pragma unroll
            for (int g = 0; g < 4; ++g) { Gs[g] = (lwv[4 * g] + lwv[4 * g + 1]) + (lwv[4 * g + 2] + lwv[4 * g + 3]); PGs[g] = shx(Gs[g], 32, lane); }
            float before = 0.f;
#pragma unroll
            for (int g = 0; g < 4; ++g) {
                float run = before + (hi ? PGs[g] : 0.f);
#pragma unroll
                for (int i = 0; i < 4; ++i) { run += lwv[4 * g + i]; cum[4 * g + i] = run; }
                before += Gs[g] + PGs[g];
            }
            cumL = before;
        }
        if (hi == ct) P.PLF[unit * 64 + 32 * ct + cl] = __expf(cumL);
        f32x16 rv, kv, vv;
        {
            const float mr = P.mu[hc], mk = P.mu[512 + hc], mv = P.mu[1024 + hc];
            f32x16 c0, p0, c1, p1, c2, p2;
            ld_col(P.PAT, cg, (unsigned)hc, hi, ch == 0, c0, p0); ld_col(P.PAT, cg, 512u + (unsigned)hc, hi, ch == 0, c1, p1); ld_col(P.PAT, cg, 1024u + (unsigned)hc, hi, ch == 0, c2, p2);
#pragma unroll
            for (int r = 0; r < 16; ++r) { rv[r] = c0[r] + mr * (p0[r] - c0[r]); kv[r] = c1[r] + mk * (p1[r] - c1[r]); vv[r] = c2[r] + mv * (p2[r] - c2[r]); }
        }
        if (P.has_vres) {
            f32x16 vp = zero16();
#pragma unroll
            for (int s = 0; s < 2; ++s) { const bf16x8 wv = *(const GAS bf16x8*)(upT + 4096 + (32 * ct + cl) * 32 + 16 * s + 8 * hi); vp = MFMA32(smv[s], wv, vp); }
            const float v0 = P.vres0[hc];
            const f32x16 vf = ld_frag(P.VFf + ((unit * 2 + ct) * 64 + lane) * 8);
#pragma unroll
            for (int r = 0; r < 16; ++r) vv[r] = vv[r] + (vf[r] - vv[r]) * sigmoidf_(vp[r] + v0);
        }
        st_frag(P.VFf + ((unit * 2 + ct) * 64 + lane) * 8, vv);
        const float kkc = P.k_k[hc], kac = P.k_a[hc], rkc = P.r_k[hc];
        f32x16 Bh;
#pragma unroll
        for (int r = 0; r < 16; ++r) {
            const int t = crow(r, hi);
            const float kk = kv[r] * kkc * rn[r];
            const float km = kv[r] * (1.0f + (av[r] - 1.0f) * kac);
            bon[r] += rv[r] * km * rkc;
            const float c = cum[r], e1 = __expf(c), e2 = __expf(c - lwv[r]), e3 = __expf(-c), e4 = __expf(cumL - c);
            const float bb = kk * av[r];
            const float zt = -kk * e2;
            Zi[t * RW_SP + 32 * ct + cl] = f2bf(zt); Ri[t * RW_SP + 32 * ct + cl] = f2bf(rv[r] * e1); Bi[t * RW_SP + 32 * ct + cl] = f2bf(bb * e3); Ki[t * RW_SP + 32 * ct + cl] = f2bf(km * e3);
            Bh[r] = bb * e4;
            kv[r] = km * e4;
        }
        st_frag(P.BF + ((unit * 2 + ct) * 64 + lane) * 8, Bh);
        unsigned Khc[8], vvc[8];
#pragma unroll
        for (int q = 0; q < 8; ++q) { Khc[q] = pk2f(kv[2 * q], kv[2 * q + 1]); vvc[q] = pk2f(vv[2 * q], vv[2 * q + 1]); }
        if (ct == 0) {
#pragma unroll
            for (int q = 0; q < 8; ++q) Khp0[q] = Khc[q];
            f32x16 g = zero16();
            g = MFMA32(pkq(Khc, 0), pkq(vvc, 0), g); g = MFMA32(pkq(Khc, 1), pkq(vvc, 1), g);
            st_frag(P.GF + (((unit * 2 + 0) * 2 + 0) * 64 + lane) * 8, g);
        } else {
            unsigned vv0[8];
            { const v4u a = *(const GAS v4u*)(P.VFf + ((unit * 2 + 0) * 64 + lane) * 8), b2 = *(const GAS v4u*)(P.VFf + ((unit * 2 + 0) * 64 + lane) * 8 + 4);
              vv0[0] = a.x; vv0[1] = a.y; vv0[2] = a.z; vv0[3] = a.w; vv0[4] = b2.x; vv0[5] = b2.y; vv0[6] = b2.z; vv0[7] = b2.w; }
            f32x16 g01 = zero16(), g10 = zero16(), g11 = zero16();
#pragma unroll
            for (int s2 = 0; s2 < 2; ++s2) { g01 = MFMA32(pkq(Khp0, s2), pkq(vvc, s2), g01); g10 = MFMA32(pkq(Khc, s2), pkq(vv0, s2), g10); g11 = MFMA32(pkq(Khc, s2), pkq(vvc, s2), g11); }
            st_frag(P.GF + (((unit * 2 + 0) * 2 + 1) * 64 + lane) * 8, g01);
            st_frag(P.GF + (((unit * 2 + 1) * 2 + 0) * 64 + lane) * 8, g10);
            st_frag(P.GF + (((unit * 2 + 1) * 2 + 1) * 64 + lane) * 8, g11);
        }
        asm volatile("" ::: "memory"); __builtin_amdgcn_sched_barrier(0);
    }
#pragma unroll
    for (int r = 0; r < 16; ++r) { const float bo = half_sum(bon[r], lane); if (cl == 0) P.BON[(row0 + crow(r, hi)) * 8 + h] = bo; }
    LDS_WAIT();
    bf16x8 zf[4], rf[4], bfr[4], kf[4];
    unsigned rtT[16];
#pragma unroll
    for (int S = 0; S < 4; ++S) { zf[S] = frag_nat(Zi, RW_SP, cl, S, hi); rf[S] = frag_nat(Ri, RW_SP, cl, S, hi); bfr[S] = frag_nat(Bi, RW_SP, cl, S, hi); kf[S] = frag_nat(Ki, RW_SP, cl, S, hi); }
#pragma unroll
    for (int ct = 0; ct < 2; ++ct)
#pragma unroll
        for (int g = 0; g < 4; ++g) { const v2u w = *(const LAS v2u*)(Ri + cl * RW_SP + 32 * ct + 8 * g + 4 * hi); rtT[ct * 8 + g * 2] = w.x; rtT[ct * 8 + g * 2 + 1] = w.y; }
    LDS_WAIT();
    {
        f32x16 Aa = zero16(), Bm = zero16(), Ab = zero16(), Ak = zero16();
#pragma unroll
        for (int S = 0; S < 4; ++S) { Aa = MFMA32(zf[S], bfr[S], Aa); Bm = MFMA32(zf[S], kf[S], Bm); Ab = MFMA32(rf[S], bfr[S], Ab); Ak = MFMA32(rf[S], kf[S], Ak); }
#pragma unroll
        for (int r = 0; r < 16; ++r) {
            const int t = crow(r, hi); const bool lo = cl < t, le = cl <= t;
            Af[t * 32 + cl] = lo ? Aa[r] : 0.f;
            BmL[t * 32 + cl] = f2bf(lo ? Bm[r] : 0.f); AbL[t * 32 + cl] = f2bf(le ? Ab[r] : 0.f); AkL[t * 32 + cl] = f2bf(le ? Ak[r] : 0.f);
        }
    }
    LDS_WAIT();
    {
        float tc[32];
#pragma unroll
        for (int t = 0; t < 32; ++t) {
            float acc = (t == cl) ? 1.0f : 0.f;
#pragma unroll
            for (int s4 = 0; s4 < t; s4 += 4) {
                const f32x4 a4 = *(const LAS f32x4*)(Af + t * 32 + s4);
                acc += a4.x * tc[s4];
                if (s4 + 1 < t) acc += a4.y * tc[s4 + 1];
                if (s4 + 2 < t) acc += a4.z * tc[s4 + 2];
                if (s4 + 3 < t) acc += a4.w * tc[s4 + 3];
            }
            asm volatile("" : "+v"(acc) :: "memory");
            tc[t] = acc;
        }
        LDS_WAIT();
#pragma unroll
        for (int t = 0; t < 32; ++t) if (hi == 0) Tn[t * 32 + cl] = f2bf(tc[t]);
        if (hi == 0) {
#pragma unroll
            for (int q = 0; q < 4; ++q) { v4u p; p.x = cvtpk(tc[8 * q], tc[8 * q + 1]); p.y = cvtpk(tc[8 * q + 2], tc[8 * q + 3]); p.z = cvtpk(tc[8 * q + 4], tc[8 * q + 5]); p.w = cvtpk(tc[8 * q + 6], tc[8 * q + 7]); *(LAS v4u*)(Tt + cl * 32 + 8 * q) = p; }
        }
    }
    LDS_WAIT();
    bf16x8 tp[2];
    {
        bf16x8 bmp[2], abp[2], akp[2];
#pragma unroll
        for (int s = 0; s < 2; ++s) { bmp[s] = frag_perm(BmL, 32, cl, s, hi); tp[s] = frag_perm(Tn, 32, cl, s, hi); abp[s] = frag_perm(AbL, 32, cl, s, hi); akp[s] = frag_perm(AkL, 32, cl, s, hi); }
#pragma unroll
        for (int vt = 0; vt < 2; ++vt) {
            unsigned vvq[8];
            { const v4u a = *(const GAS v4u*)(P.VFf + ((unit * 2 + vt) * 64 + lane) * 8), b2 = *(const GAS v4u*)(P.VFf + ((unit * 2 + vt) * 64 + lane) * 8 + 4);
              vvq[0] = a.x; vvq[1] = a.y; vvq[2] = a.z; vvq[3] = a.w; vvq[4] = b2.x; vvq[5] = b2.y; vvq[6] = b2.z; vvq[7] = b2.w; }
            f32x16 w0 = zero16(), u0 = zero16(), y0 = zero16();
#pragma unroll
            for (int s = 0; s < 2; ++s) w0 = MFMA32(bmp[s], pkq(vvq, s), w0);
#pragma unroll
            for (int s = 0; s < 2; ++s) u0 = MFMA32(tp[s], pk8(w0, s), u0);
#pragma unroll
            for (int s = 0; s < 2; ++s) { y0 = MFMA32(abp[s], pk8(u0, s), y0); y0 = MFMA32(akp[s], pkq(vvq, s), y0); }
            st_frag(P.U0F + ((unit * 2 + vt) * 64 + lane) * 8, u0);
            st_frag(P.YF + ((unit * 2 + vt) * 64 + lane) * 8, y0);
        }
    }
    f32x16 qT = zero16();
#pragma unroll
    for (int s = 0; s < 2; ++s) qT = MFMA32(frag_nat(Tt, 32, cl, s, hi), frag_nat(AbL, 32, cl, s, hi), qT);
    const bf16x8 qp0 = pk8(qT, 0), qp1 = pk8(qT, 1);
#pragma unroll
    for (int ct = 0; ct < 2; ++ct) {
        f32x16 zh = zero16(), rh;
#pragma unroll
        for (int r = 0; r < 16; ++r) { const unsigned w = rtT[ct * 8 + (r >> 1)]; rh[r] = (r & 1) ? bfhi(w) : bflo(w); }
        unsigned zq[8];
#pragma unroll
        for (int q = 0; q < 8; ++q) { const unsigned lo_ = Zi[crow(2 * q, hi) * RW_SP + 32 * ct + cl], hi_ = Zi[crow(2 * q + 1, hi) * RW_SP + 32 * ct + cl]; zq[q] = lo_ | (hi_ << 16); }
        zh = MFMA32(pkq(zq, 0), tp[0], zh); zh = MFMA32(pkq(zq, 1), tp[1], zh);
        rh = MFMA32(pkq(zq, 0), qp0, rh); rh = MFMA32(pkq(zq, 1), qp1, rh);
        bf16* zrow = P.ZH + (unit * 32 + cl) * 64; bf16* rrow = P.RH + (unit * 32 + cl) * 64;
#pragma unroll
        for (int g = 0; g < 4; ++g) {
            const int pos = 16 * (2 * ct + (g >> 1)) + 8 * hi + 4 * (g & 1);
            v2u a, c2; a.x = cvtpk(zh[4 * g], zh[4 * g + 1]); a.y = cvtpk(zh[4 * g + 2], zh[4 * g + 3]); c2.x = cvtpk(rh[4 * g], rh[4 * g + 1]); c2.y = cvtpk(rh[4 * g + 2], rh[4 * g + 3]);
            *(GAS v2u*)(zrow + pos) = a; *(GAS v2u*)(rrow + pos) = c2;
        }
    }
    LDS_WAIT();
}

constexpr int SC_SLOTS = 5, SC_PIECES = 28, SC_SLOT_BYTES = SC_PIECES * 1024, SC_FLAGS = SC_SLOTS * SC_SLOT_BYTES;
DI void rwkv_scan_wg(const RwkvC& P, int b, int h, int vt, LAS unsigned char* lds, int wave, int lane) {
    const int cl = lane & 31, hi = lane >> 5; (void)cl;
    volatile LAS unsigned* flg = (volatile LAS unsigned*)(lds + SC_FLAGS);
    if (wave == 0 && lane < 8) flg[lane] = 0u;
    __syncthreads();
    const unsigned unit0 = (unsigned)((b * NH + h) * RW_NCH);
    if (wave >= 1 && wave <= SC_SLOTS) {
        LAS unsigned char* slot = lds + (wave - 1) * SC_SLOT_BYTES + lane * 16;
#pragma unroll 1
        for (int ch = wave - 1; ch < RW_NCH; ch += SC_SLOTS) {
            const unsigned unit = unit0 + ch;
            v4u pc[SC_PIECES];
            const bf16* zrow = P.ZH + (unit * 32 + (lane & 31)) * 64 + 8 * hi; const bf16* rrow = P.RH + (unit * 32 + (lane & 31)) * 64 + 8 * hi;
#pragma unroll
            for (int S = 0; S < 4; ++S) { pc[S] = *(const GAS v4u*)(zrow + 16 * S); pc[4 + S] = *(const GAS v4u*)(rrow + 16 * S); }
#pragma unroll
            for (int ct = 0; ct < 2; ++ct)
#pragma unroll
                for (int s2 = 0; s2 < 2; ++s2) pc[8 + ct * 2 + s2] = *(const GAS v4u*)(P.BF + ((unit * 2 + ct) * 64 + lane) * 8 + 4 * s2);
#pragma unroll
            for (int s2 = 0; s2 < 2; ++s2) { pc[12 + s2] = *(const GAS v4u*)(P.U0F + ((unit * 2 + vt) * 64 + lane) * 8 + 4 * s2); pc[14 + s2] = *(const GAS v4u*)(P.YF + ((unit * 2 + vt) * 64 + lane) * 8 + 4 * s2); }
#pragma unroll
            for (int ct = 0; ct < 2; ++ct)
#pragma unroll
                for (int s2 = 0; s2 < 2; ++s2) pc[16 + ct * 2 + s2] = *(const GAS v4u*)(P.GF + (((unit * 2 + ct) * 2 + vt) * 64 + lane) * 8 + 4 * s2);
#pragma unroll
            for (int ct = 0; ct < 2; ++ct)
#pragma unroll
                for (int g = 0; g < 4; ++g) pc[20 + ct * 4 + g] = *(const GAS v4u*)(P.PLF + unit * 64 + 32 * ct + 8 * g + 4 * hi);
            while ((int)flg[SC_SLOTS] < ch - SC_SLOTS + 1) __builtin_amdgcn_s_sleep(1);
#pragma unroll
            for (int p = 0; p < SC_PIECES; ++p) *(LAS v4u*)(slot + p * 1024) = pc[p];
            LDS_WAIT();
            if (lane == 0) flg[wave - 1] = (unsigned)(ch + 1);
        }
    } else if (wave == 0) {
        f32x16 st[2] = {zero16(), zero16()};
#pragma unroll 1
        for (int ch = 0; ch < RW_NCH; ++ch) {
            const unsigned unit = unit0 + ch;
            const int sl = ch % SC_SLOTS;
            const LAS unsigned char* slot = lds + sl * SC_SLOT_BYTES + lane * 16;
            while (flg[sl] != (unsigned)(ch + 1)) __builtin_amdgcn_s_sleep(1);
            v4u pc[SC_PIECES];
#pragma unroll
            for (int p = 0; p < SC_PIECES; ++p) pc[p] = *(const LAS v4u*)(slot + p * 1024);
            LDS_WAIT();
            if (lane == 0) flg[SC_SLOTS] = (unsigned)(ch + 1);
            f32x16 U, Y, gg[2];
#pragma unroll
            for (int q = 0; q < 4; ++q) { U[2 * q] = bflo(pc[12][q]); U[2 * q + 1] = bfhi(pc[12][q]); U[8 + 2 * q] = bflo(pc[13][q]); U[8 + 2 * q + 1] = bfhi(pc[13][q]);
                                          Y[2 * q] = bflo(pc[14][q]); Y[2 * q + 1] = bfhi(pc[14][q]); Y[8 + 2 * q] = bflo(pc[15][q]); Y[8 + 2 * q + 1] = bfhi(pc[15][q]); }
#pragma unroll
            for (int ct = 0; ct < 2; ++ct)
#pragma unroll
                for (int q = 0; q < 4; ++q) { gg[ct][2 * q] = bflo(pc[16 + 2 * ct][q]); gg[ct][2 * q + 1] = bfhi(pc[16 + 2 * ct][q]); gg[ct][8 + 2 * q] = bflo(pc[17 + 2 * ct][q]); gg[ct][8 + 2 * q + 1] = bfhi(pc[17 + 2 * ct][q]); }
#pragma unroll
            for (int ct = 0; ct < 2; ++ct)
#pragma unroll
                for (int s2 = 0; s2 < 2; ++s2) { const bf16x8 sb = pk8(st[ct], s2); U = MFMA32(__builtin_bit_cast(bf16x8, pc[2 * ct + s2]), sb, U); Y = MFMA32(__builtin_bit_cast(bf16x8, pc[4 + 2 * ct + s2]), sb, Y); }
            st_frag(P.YF + ((unit * 2 + vt) * 64 + lane) * 8, Y);
            const bf16x8 ub0 = pk8(U, 0), ub1 = pk8(U, 1);
#pragma unroll
            for (int ct = 0; ct < 2; ++ct) {
                f32x16 ns;
#pragma unroll
                for (int g = 0; g < 4; ++g) { const v4u pw = pc[20 + ct * 4 + g];
                    ns[4 * g] = __uint_as_float(pw.x) * st[ct][4 * g] + gg[ct][4 * g]; ns[4 * g + 1] = __uint_as_float(pw.y) * st[ct][4 * g + 1] + gg[ct][4 * g + 1];
                    ns[4 * g + 2] = __uint_as_float(pw.z) * st[ct][4 * g + 2] + gg[ct][4 * g + 2]; ns[4 * g + 3] = __uint_as_float(pw.w) * st[ct][4 * g + 3] + gg[ct][4 * g + 3]; }
                ns = MFMA32(__builtin_bit_cast(bf16x8, pc[8 + 2 * ct]), ub0, ns); ns = MFMA32(__builtin_bit_cast(bf16x8, pc[8 + 2 * ct + 1]), ub1, ns);
                st[ct] = ns;
            }
        }
    }
    __syncthreads();
}

DI void rwkv_post_unit(const RwkvC& P, int b, int h, int ch, LAS unsigned char* lw_, int lane) {
    const int cl = lane & 31, hi = lane >> 5;
    const unsigned unit = (unsigned)((b * NH + h) * RW_NCH + ch);
    const unsigned row0 = (unsigned)(b * SEQ + ch * RW_L);
    LAS bf16* X1 = (LAS bf16*)lw_;
    f32x16 y[2], gt[2], vv[2];
#pragma unroll
    for (int vt = 0; vt < 2; ++vt) { y[vt] = ld_frag(P.YF + ((unit * 2 + vt) * 64 + lane) * 8); gt[vt] = ld_frag(P.GTF + ((unit * 2 + vt) * 64 + lane) * 8); vv[vt] = ld_frag(P.VFf + ((unit * 2 + vt) * 64 + lane) * 8); }
    const float lg0 = P.lnx_g[h * 64 + cl], lg1 = P.lnx_g[h * 64 + 32 + cl], lb0 = P.lnx_b[h * 64 + cl], lb1 = P.lnx_b[h * 64 + 32 + cl];
    f32x16 o0, o1;
#pragma unroll
    for (int r = 0; r < 16; ++r) {
        const float mean = half_sum(y[0][r] + y[1][r], lane) * (1.f / 64.f);
        const float d0 = y[0][r] - mean, d1 = y[1][r] - mean;
        const float var = half_sum(d0 * d0 + d1 * d1, lane) * (1.f / 64.f);
        const float rs = rsqrtf(var + LNX_EPS);
        const float bo = P.BON[(row0 + crow(r, hi)) * 8 + h];
        o0[r] = (d0 * rs * lg0 + lb0 + bo * vv[0][r]) * gt[0][r];
        o1[r] = (d1 * rs * lg1 + lb1 + bo * vv[1][r]) * gt[1][r];
    }
    stage_n(X1, o0, o1, cl, hi); LDS_WAIT();
#pragma unroll
    for (int i = 0; i < 4; ++i) { const int pc = lane + 64 * i, t = pc >> 3, q = pc & 7;
        const v4u w = *(const LAS v4u*)(X1 + t * RW_SP + 8 * q);
        *(GAS v4u*)(P.ymix + (row0 + t) * D + h * 64 + 8 * q) = w; }
    LDS_WAIT();
}
constexpr int NPHASE = 28;
#ifndef MK_SINGLE
#define MK_SINGLE 1
#endif
struct Args { const float* in[46]; float* out; unsigned char* ws; int ph_lo, ph_hi; };

DI unsigned char* opq(unsigned char* p) { GAS unsigned char* g = (GAS unsigned char*)p; asm volatile("" : "+s"(g)); return (unsigned char*)g; }
DI int opqs(int v) { asm volatile("" : "+s"(v)); return v; }
DI int opqv(int v) { asm volatile("" : "+v"(v)); return v; }
DI const float* inp(int i) { typedef const GAS float* gfp; const __attribute__((address_space(4))) gfp* t = (const __attribute__((address_space(4))) gfp*)__builtin_amdgcn_kernarg_segment_ptr(); asm volatile("" : "+s"(t)); return (const float*)t[i]; }

__global__ void __launch_bounds__(NWAVES * 64, 2) fwd_kernel(Args args) {
    extern __shared__ __attribute__((aligned(16))) unsigned char lds_raw[];
    LAS unsigned char* lds = (LAS unsigned char*)lds_raw;
    volatile LAS unsigned* MISC = (volatile LAS unsigned*)(lds + MISC_OFF);
    const int wave0 = __builtin_amdgcn_readfirstlane((int)threadIdx.x >> 6);
    const int G0 = gridDim.x, blk0 = blockIdx.x;
#define PHV const int lane = opqv(lane_id()), blk = opqs(blk0), G = opqs(G0), wave = opqs(wave0), tid = wave * 64 + lane, gw = blk * NWAVES + wave, NGW = G * NWAVES; (void)tid; (void)lane; (void)gw; (void)NGW; (void)wave
    unsigned char* ws0 = args.ws;
#define ws opq(ws0)
#define ctl ((unsigned*)(ws + WS_CTL))
    for (int u = wave0 * 64 + lane_id(); u < (LDS_BYTES - MISC_OFF) / 4; u += NWAVES * 64) ((LAS unsigned*)(lds + MISC_OFF))[u] = 0u;
    __syncthreads();
#if MK_SINGLE
    constexpr int lo = 0, hi = NPHASE;
#else
    const int lo = args.ph_lo, hi = args.ph_hi;
#endif
    if (hi - lo > 1) (void)xcd_barrier_post(ctl + CW_BAR, MISC + 8, wave0 * 64 + lane_id());
#ifndef PHMASK
#define PHMASK 0xFFFFFFF
#endif
#define IN(k) (((PHMASK >> (k)) & 1) && lo <= (k) && (k) < hi)
#ifndef GEMM_REP
#define GEMM_REP 1
#endif
#define GRID_BAR() do { XcdBarrier bb_; bb_.bar = ctl + CW_BAR; bb_.x = xb_xcc_id(); bb_.st = MISC + 8; xcd_barrier(bb_, opqs(wave0) * 64 + opqv(lane_id())); } while (0)
#define GEMM_RUN(...) do { __VA_ARGS__; if (GEMM_REP > 1) { GRID_BAR(); __VA_ARGS__; } } while (0)
#ifndef PROBE_MASK
#define PROBE_MASK 0u
#endif
    unsigned long long tph_ = PROBE_MASK ? __builtin_amdgcn_s_memrealtime() : 0ull;
#define SEAM(k) do { if (IN(k) && IN((k) + 1)) { XcdBarrier bb_; bb_.bar = ctl + CW_BAR; bb_.x = xb_xcc_id(); bb_.st = MISC + 8; xcd_barrier(bb_, opqs(wave0) * 64 + opqv(lane_id())); \
        if (PROBE_MASK) { const unsigned long long t1_ = __builtin_amdgcn_s_memrealtime(); if ((PROBE_MASK >> (k)) & 1u) { while (__builtin_amdgcn_s_memrealtime() - t1_ < t1_ - tph_) __builtin_amdgcn_s_sleep(8); } tph_ = __builtin_amdgcn_s_memrealtime(); } } } while (0)

#define B_HN ((bf16*)(ws + WS_HN))
#define B_YMIX ((bf16*)(ws + WS_YMIX))
#define B_VF ((bf16*)(ws + WS_VF))
#define B_PA ((bf16*)(ws + WS_PA))
#define B_PB ((bf16*)(ws + WS_PB))
#define B_Y ((bf16*)(ws + WS_Y))
    float* xo = args.out;
#define x_in inp(0)

    if (IN(0)) { PHV;
        LAS float* scr = (LAS float*)(lds + wave * 16384);
        conv_matrix<1>(inp(2), D, 3232, (bf16*)(ws + WS_WIN0), 1696, scr, gw, NGW, lane);
        conv_matrix<1>(inp(23), D, 3264, (bf16*)(ws + WS_WIN1), 1728, scr, gw, NGW, lane);
        zero_rows((bf16*)(ws + WS_WIN0), D, 1696, NA, gw, NGW, lane);
        zero_rows((bf16*)(ws + WS_WIN1), D, 1728, NA, gw, NGW, lane);
        conv_matrix<0>(inp(15), D, D, (bf16*)(ws + WS_WOUT0), 0, scr, gw, NGW, lane);
        conv_matrix<0>(inp(38), D, D, (bf16*)(ws + WS_WOUT1), 0, scr, gw, NGW, lane);
        conv_matrix<2>(inp(18), D, FF, (bf16*)(ws + WS_WGU0), 0, scr, gw, NGW, lane);
        conv_matrix<3>(inp(19), D, FF, (bf16*)(ws + WS_WGU0), 0, scr, gw, NGW, lane);
        conv_matrix<0>(inp(20), FF, D, (bf16*)(ws + WS_WDN0), 0, scr, gw, NGW, lane);
        phase_norm0(x_in, inp(1), B_HN, gw, NGW, lane);
        {
            bf16* upt = (bf16*)(ws + WS_UPT);
            for (int i = gw * 64 + lane; i < 2 * 8 * 12288; i += NGW * 64) {
                const int l2 = i / (8 * 12288), rem = i % (8 * 12288), hh = rem / 12288, e = rem % 12288;
                float val = 0.f;
                if (e < 2048) { const int c = e >> 5, k = e & 31; val = inp(l2 ? 26 : 5)[k * 512 + hh * 64 + c]; }
                else if (e < 4096) { const int c = (e - 2048) >> 5, k = e & 31; val = inp(l2 ? 28 : 7)[k * 512 + hh * 64 + c]; }
                else if (e < 6144) { const int c = (e - 4096) >> 5, k = e & 31; if (l2) val = inp(31)[k * 512 + hh * 64 + c]; }
                else { const int c = (e - 6144) / 96, k = (e - 6144) % 96; val = inp(l2 ? 29 : 8)[k * 512 + hh * 64 + c]; }
                upt[i] = f2bf(val);
            }
        }
    }
    SEAM(0);

#pragma unroll
    for (int l = 0; l < 2; ++l) {
        const int pb = l ? 10 : 1;
        if (IN(pb)) { PHV;
            {
                pg8::Gemm g{B_HN, (const bf16*)(ws + (l ? WS_WIN1 : WS_WIN0)), M, 1536, D}; pg8::StaticOrder S; S.init(M, 1536, G, blk);
                pg8::EpiProjT E{B_PA};
                GEMM_RUN(pg8::gemm_phase<pg8::EpiProjT, pg8::StaticOrder, true, true, true>(lds, g, S, E, tid));
            }
            {
                pg8::Gemm g{B_HN, (const bf16*)(ws + (l ? WS_WIN1 : WS_WIN0)) + (size_t)1536 * D, M, 1792, D}; pg8::StaticOrder S; S.init(M, 1792, G, blk);
                pg8::EpiProj E{(bf16*)(ws + WS_PAS), B_PB};
                GEMM_RUN(pg8::gemm_phase<pg8::EpiProj, pg8::StaticOrder, true, true>(lds, g, S, E, tid));
            }
        }
        SEAM(pb);
#define RWKV_SETUP \
            RwkvC P; { const int o = l ? 21 : 0, o2 = l ? 23 : 0; unsigned char* w_ = ws; \
            P.PAT = (const bf16*)(w_ + WS_PA); P.PAS = (const bf16*)(w_ + WS_PAS); P.mu = inp(3 + o); P.decay0 = inp(4 + o); P.iclr0 = inp(6 + o); P.vres0 = inp(30); \
            P.k_k = inp(9 + o2); P.k_a = inp(10 + o2); P.r_k = inp(11 + o2); P.lnx_g = inp(12 + o2); P.lnx_b = inp(13 + o2); \
            P.upT = (const bf16*)(w_ + WS_UPT) + (size_t)l * 8 * 12288; P.VFf = (unsigned*)(w_ + WS_VF); P.ZH = (bf16*)(w_ + WS_ZH); P.RH = (bf16*)(w_ + WS_RH); \
            P.BF = (unsigned*)(w_ + WS_BF); P.U0F = (unsigned*)(w_ + WS_U0F); P.YF = (unsigned*)(w_ + WS_YF); P.GTF = (unsigned*)(w_ + WS_GTF); P.GF = (unsigned*)(w_ + WS_GF); \
            P.PLF = (float*)(w_ + WS_PLF); P.BON = (float*)(w_ + WS_BON); P.ymix = (bf16*)(w_ + WS_YMIX); P.has_vres = l; }
        if (IN(pb + 1)) { PHV;
            RWKV_SETUP
            for (int u = blk; u < NBATCH * RW_NCH; u += G) rwkv_pre_unit(P, u / RW_NCH, wave, u % RW_NCH, lds + wave * RW_WAVE_LDS, lane_id());
        }
        SEAM(pb + 1);
        if (IN(pb + 2)) { PHV;
            const bool split = G >= 128;
            if (!split || blk < 64) {
                { RWKV_SETUP
                    for (int cid = blk; cid < 64; cid += G) rwkv_scan_wg(P, cid >> 4, (cid >> 1) & 7, cid & 1, lds, wave, lane); }
            }
            if (!split || blk >= 64) {
                const float* sbg = inp(14 + (l ? 23 : 0));
                const int sbw = split ? G - 64 : G, sbi = split ? blk - 64 : blk;
                for (int u = sbi; u < NBATCH * NH * (SEQ / 256); u += sbw) {
                    const int qb = u & 31, bh = u >> 5;
                    sb_wave(B_PB, B_YMIX, sbg, bh >> 3, bh & 7, qb * 256 + wave * 32, lds + wave * 8192, lane_id());
                }
            }
        }
        SEAM(pb + 2);
        if (IN(pb + 3)) { PHV;
            RWKV_SETUP
            for (int u = blk; u < NBATCH * RW_NCH; u += G) rwkv_post_unit(P, u / RW_NCH, wave, u % RW_NCH, lds + wave * RW_WAVE_LDS, lane_id());
        }
        SEAM(pb + 3);
        if (IN(pb + 4)) { PHV;
            pg8::Gemm g{B_YMIX, (const bf16*)(ws + (l ? WS_WOUT1 : WS_WOUT0)), M, D, D}; pg8::StaticOrder S; S.init(M, D, G, blk);
            pg8::EpiBf16Plain E{B_Y, D};
            GEMM_RUN(pg8::gemm_phase<pg8::EpiBf16Plain, pg8::StaticOrder, true, true>(lds, g, S, E, tid));
        }
        SEAM(pb + 4);
        if (IN(pb + 5)) { PHV;
            if (l == 0) phase_resnorm<false>(x_in, B_Y, nullptr, inp(16), inp(17), xo, (bf16*)(ws + WS_HNF0), nullptr, nullptr, nullptr, nullptr, gw, NGW, lane);
            else phase_resnorm<false>(xo, B_Y, nullptr, inp(39), inp(40), xo, (bf16*)(ws + WS_HNF1), inp(41), (unsigned*)(ws + WS_SEL), (float*)(ws + WS_GTS), ctl + CW_TOT, gw, NGW, lane);
        }
        SEAM(pb + 5);
    if (l == 0) {
        if (IN(7)) { PHV;
            pg8::Gemm g{(const bf16*)(ws + WS_HNF0), (const bf16*)(ws + WS_WGU0), M, 2 * FF, D}; pg8::StaticOrder S; S.init(M, 2 * FF, G, blk);
            pg8::EpiSwiglu E{(bf16*)(ws + WS_H0), FF, 0};
            GEMM_RUN(pg8::gemm_phase<pg8::EpiSwiglu, pg8::StaticOrder, true, true>(lds, g, S, E, tid));
        }
        SEAM(7);
        if (IN(8)) { PHV;
            pg8::Gemm g{(const bf16*)(ws + WS_H0), (const bf16*)(ws + WS_WDN0), M, D, FF}; pg8::StaticOrder S; S.init(M, D, G, blk);
            pg8::EpiBf16Plain E{(bf16*)(ws + WS_F), D};
            GEMM_RUN(pg8::gemm_phase<pg8::EpiBf16Plain, pg8::StaticOrder, true, true>(lds, g, S, E, tid));
        }
        SEAM(8);
        if (IN(9)) { PHV; phase_resnorm<false>(xo, (const bf16*)(ws + WS_F), nullptr, inp(21), inp(22), xo, B_HN, nullptr, nullptr, nullptr, nullptr, gw, NGW, lane); }
        SEAM(9);
    } else {
        if (IN(16)) { PHV;
            LAS float* scr = (LAS float*)(lds + wave * 16384);
#pragma unroll 1
            for (int e = 0; e < NE; ++e) {
                conv_matrix<2>(inp(42) + (size_t)e * D * FF, D, FF, (bf16*)(ws + WS_WMGU) + (size_t)e * 2 * FF * D, 0, scr, gw, NGW, lane);
                conv_matrix<3>(inp(43) + (size_t)e * D * FF, D, FF, (bf16*)(ws + WS_WMGU) + (size_t)e * 2 * FF * D, 0, scr, gw, NGW, lane);
                conv_matrix<0>(inp(44) + (size_t)e * D * FF, FF, D, (bf16*)(ws + WS_WMDN) + (size_t)e * D * FF, 0, scr, gw, NGW, lane);
            }
            phase_moe_sort((const unsigned*)(ws + WS_SEL), (const float*)(ws + WS_GTS), ctl + CW_TOT, ctl + CW_CUR, (unsigned*)(ws + WS_POS), (float*)(ws + WS_GSORT), (const bf16*)(ws + WS_HNF1), (bf16*)(ws + WS_HS), gw, NGW, lane);
        }
        SEAM(16);
#pragma unroll 1
        for (int p = 0; p < MOE_PARTS; ++p) {
            const int phg = 17 + 2 * p;
            if (IN(phg) || IN(phg + 1)) {
                PHV;
                int mytot; const int myoff = moe_offsets(ctl + CW_TOT, lane, mytot);
                pg8::MoeOrder S;
                const int nTiles = __builtin_amdgcn_readfirstlane(shi(myoff, 8)) >> 8;
                S.ts1 = __builtin_amdgcn_readfirstlane(shi(myoff, 1)) >> 8; S.ts2 = __builtin_amdgcn_readfirstlane(shi(myoff, 2)) >> 8; S.ts3 = __builtin_amdgcn_readfirstlane(shi(myoff, 3)) >> 8;
                S.ts4 = __builtin_amdgcn_readfirstlane(shi(myoff, 4)) >> 8; S.ts5 = __builtin_amdgcn_readfirstlane(shi(myoff, 5)) >> 8; S.ts6 = __builtin_amdgcn_readfirstlane(shi(myoff, 6)) >> 8;
                S.ts7 = __builtin_amdgcn_readfirstlane(shi(myoff, 7)) >> 8;
                const int t0 = p * MOE_PART_TILES; int nT = nTiles - t0; nT = nT < 0 ? 0 : (nT > MOE_PART_TILES ? MOE_PART_TILES : nT);
                S.t0 = t0; S.nT = nT; S.G = G; S.c = blk;
                if (IN(phg)) { PHV;
                    S.nN = 2 * FF / 256; S.nwg = nT * S.nN; S.nNe = 2 * FF / 256; S.arel = 0;
                    pg8::Gemm g{(const bf16*)(ws + WS_HS), (const bf16*)(ws + WS_WMGU), 0, 0, D};
                    pg8::EpiSwiglu E{(bf16*)(ws + WS_HP), FF, -(long)t0 * 256};
                    GEMM_RUN(pg8::gemm_phase<pg8::EpiSwiglu, pg8::MoeOrder, true, true>(lds, g, S, E, tid));
                }
                SEAM(phg);
                if (IN(phg + 1)) { PHV;
                    S.nN = D / 256; S.nwg = nT * S.nN; S.nNe = D / 256; S.arel = 1;
                    pg8::Gemm g{(const bf16*)(ws + WS_HP), (const bf16*)(ws + WS_WMDN), 0, 0, FF};
                    pg8::EpiMoeDown E{(bf16*)(ws + WS_HS), D, (const float*)(ws + WS_GSORT)};
                    GEMM_RUN(pg8::gemm_phase<pg8::EpiMoeDown, pg8::MoeOrder, true, true>(lds, g, S, E, tid));
                }
                SEAM(phg + 1);
            }
        }
        if (IN(27)) { PHV; phase_resnorm<true>(xo, (const bf16*)(ws + WS_HS), (const unsigned*)(ws + WS_POS), inp(45), nullptr, xo, nullptr, nullptr, nullptr, nullptr, nullptr, gw, NGW, lane); }
    }
    }
#undef IN
#undef SEAM
#undef x_in
#undef PHV
#undef ws
#undef ctl
#undef B_HN
#undef B_YMIX
#undef B_VF
#undef B_PA
#undef B_PB
#undef B_Y
}

extern "C" void kernel_launch(void* const* d_in, const int* in_sizes, int n_in, void* d_out, int out_size, void* d_ws, size_t ws_size, hipStream_t stream) {
    static int grid = 0;
    if (grid == 0) {
        if (n_in != 46 || in_sizes[0] != M * D || out_size != M * D || ws_size < WS_END) { fprintf(stderr, "kernel_launch: unexpected problem: n_in %d in0 %d out %d ws %zu (need %zu)\n", n_in, n_in > 0 ? in_sizes[0] : -1, out_size, ws_size, (size_t)WS_END); grid = -1; return; }
        int dev = 0, cus = 0, per_cu = 0;
        if (hipGetDevice(&dev) != hipSuccess || hipDeviceGetAttribute(&cus, hipDeviceAttributeMultiprocessorCount, dev) != hipSuccess) { grid = -1; return; }
        if (hipFuncSetAttribute((const void*)fwd_kernel, hipFuncAttributeMaxDynamicSharedMemorySize, LDS_BYTES) != hipSuccess) { fprintf(stderr, "kernel_launch: hipFuncSetAttribute failed\n"); grid = -1; return; }
        if (hipOccupancyMaxActiveBlocksPerMultiprocessor(&per_cu, (const void*)fwd_kernel, NWAVES * 64, LDS_BYTES) != hipSuccess || per_cu < 1) { fprintf(stderr, "kernel_launch: occupancy query says %d\n", per_cu); }
        (void)hipGetLastError();
        grid = cus;
    }
    if (grid < 0) return;
    (void)hipMemsetAsync((char*)d_ws + WS_CTL, 0, CTL_ZERO_BYTES, stream);
    Args a{};
    for (int i = 0; i < 46; ++i) a.in[i] = (const float*)d_in[i];
    a.out = (float*)d_out; a.ws = (unsigned char*)d_ws;
#if MK_SINGLE
    a.ph_lo = 0; a.ph_hi = NPHASE;
    hipLaunchKernelGGL(fwd_kernel, dim3(grid), dim3(NWAVES * 64), LDS_BYTES, stream, a);
#else
    for (int p = 0; p < NPHASE; ++p) { a.ph_lo = p; a.ph_hi = p + 1; hipLaunchKernelGGL(fwd_kernel, dim3(grid), dim3(NWAVES * 64), LDS_BYTES, stream, a); }
#endif
}
```

```cpp
#include <hip/hip_runtime.h>
#include <cstdio>
#include <cstdint>
namespace pg8 {
#define PG8_LAS __attribute__((address_space(3)))
typedef unsigned short bf16_t;
typedef short bf16x8 __attribute__((ext_vector_type(8)));
typedef float f32x4 __attribute__((ext_vector_type(4)));
typedef unsigned u32x4 __attribute__((ext_vector_type(4)));
constexpr int BM = 256, BK = 64, HALF = 128, HTB = HALF * BK * 2  , STAGE_BYTES = 8 * HTB, NXCD = 8, WGM = 8;

__host__ __device__ __forceinline__ int lds_byte(int r, int c) { const int st = (r >> 4) * 2 + (c >> 5), rr = r & 15, cc = c & 31, ob = rr * 64 + cc * 2; return st * 1024 + (ob ^ (((ob >> 9) & 1) << 5)); }
__host__ __device__ __forceinline__ void stage_rc(int b, int& R, int& C) { const int st = b / 1024, sb = b % 1024, swz = sb ^ (((sb >> 9) & 1) << 5); R = (st >> 1) * 16 + swz / 64; C = (st & 1) * 32 + (swz % 64) / 2; }
__host__ __device__ __forceinline__ int perm32(int rho) { const int n = rho >> 4, i = rho & 15; return 8 * (i >> 2) + 4 * n + (i & 3); }

struct Unit { int pm, pa, pn, po; };
struct Gemm { const bf16_t* A; const bf16_t* Bt; int M, N, K; int sa, sb; };

struct StaticOrder {
    int nM, nN, nwg, G, c;
    __host__ __device__ void init(int M, int N, int G_, int c_) { nM = M / BM; nN = N / BM; nwg = nM * nN; G = G_; c = c_; }
    __host__ __device__ bool next(int i, Unit& u) const {
        const long L = (long)i * G + c; if (L >= nwg) return false;
        int wgid = (int)L; { const int q = nwg / NXCD, r = nwg % NXCD, xcd = wgid % NXCD, off = wgid / NXCD; wgid = (xcd < r ? xcd * (q + 1) : r * (q + 1) + (xcd - r) * q) + off; }
        const int nig = WGM * nN, gid = wgid / nig, fm = gid * WGM, gsz = (nM - fm) < WGM ? (nM - fm) : WGM;
        u.pm = fm + ((wgid % nig) % gsz); u.pn = (wgid % nig) / gsz; u.pa = u.pm; u.po = u.pn; return true;
    }
    __device__ __forceinline__ void a_ready(const Unit&) const {}
    __device__ __forceinline__ void done(const Unit&) const {}
};

__device__ __forceinline__ unsigned cvt_pk_bf16(float lo, float hi) { unsigned r; asm volatile("v_cvt_pk_bf16_f32 %0, %1, %2" : "=v"(r) : "v"(lo), "v"(hi)); return r; }
typedef float f32x2 __attribute__((ext_vector_type(2)));

template <class Epi, class Sched, bool ALIGN_EPI = false, bool SP2 = false, bool SWAP = false, bool FP8 = false>
__device__ __forceinline__ void gemm_phase(PG8_LAS unsigned char* lds, const Gemm g, const Sched& S, const Epi& E, int tid_in) {
    int tid_ = tid_in; asm volatile("" : "+v"(tid_));
    const int tid = tid_, wid = __builtin_amdgcn_readfirstlane(tid >> 6), lane = tid & 63, wr = wid >> 2, wc = wid & 3, fr = lane & 15, fq = lane >> 4;
    const int K = g.K, nt = K / BK;
    unsigned voffA[2], voffB[2];
#pragma unroll
    for (int i = 0; i < 2; ++i) { int R, C; stage_rc(tid * 16 + i * 8192, R, C); const int Rb = Epi::PERM ? ((R & ~31) + perm32(R & 31)) : R;
        voffA[i] = (unsigned)(R * K + C) * 2u; voffB[i] = (unsigned)(Rb * K + C) * 2u; }
    const size_t kstep = (size_t)(BK * 2);
    const size_t hstep = (size_t)HALF * K * 2;
    const size_t tstep = 2 * hstep;
    const unsigned ldsw = (unsigned)wid * 1024u;
    const int aoff = lds_byte(wr * 64 + fr, fq * 8), boff = lds_byte(wc * 32 + fr, fq * 8);
#define PG8_SA(b, h) (((b) * 2 + (h)) * HTB)
#define PG8_SB(b, h) ((4 + (b) * 2 + (h)) * HTB)
#define PG8_STAGE(bufoff, gbase, voff) do { _Pragma("unroll") for (int _i = 0; _i < 2; ++_i) \
        __builtin_amdgcn_global_load_lds((const unsigned*)((const char*)(gbase) + (voff)[_i]), (PG8_LAS unsigned*)(lds + (bufoff) + ldsw + _i * 8192), 16, 0, 0); } while (0)
#define PG8_LDA(dst, b, h) do { _Pragma("unroll") for (int m = 0; m < 4; ++m) dst[m] = __builtin_shufflevector(*(const PG8_LAS bf16x8*)(lds + PG8_SA(b, h) + aoff + m * 2048), *(const PG8_LAS bf16x8*)(lds + PG8_SA(b, h) + aoff + m * 2048 + 1024), 0, 1, 2, 3, 4, 5, 6, 7, 8, 9, 10, 11, 12, 13, 14, 15); } while (0)
#define PG8_LDB(dst, b, h) do { _Pragma("unroll") for (int n = 0; n < 2; ++n) dst[n] = __builtin_shufflevector(*(const PG8_LAS bf16x8*)(lds + PG8_SB(b, h) + boff + n * 2048), *(const PG8_LAS bf16x8*)(lds + PG8_SB(b, h) + boff + n * 2048 + 1024), 0, 1, 2, 3, 4, 5, 6, 7, 8, 9, 10, 11, 12, 13, 14, 15); } while (0)
#define PG8_HALF(v, k) ((k) ? __builtin_shufflevector(v, v, 8, 9, 10, 11, 12, 13, 14, 15) : __builtin_shufflevector(v, v, 0, 1, 2, 3, 4, 5, 6, 7))
#define PG8_MMA(ai, bj, At, Bt) do { __builtin_amdgcn_s_setprio(1); \
        if constexpr (FP8) { typedef int v8i_ __attribute__((ext_vector_type(8))); \
            _Pragma("unroll") for (int m = 0; m < 4; ++m) _Pragma("unroll") for (int n = 0; n < 2; ++n) \
                asm volatile("v_mfma_scale_f32_16x16x128_f8f6f4 %0, %1, %2, %0, %3, %4 op_sel_hi:[0,0,0]" : "+v"(acc[ai][bj][m][n]) : "v"(__builtin_bit_cast(v8i_, Bt[n])), "v"(__builtin_bit_cast(v8i_, At[m])), "v"(g.sb), "v"(g.sa));   \
        } else { _Pragma("unroll") for (int m = 0; m < 4; ++m) _Pragma("unroll") for (int n = 0; n < 2; ++n) _Pragma("unroll") for (int k = 0; k < 2; ++k) \
            acc[ai][bj][m][n] = SWAP ? __builtin_amdgcn_mfma_f32_16x16x32_bf16(PG8_HALF(At[m], k), PG8_HALF(Bt[n], k), acc[ai][bj][m][n], 0, 0, 0) : __builtin_amdgcn_mfma_f32_16x16x32_bf16(PG8_HALF(Bt[n], k), PG8_HALF(At[m], k), acc[ai][bj][m][n], 0, 0, 0); } \
        __builtin_amdgcn_s_setprio(0); } while (0)
#define PG8_WAIT_V(n) asm volatile("s_waitcnt vmcnt(" #n ")" ::: "memory")
#define PG8_WAIT_L(n) asm volatile("s_waitcnt lgkmcnt(" #n ")" ::: "memory")
#define PG8_BAR __builtin_amdgcn_s_barrier()
#define PG8_SCHED __builtin_amdgcn_sched_barrier(0)
    Unit cur, nxt; int ui = 0;
    if (!S.next(0, cur)) return;
    f32x4 acc[2][2][4][2];
#pragma unroll
    for (int a = 0; a < 2; ++a)
#pragma unroll
        for (int b = 0; b < 2; ++b)
#pragma unroll
            for (int m = 0; m < 4; ++m)
#pragma unroll
                for (int n = 0; n < 2; ++n) acc[a][b][m][n] = (f32x4){0.f, 0.f, 0.f, 0.f};
    typedef short s16x16 __attribute__((ext_vector_type(16)));
    s16x16 At[4], B0[2], B1[2];
    const char* cA = (const char*)g.A + (size_t)cur.pa * tstep; const char* cB = (const char*)g.Bt + (size_t)cur.pn * tstep;
    S.a_ready(cur);
    if constexpr (SP2) {
        PG8_STAGE(PG8_SB(0, 0), cB, voffB); PG8_STAGE(PG8_SB(0, 1), cB + hstep, voffB); PG8_STAGE(PG8_SA(0, 0), cA, voffA); PG8_STAGE(PG8_SA(0, 1), cA + hstep, voffA);
        if (wr == 1) PG8_BAR;
        PG8_WAIT_V(2); PG8_BAR;
        PG8_STAGE(PG8_SB(1, 0), cB + kstep, voffB); PG8_STAGE(PG8_SA(1, 0), cA + kstep, voffA); PG8_STAGE(PG8_SB(1, 1), cB + hstep + kstep, voffB);
        PG8_WAIT_V(6); PG8_BAR;
    } else {
        PG8_STAGE(PG8_SB(0, 0), cB, voffB); PG8_STAGE(PG8_SA(0, 0), cA, voffA); PG8_STAGE(PG8_SB(0, 1), cB + hstep, voffB); PG8_STAGE(PG8_SA(0, 1), cA + hstep, voffA);
        if (wr == 1) PG8_BAR;
        PG8_WAIT_V(4); PG8_BAR;
        PG8_STAGE(PG8_SB(1, 0), cB + kstep, voffB); PG8_STAGE(PG8_SA(1, 0), cA + kstep, voffA); PG8_STAGE(PG8_SB(1, 1), cB + hstep + kstep, voffB);
        PG8_WAIT_V(6); PG8_BAR;
    }
    for (;;) {
        const bool has_next = S.next(ui + 1, nxt);
        const char* nA = has_next ? (const char*)g.A + (size_t)nxt.pa * tstep : cA; const char* nB = has_next ? (const char*)g.Bt + (size_t)nxt.pn * tstep : cB;
#pragma unroll 1
        for (int t = 0; t < nt; t += 2) {
            const bool last = (t == nt - 2);
            const char* a1 = cA + (size_t)(t + 1) * kstep;
            const char* a2 = last ? nA : cA + (size_t)(t + 2) * kstep; const char* b2 = last ? nB : cB + (size_t)(t + 2) * kstep;
            const char* a3 = a2 + kstep; const char* b3 = b2 + kstep;
            if (last && has_next) S.a_ready(nxt);
            if constexpr (SP2) {
            PG8_LDB(B0, 0, 0); PG8_LDB(B1, 0, 1); PG8_SCHED; PG8_LDA(At, 0, 0); PG8_STAGE(PG8_SA(1, 1), a1 + hstep, voffA);
            PG8_WAIT_V(8); PG8_WAIT_L(0); PG8_BAR; PG8_MMA(0, 0, At, B0); PG8_MMA(0, 1, At, B1); PG8_BAR; PG8_SCHED;
            PG8_LDA(At, 0, 1); PG8_STAGE(PG8_SB(0, 0), b2, voffB); PG8_STAGE(PG8_SB(0, 1), b2 + hstep, voffB); PG8_STAGE(PG8_SA(0, 0), a2, voffA);
            PG8_WAIT_V(8); PG8_WAIT_L(0); PG8_BAR; PG8_MMA(1, 0, At, B0); PG8_MMA(1, 1, At, B1); PG8_BAR; PG8_SCHED;
            PG8_LDB(B0, 1, 0); PG8_LDB(B1, 1, 1); PG8_SCHED; PG8_LDA(At, 1, 0); PG8_STAGE(PG8_SA(0, 1), a2 + hstep, voffA);
            PG8_WAIT_V(8); PG8_WAIT_L(0); PG8_BAR; PG8_MMA(0, 0, At, B0); PG8_MMA(0, 1, At, B1); PG8_BAR; PG8_SCHED;
            PG8_LDA(At, 1, 1); PG8_STAGE(PG8_SB(1, 0), b3, voffB); PG8_STAGE(PG8_SB(1, 1), b3 + hstep, voffB); PG8_STAGE(PG8_SA(1, 0), a3, voffA);
            PG8_WAIT_V(8); PG8_WAIT_L(0); PG8_BAR; PG8_MMA(1, 0, At, B0); PG8_MMA(1, 1, At, B1); PG8_BAR; PG8_SCHED;
            } else {
            PG8_LDB(B0, 0, 0); PG8_SCHED; PG8_LDA(At, 0, 0); PG8_STAGE(PG8_SA(1, 1), a1 + hstep, voffA);
            PG8_WAIT_L(8); PG8_BAR; PG8_WAIT_L(0); PG8_MMA(0, 0, At, B0); PG8_BAR; PG8_SCHED;
            PG8_LDB(B1, 0, 1); PG8_STAGE(PG8_SB(0, 0), b2, voffB);
            PG8_BAR; PG8_WAIT_L(0); PG8_MMA(0, 1, At, B1); PG8_BAR;
            PG8_LDA(At, 0, 1); PG8_STAGE(PG8_SA(0, 0), a2, voffA);
            PG8_BAR; PG8_WAIT_L(0); PG8_MMA(1, 0, At, B0); PG8_BAR; PG8_SCHED;
            PG8_STAGE(PG8_SB(0, 1), b2 + hstep, voffB);
            PG8_WAIT_V(6); PG8_BAR; PG8_MMA(1, 1, At, B1); PG8_BAR;
            PG8_LDB(B0, 1, 0); PG8_SCHED; PG8_LDA(At, 1, 0); PG8_STAGE(PG8_SA(0, 1), a2 + hstep, voffA);
            PG8_WAIT_L(8); PG8_BAR; PG8_WAIT_L(0); PG8_MMA(0, 0, At, B0); PG8_BAR; PG8_SCHED;
            PG8_LDB(B1, 1, 1); PG8_STAGE(PG8_SB(1, 0), b3, voffB);
            PG8_BAR; PG8_WAIT_L(0); PG8_MMA(0, 1, At, B1); PG8_BAR;
            PG8_LDA(At, 1, 1); PG8_STAGE(PG8_SA(1, 0), a3, voffA);
            PG8_BAR; PG8_WAIT_L(0); PG8_MMA(1, 0, At, B0); PG8_BAR; PG8_SCHED;
            PG8_STAGE(PG8_SB(1, 1), b3 + hstep, voffB);
            PG8_WAIT_V(6); PG8_BAR; PG8_MMA(1, 1, At, B1); PG8_BAR;
            }
        }
        if constexpr (ALIGN_EPI) { if (wr == 0) PG8_BAR; }
        if constexpr (FP8) asm volatile("s_nop 15\n\ts_nop 15" ::: "memory");
        if constexpr (!Epi::AFTER_DRAIN) { Unit ue_ = cur; int fr_ = fr, fq_ = fq; asm volatile("" : "+s"(ue_.pm), "+s"(ue_.po), "+v"(fr_), "+v"(fq_));
            E(acc, ue_, wr, wc, fr_, fq_); S.done(cur); }
        if (!has_next) break;
#pragma unroll
        for (int a = 0; a < 2; ++a)
#pragma unroll
            for (int b = 0; b < 2; ++b)
#pragma unroll
                for (int m = 0; m < 4; ++m)
#pragma unroll
                    for (int n = 0; n < 2; ++n) acc[a][b][m][n] = (f32x4){0.f, 0.f, 0.f, 0.f};
        cur = nxt; cA = nA; cB = nB; ++ui;
        if constexpr (ALIGN_EPI) { if (wr == 1) PG8_BAR; }
    }
    PG8_WAIT_V(0);
    if constexpr (!ALIGN_EPI) { if (wr == 0) PG8_BAR; }
    PG8_BAR;
    if constexpr (Epi::AFTER_DRAIN) { E.fused(acc, cur, wr, wc, fr, fq, lds, wid, lane); S.done(cur); }
#undef PG8_SA
#undef PG8_SB
#undef PG8_STAGE
#undef PG8_LDA
#undef PG8_LDB
#undef PG8_MMA
#undef PG8_HALF
#undef PG8_WAIT_V
#undef PG8_WAIT_L
#undef PG8_BAR
#undef PG8_SCHED
}
}
namespace pg8 {
__device__ __forceinline__ unsigned pk4_fp8(float a, float c, float d, float e) {
    a = fminf(fmaxf(a, -448.f), 448.f); c = fminf(fmaxf(c, -448.f), 448.f); d = fminf(fmaxf(d, -448.f), 448.f); e = fminf(fmaxf(e, -448.f), 448.f);
    int w = 0; w = __builtin_amdgcn_cvt_pk_fp8_f32(a, c, w, false); w = __builtin_amdgcn_cvt_pk_fp8_f32(d, e, w, true); return (unsigned)w;
}
struct EpiProjT {
    static constexpr bool PERM = false, AFTER_DRAIN = false;
    bf16_t* PAT;
    __device__ __forceinline__ void operator()(const f32x4 (&acc)[2][2][4][2], const Unit& u, int wr, int wc, int fr, int fq) const {
        const unsigned row0 = (unsigned)(u.pm * BM + wr * 64 + 4 * fq), col0 = (unsigned)(u.po * BM + wc * 32 + fr);
#pragma unroll
        for (int ai = 0; ai < 2; ++ai)
#pragma unroll
            for (int m = 0; m < 4; ++m) { const unsigned t0 = row0 + ai * HALF + m * 16;
#pragma unroll
                for (int bj = 0; bj < 2; ++bj)
#pragma unroll
                    for (int n = 0; n < 2; ++n) { const unsigned nc = col0 + bj * HALF + n * 16; const f32x4 v = acc[ai][bj][m][n];
                        typedef unsigned u32x2 __attribute__((ext_vector_type(2))); u32x2 w; w.x = cvt_pk_bf16(v[0], v[1]); w.y = cvt_pk_bf16(v[2], v[3]);
                        *(u32x2*)(PAT + (((t0 >> 5) * 1536u + nc) * 32u + (t0 & 31u))) = w; } }
    }
};
struct EpiProj {
    static constexpr bool PERM = true, AFTER_DRAIN = false;
    bf16_t* PAS; bf16_t* PB;
    __device__ __forceinline__ void operator()(const f32x4 (&acc)[2][2][4][2], const Unit& u, int wr, int wc, int fr, int fq) const {
        const int row0 = u.pm * BM + wr * 64 + fr;
        bf16_t* base; int ldc, colt;
        if (u.po < 1) { base = PAS; ldc = 256; colt = 0; } else { base = PB; ldc = 1536; colt = (u.po - 1) * BM; }
        const int col0 = colt + wc * 32 + 8 * fq;
#pragma unroll
        for (int ai = 0; ai < 2; ++ai)
#pragma unroll
            for (int m = 0; m < 4; ++m) { bf16_t* rowp = base + (size_t)(row0 + ai * HALF + m * 16) * ldc + col0;
#pragma unroll
                for (int bj = 0; bj < 2; ++bj) { const f32x4 v0 = acc[ai][bj][m][0], v1 = acc[ai][bj][m][1];
                    u32x4 w; w.x = cvt_pk_bf16(v0[0], v0[1]); w.y = cvt_pk_bf16(v0[2], v0[3]); w.z = cvt_pk_bf16(v1[0], v1[1]); w.w = cvt_pk_bf16(v1[2], v1[3]);
                    *(u32x4*)(rowp + bj * HALF) = w; } }
    }
};
struct EpiBf16Plain {
    static constexpr bool PERM = true, AFTER_DRAIN = false;
    bf16_t* O; int ldc;
    __device__ __forceinline__ void operator()(const f32x4 (&acc)[2][2][4][2], const Unit& u, int wr, int wc, int fr, int fq) const {
        const int row0 = u.pm * BM + wr * 64 + fr;
        const int col0 = u.po * BM + wc * 32 + 8 * fq;
#pragma unroll
        for (int ai = 0; ai < 2; ++ai)
#pragma unroll
            for (int m = 0; m < 4; ++m) { bf16_t* rowp = O + (size_t)(row0 + ai * HALF + m * 16) * ldc + col0;
#pragma unroll
                for (int bj = 0; bj < 2; ++bj) { const f32x4 v0 = acc[ai][bj][m][0], v1 = acc[ai][bj][m][1];
                    u32x4 w; w.x = cvt_pk_bf16(v0[0], v0[1]); w.y = cvt_pk_bf16(v0[2], v0[3]); w.z = cvt_pk_bf16(v1[0], v1[1]); w.w = cvt_pk_bf16(v1[2], v1[3]);
                    *(u32x4*)(rowp + bj * HALF) = w; } }
    }
};
template <bool F8> struct EpiSwiglu {
    static constexpr bool PERM = true, AFTER_DRAIN = false;
    unsigned char* H; int ldc; long rowoff;
    __device__ __forceinline__ void operator()(const f32x4 (&acc)[2][2][4][2], const Unit& u, int wr, int wc, int fr, int fq) const {
        const long row0 = (long)u.pm * BM + wr * 64 + fr + rowoff;
        const int col0 = u.po * HALF + wc * 32 + 8 * fq;
#pragma unroll
        for (int ai = 0; ai < 2; ++ai)
#pragma unroll
            for (int m = 0; m < 4; ++m) { unsigned char* rowp = H + ((size_t)(row0 + ai * HALF + m * 16) * ldc + col0) * (F8 ? 1 : 2);
                float o[8];
#pragma unroll
                for (int n = 0; n < 2; ++n)
#pragma unroll
                    for (int j = 0; j < 4; ++j) { const float g = acc[ai][0][m][n][j], up = acc[ai][1][m][n][j];
                        const float s = g * __builtin_amdgcn_rcpf(1.0f + __builtin_amdgcn_exp2f(-1.4426950408889634f * g)); o[n * 4 + j] = s * up; }
                if (F8) { typedef unsigned u32x2 __attribute__((ext_vector_type(2))); u32x2 w; w.x = pk4_fp8(o[0] * 8.f, o[1] * 8.f, o[2] * 8.f, o[3] * 8.f); w.y = pk4_fp8(o[4] * 8.f, o[5] * 8.f, o[6] * 8.f, o[7] * 8.f);
                    *(u32x2*)rowp = w; }
                else { u32x4 w; w.x = cvt_pk_bf16(o[0], o[1]); w.y = cvt_pk_bf16(o[2], o[3]); w.z = cvt_pk_bf16(o[4], o[5]); w.w = cvt_pk_bf16(o[6], o[7]); *(u32x4*)rowp = w; } }
    }
};
struct EpiMoeDown {
    static constexpr bool PERM = true, AFTER_DRAIN = false;
    bf16_t* O; int ldc; const float* gs;
    __device__ __forceinline__ void operator()(const f32x4 (&acc)[2][2][4][2], const Unit& u, int wr, int wc, int fr, int fq) const {
        const int row0 = u.pm * BM + wr * 64 + fr;
        const int col0 = u.po * BM + wc * 32 + 8 * fq;
#pragma unroll
        for (int ai = 0; ai < 2; ++ai)
#pragma unroll
            for (int m = 0; m < 4; ++m) { const int row = row0 + ai * HALF + m * 16; const float gt = gs[row]; bf16_t* rowp = O + (size_t)row * ldc + col0;
#pragma unroll
                for (int bj = 0; bj < 2; ++bj) { const f32x4 v0 = acc[ai][bj][m][0] * gt, v1 = acc[ai][bj][m][1] * gt;
                    u32x4 w; w.x = cvt_pk_bf16(v0[0], v0[1]); w.y = cvt_pk_bf16(v0[2], v0[3]); w.z = cvt_pk_bf16(v1[0], v1[1]); w.w = cvt_pk_bf16(v1[2], v1[3]);
                    *(u32x4*)(rowp + bj * HALF) = w; } }
    }
};
struct MoeOrder {
    int t0, nT, nN, nwg, G, c, nNe, arel;
    int ts1, ts2, ts3, ts4, ts5, ts6, ts7;
    __device__ bool next(int i, Unit& u) const {
        const long L = (long)i * G + c; if (L >= nwg) return false;
        int wgid = (int)L; { const int q = nwg / NXCD, r = nwg % NXCD, xcd = wgid % NXCD, off = wgid / NXCD; wgid = (xcd < r ? xcd * (q + 1) : r * (q + 1) + (xcd - r) * q) + off; }
        const int nig = WGM * nN, gid = wgid / nig, fm = gid * WGM, gsz = (nT - fm) < WGM ? (nT - fm) : WGM;
        const int pml = fm + ((wgid % nig) % gsz), pnl = (wgid % nig) / gsz;
        u.pm = t0 + pml; u.pa = arel ? pml : u.pm; u.po = pnl;
        const int e = (u.pm >= ts1) + (u.pm >= ts2) + (u.pm >= ts3) + (u.pm >= ts4) + (u.pm >= ts5) + (u.pm >= ts6) + (u.pm >= ts7);
        u.pn = e * nNe + pnl; return true;
    }
    __device__ __forceinline__ void a_ready(const Unit&) const {}
    __device__ __forceinline__ void done(const Unit&) const {}
};
}
constexpr int NWAVES = 8;
constexpr int NBATCH = 4, SEQ = 8192, M = NBATCH * SEQ, D = 1024, NH = 8, HD = 64;
constexpr int NA = 1792, NPB = 1536, NPROJ = NA + NPB, FF = 3584, NE = 8;
constexpr int MOE_PART_TILES = 128, MOE_PARTS = 3;
constexpr float NORM_EPS = 1e-6f, LNX_EPS = 64e-5f, DECAY_SCALE = 0.6065306597126334f;
constexpr float SB_EXIT = -104.0f;

constexpr size_t MiB = 1u << 20;
constexpr size_t WS_CTL = 0, CTL_ZERO_BYTES = 1 * MiB;
constexpr size_t WS_WIN0 = 1 * MiB, WS_WIN1 = 8 * MiB, WS_WOUT0 = 15 * MiB, WS_WOUT1 = 17 * MiB, WS_WGU0 = 19 * MiB, WS_WDN0 = 33 * MiB;
constexpr size_t WS_SEL = 40 * MiB, WS_GTS = WS_SEL + 128 * 1024, WS_POS = WS_GTS + 256 * 1024, WS_GSORT = WS_POS + 256 * 1024;
constexpr size_t WS_VF = 41 * MiB;
constexpr size_t WS_PA = 73 * MiB;
constexpr size_t WS_PAS = 169 * MiB;
constexpr size_t WS_YMIX = 73 * MiB;
constexpr size_t WS_PB = 185 * MiB;
constexpr size_t WS_Y = 185 * MiB;
constexpr size_t WS_F = 185 * MiB;
constexpr size_t WS_SCR = 281 * MiB;
constexpr size_t WS_ZH = WS_SCR, WS_RH = WS_SCR + 32 * MiB, WS_BF = WS_SCR + 64 * MiB, WS_U0F = WS_SCR + 96 * MiB, WS_YF = WS_SCR + 128 * MiB, WS_GTF = WS_SCR + 160 * MiB, WS_GF = WS_SCR + 192 * MiB, WS_PLF = WS_SCR + 256 * MiB;
constexpr size_t WS_HN = 281 * MiB;
constexpr size_t WS_HNF0 = 73 * MiB, WS_HNF1 = 41 * MiB;
constexpr size_t WS_H0 = 281 * MiB;
constexpr size_t WS_UPT = 14 * MiB + 512 * 1024;
constexpr size_t WS_BON = 40 * MiB;
constexpr size_t WS_WMGU = 105 * MiB, WS_WMDN = 161 * MiB, WS_HS = 189 * MiB, WS_FS = 255 * MiB, WS_HP = 387 * MiB, WS_END = 539 * MiB;
static_assert(WS_WIN0 + (size_t)NPROJ * D * 2 <= WS_WIN1 && WS_WIN1 + (size_t)NPROJ * D * 2 <= WS_UPT && WS_UPT + 2 * 8 * 12288 * 2 <= WS_WOUT0 && WS_WGU0 + (size_t)2 * FF * D * 2 <= WS_WDN0, "weights map");
static_assert(WS_GSORT + (size_t)(2 * M + 2048) * 4 <= 41 * MiB, "routing tables");
static_assert(WS_PA + (size_t)M * NA * 2 <= WS_PB && WS_PB + (size_t)M * NPB * 2 <= WS_SCR && WS_PLF + (size_t)8192 * 64 * 4 <= WS_END && WS_H0 + (size_t)M * FF * 2 <= WS_END, "act map");
static_assert(WS_WMGU + (size_t)NE * 2 * FF * D <= WS_WMDN && WS_WMDN + (size_t)NE * D * FF <= WS_HS && WS_HS + (size_t)(2 * M + 2048) * D <= WS_FS && WS_FS + (size_t)(2 * M + 2048) * D * 2 <= WS_HP && WS_HP + (size_t)MOE_PART_TILES * 256 * FF <= WS_END, "moe map");
constexpr int CW_BAR = 4096, CW_TOT = 16384, CW_CUR = 16384 + 1024;

constexpr int RING_BYTES = 131072, LDS_BYTES = 163840, MISC_OFF = LDS_BYTES - 512;

#define GAS __attribute__((address_space(1)))
#define LAS __attribute__((address_space(3)))
typedef unsigned short bf16;
typedef unsigned v4u __attribute__((ext_vector_type(4)));
typedef unsigned v2u __attribute__((ext_vector_type(2)));
typedef float f32x4 __attribute__((ext_vector_type(4)));
typedef float f32x16 __attribute__((ext_vector_type(16)));
typedef short bf16x8 __attribute__((ext_vector_type(8)));
typedef short s16x4 __attribute__((ext_vector_type(4)));
typedef float f32x2_t __attribute__((ext_vector_type(2)));
typedef __bf16 bf16x2_t __attribute__((ext_vector_type(2)));
#define RLX_AGENT __ATOMIC_RELAXED, __HIP_MEMORY_SCOPE_AGENT
#define LDS_WAIT() asm volatile("s_waitcnt lgkmcnt(0)" ::: "memory")
#define DI __device__ __forceinline__
#define MFMA32(a, b, c) __builtin_amdgcn_mfma_f32_32x32x16_bf16((a), (b), (c), 0, 0, 0)

DI unsigned cvtpk(float lo, float hi) { f32x2_t v = {lo, hi}; bf16x2_t b = __builtin_convertvector(v, bf16x2_t); return __builtin_bit_cast(unsigned, b); }
DI unsigned short f2bf(float f) { return (unsigned short)(cvtpk(f, 0.f) & 0xffffu); }
DI float bf2f(unsigned short u) { return __uint_as_float((unsigned)u << 16); }
DI float bflo(unsigned u) { return __uint_as_float(u << 16); }
DI float bfhi(unsigned u) { return __uint_as_float(u & 0xffff0000u); }
DI int lane_id() { int l; asm volatile("v_mbcnt_lo_u32_b32 %0, -1, 0\n\tv_mbcnt_hi_u32_b32 %0, -1, %0" : "=v"(l)); return l; }
DI float shx(float v, int o, int lane) { return __builtin_bit_cast(float, __builtin_amdgcn_ds_bpermute((lane ^ o) << 2, __builtin_bit_cast(int, v))); }
DI int shi(int v, int src) { return __builtin_amdgcn_ds_bpermute(src << 2, v); }
DI float wave_sum(float v, int lane) {
#pragma unroll
    for (int o = 1; o < 64; o <<= 1) v += shx(v, o, lane);
    return v;
}
DI float sigmoidf_(float x) { return __builtin_amdgcn_rcpf(1.0f + __expf(-x)); }
DI unsigned pk4_fp8(float a, float c, float d, float e) {
    a = fminf(fmaxf(a, -448.f), 448.f); c = fminf(fmaxf(c, -448.f), 448.f); d = fminf(fmaxf(d, -448.f), 448.f); e = fminf(fmaxf(e, -448.f), 448.f);
    int w = 0; w = __builtin_amdgcn_cvt_pk_fp8_f32(a, c, w, false); w = __builtin_amdgcn_cvt_pk_fp8_f32(d, e, w, true); return (unsigned)w;
}
constexpr float F8_HN = 16.f, F8_W = 64.f, F8_H = 8.f;
constexpr int E8_HN = 0x7B7B7B7B, E8_W = 0x79797979, E8_H = 0x7C7C7C7C;
DI int crow(int r, int hi) { return (r & 3) + 8 * (r >> 2) + 4 * hi; }

#define XB_TMO      128
#define XB_XCNT(j)  (256  + 64 * (j))
#define XB_XSUB(j)  (1280 + 64 * (j))
#define XB_XGEN(j)  (2304 + 64 * (j))
#define XB_TOP      3328
#define XB_TOPGEN   3392
#define XCD_BAR_WORDS 3456
#define XB_SPIN_CAP (1u << 22)
DI unsigned xb_ld(unsigned* p)              { return __hip_atomic_load(p, __ATOMIC_RELAXED, __HIP_MEMORY_SCOPE_AGENT); }
DI unsigned xb_add(unsigned* p, unsigned v) { return __hip_atomic_fetch_add(p, v, __ATOMIC_RELAXED, __HIP_MEMORY_SCOPE_AGENT); }
DI unsigned xb_xcc_id() { return (unsigned)__builtin_amdgcn_s_getreg((3 << 11) | 20) & 0xFu; }
#define XB_SPIN(cond, bar) do { unsigned _sp = 0; while (cond) { __builtin_amdgcn_s_sleep(1); \
    if ((++_sp & 255u) == 0u) { if (xb_ld(&(bar)[XB_TMO])) break; if (_sp > XB_SPIN_CAP) { atomicAdd(&(bar)[XB_TMO], 1u); break; } } } } while (0)
struct XcdBarrier { unsigned* bar; unsigned x; volatile LAS unsigned* st; };
DI XcdBarrier xcd_barrier_post(unsigned* bar, volatile LAS unsigned* st, int tid) {
    XcdBarrier b; b.bar = bar; b.x = xb_xcc_id(); b.st = st;
    if (tid == 0) (void)xb_add(&bar[XB_XCNT(b.x)], 1u);
    return b;
}
DI void xcd_barrier_complete(unsigned* bar, unsigned x, unsigned& nloc, unsigned& nx) {
    const unsigned G = gridDim.x * gridDim.y * gridDim.z;
    unsigned sum, cnt, mine, sp = 0u;
    for (;;) {
        sum = 0u; cnt = 0u; mine = 0u;
#pragma unroll
        for (unsigned j = 0; j < 16; ++j) { const unsigned c = xb_ld(&bar[XB_XCNT(j)]); sum += c; cnt += (c > 0u) ? 1u : 0u; mine = (j == x) ? c : mine; }
        if (sum == G) break;
        __builtin_amdgcn_s_sleep(1);
        if ((++sp & 255u) == 0u) { if (xb_ld(&bar[XB_TMO])) break; if (sp > XB_SPIN_CAP) { atomicAdd(&bar[XB_TMO], 1u); break; } }
    }
    nloc = mine > 0u ? mine : 1u; nx = cnt > 0u ? cnt : 1u;
}
DI void xcd_barrier(const XcdBarrier& b, int tid) {
    asm volatile("s_waitcnt vmcnt(0)" ::: "memory");
    __syncthreads();
    if (tid == 0) {
        unsigned* bar = b.bar; const unsigned bx = b.x;
        __builtin_amdgcn_s_waitcnt(0);
        unsigned nloc = b.st[0], nx = b.st[1];
        if (nloc == 0u) { xcd_barrier_complete(bar, bx, nloc, nx); b.st[0] = nloc; b.st[1] = nx; }
        const unsigned old = xb_add(&bar[XB_XSUB(bx)], 1u);
        const unsigned gen = old / nloc;
        if (old + 1u == (gen + 1u) * nloc) {
            __builtin_amdgcn_fence(__ATOMIC_RELEASE, "agent");
            asm volatile("s_waitcnt vmcnt(0)" ::: "memory");
            const unsigned og = xb_add(&bar[XB_TOP], 1u);
            const unsigned tg = og / nx;
            if (og + 1u == (tg + 1u) * nx) xb_add(&bar[XB_TOPGEN], 1u);
            else XB_SPIN(xb_ld(&bar[XB_TOPGEN]) == tg, bar);
            __builtin_amdgcn_fence(__ATOMIC_ACQUIRE, "agent");
            xb_add(&bar[XB_XGEN(bx)], 1u);
            asm volatile("s_waitcnt vmcnt(0)" ::: "memory");
        } else {
            XB_SPIN(xb_ld(&bar[XB_XGEN(bx)]) == gen, bar);
            __builtin_amdgcn_fence(__ATOMIC_ACQUIRE, "agent");
            asm volatile("s_waitcnt vmcnt(0)" ::: "memory");
        }
    }
    __syncthreads();
}

DI void transpose_item(const float* W, int N, int k0, int n0, bf16* WT, int Kt, int drow0, LAS float* scr, int lane) {
#pragma unroll 8
    for (int i = 0; i < 32; ++i) { const int kk = 2 * i + (lane >> 5); scr[kk * 33 + (lane & 31)] = W[(size_t)(k0 + kk) * N + n0 + (lane & 31)]; }
    LDS_WAIT(); asm volatile("" ::: "memory");
    const int c = lane & 7;
#pragma unroll
    for (int j = 0; j < 4; ++j) { const int n = (lane >> 3) + 8 * j; const LAS float* s = scr + (8 * c) * 33 + n;
        v4u o; o.x = cvtpk(s[0 * 33], s[1 * 33]); o.y = cvtpk(s[2 * 33], s[3 * 33]); o.z = cvtpk(s[4 * 33], s[5 * 33]); o.w = cvtpk(s[6 * 33], s[7 * 33]);
        *(GAS v4u*)(WT + (size_t)(drow0 + n) * Kt + k0 + 8 * c) = o; }
    LDS_WAIT(); asm volatile("" ::: "memory");
}
DI void transpose_item8(const float* W, int N, int k0, int n0, unsigned char* WT, int Kt, int drow0, LAS float* scr, int lane) {
#pragma unroll 8
    for (int i = 0; i < 32; ++i) { const int kk = 2 * i + (lane >> 5); scr[kk * 33 + (lane & 31)] = W[(size_t)(k0 + kk) * N + n0 + (lane & 31)]; }
    LDS_WAIT(); asm volatile("" ::: "memory");
    const int c = lane & 7;
#pragma unroll
    for (int j = 0; j < 4; ++j) { const int n = (lane >> 3) + 8 * j; const LAS float* s = scr + (8 * c) * 33 + n;
        v2u o; o.x = pk4_fp8(s[0 * 33] * F8_W, s[1 * 33] * F8_W, s[2 * 33] * F8_W, s[3 * 33] * F8_W); o.y = pk4_fp8(s[4 * 33] * F8_W, s[5 * 33] * F8_W, s[6 * 33] * F8_W, s[7 * 33] * F8_W);
        *(GAS v2u*)(WT + (size_t)(drow0 + n) * Kt + k0 + 8 * c) = o; }
    LDS_WAIT(); asm volatile("" ::: "memory");
}
template <int MODE>
DI void conv_matrix8(const float* W, int K, int N, unsigned char* WT, LAS float* scr, int gw, int NGW, int lane) {
    const int nblk = N / 32, nitems = (K / 64) * nblk;
    for (int it = gw; it < nitems; it += NGW) {
        const int kb = it / nblk, nb = it % nblk, n0 = nb * 32;
        int drow0;
        if (MODE == 0) drow0 = n0;
        else if (MODE == 2) drow0 = (n0 >> 7) * 256 + (n0 & 127);
        else drow0 = (n0 >> 7) * 256 + 128 + (n0 & 127);
        transpose_item8(W, N, kb * 64, n0, WT, K, drow0, scr, lane);
    }
}
template <int MODE>
DI void conv_matrix(const float* W, int K, int N, bf16* WT, int nrw, LAS float* scr, int gw, int NGW, int lane) {
    const int nblk = N / 32, nitems = (K / 64) * nblk;
    for (int it = gw; it < nitems; it += NGW) {
        const int kb = it / nblk, nb = it % nblk, n0 = nb * 32;
        int drow0;
        if (MODE == 0) drow0 = n0;
        else if (MODE == 1) drow0 = n0 < nrw ? n0 : NA + (n0 - nrw);
        else if (MODE == 2) drow0 = (n0 >> 7) * 256 + (n0 & 127);
        else drow0 = (n0 >> 7) * 256 + 128 + (n0 & 127);
        transpose_item(W, N, kb * 64, n0, WT, K, drow0, scr, lane);
    }
}
DI void zero_rows(bf16* WT, int Kt, int r0, int r1, int gw, int NGW, int lane) {
    const int per = Kt / 8;
    const long total = (long)(r1 - r0) * per;
    for (long i = (long)gw * 64 + lane; i < total; i += (long)NGW * 64) *(GAS v4u*)(WT + (size_t)r0 * Kt + i * 8) = (v4u){0u, 0u, 0u, 0u};
}

DI float dot4(f32x4 a) { return (a.x * a.x + a.y * a.y) + (a.z * a.z + a.w * a.w); }
DI f32x4 ld_bf16x4(const bf16* p) { const v2u u = *(const GAS v2u*)p; return (f32x4){bflo(u.x), bfhi(u.x), bflo(u.y), bfhi(u.y)}; }
DI void st_bf16x4(bf16* p, f32x4 v) { v2u u; u.x = cvtpk(v.x, v.y); u.y = cvtpk(v.z, v.w); *(GAS v2u*)p = u; }

DI void phase_norm0(const float* x, const float* g, bf16* hn, int gw, int NGW, int lane) {
    f32x4 gv[4];
#pragma unroll
    for (int j = 0; j < 4; ++j) gv[j] = *(const f32x4*)(g + 4 * lane + 256 * j);
    for (int m = gw; m < M; m += NGW) {
        f32x4 v[4]; float s = 0.f;
#pragma unroll
        for (int j = 0; j < 4; ++j) { v[j] = *(const GAS f32x4*)(x + (size_t)m * D + 4 * lane + 256 * j); s += dot4(v[j]); }
        const float rs = rsqrtf(wave_sum(s, lane) * (1.f / D) + NORM_EPS);
#pragma unroll
        for (int j = 0; j < 4; ++j) st_bf16x4(hn + (size_t)m * D + 4 * lane + 256 * j, v[j] * rs * gv[j]);
    }
}
template <bool MOEF, bool HN8>
DI void phase_resnorm(const float* xin, const bf16* y, const unsigned* pos, const float* g1, const float* g2, float* xout, bf16* hn,
                      const float* rt, unsigned* sel, float* gts, unsigned* totals, int gw, int NGW, int lane) {
    f32x4 g1v[4], g2v[4];
#pragma unroll
    for (int j = 0; j < 4; ++j) { g1v[j] = *(const f32x4*)(g1 + 4 * lane + 256 * j); g2v[j] = g2 ? *(const f32x4*)(g2 + 4 * lane + 256 * j) : (f32x4){0.f, 0.f, 0.f, 0.f}; }
    unsigned mycnt = 0;
    for (int m = gw; m < M; m += NGW) {
        f32x4 v[4], yv[4]; float s = 0.f;
        if (MOEF) {
            const unsigned p0 = __hip_atomic_load(pos + 2 * m, RLX_AGENT), p1 = __hip_atomic_load(pos + 2 * m + 1, RLX_AGENT);
#pragma unroll
            for (int j = 0; j < 4; ++j) yv[j] = ld_bf16x4(y + (size_t)p0 * D + 4 * lane + 256 * j) + ld_bf16x4(y + (size_t)p1 * D + 4 * lane + 256 * j);
        } else {
#pragma unroll
            for (int j = 0; j < 4; ++j) yv[j] = ld_bf16x4(y + (size_t)m * D + 4 * lane + 256 * j);
        }
#pragma unroll
        for (int j = 0; j < 4; ++j) { v[j] = *(const GAS f32x4*)(xin + (size_t)m * D + 4 * lane + 256 * j); s += dot4(yv[j]); }
        const float rsy = rsqrtf(wave_sum(s, lane) * (1.f / D) + NORM_EPS);
        float s2 = 0.f;
#pragma unroll
        for (int j = 0; j < 4; ++j) { v[j] = v[j] + yv[j] * rsy * g1v[j]; s2 += dot4(v[j]); *(GAS f32x4*)(xout + (size_t)m * D + 4 * lane + 256 * j) = v[j]; }
        if (g2) {
            const float rsx = rsqrtf(wave_sum(s2, lane) * (1.f / D) + NORM_EPS);
#pragma unroll
            for (int j = 0; j < 4; ++j) { v[j] = v[j] * rsx * g2v[j];
                if (HN8) *(GAS unsigned*)((unsigned char*)hn + (size_t)m * D + 4 * lane + 256 * j) = pk4_fp8(v[j].x * F8_HN, v[j].y * F8_HN, v[j].z * F8_HN, v[j].w * F8_HN);
                else st_bf16x4(hn + (size_t)m * D + 4 * lane + 256 * j, v[j]); }
            if (rt) {
                float pe[8];
#pragma unroll
                for (int e = 0; e < 8; ++e) pe[e] = 0.f;
#pragma unroll
                for (int j = 0; j < 4; ++j)
#pragma unroll
                    for (int i = 0; i < 4; ++i) { const float hv = v[j][i]; const float* rp = rt + (size_t)(4 * lane + 256 * j + i) * 8;
                        const f32x4 ra = *(const f32x4*)rp, rb = *(const f32x4*)(rp + 4);
                        pe[0] += hv * ra.x; pe[1] += hv * ra.y; pe[2] += hv * ra.z; pe[3] += hv * ra.w; pe[4] += hv * rb.x; pe[5] += hv * rb.y; pe[6] += hv * rb.z; pe[7] += hv * rb.w; }
                float v0 = -3.0e38f, v1 = -3.0e38f; int e0 = 0, e1 = 0;
#pragma unroll
                for (int e = 0; e < 8; ++e) { const float lg = wave_sum(pe[e], lane); if (lg > v0) { v1 = v0; e1 = e0; v0 = lg; e0 = e; } else if (lg > v1) { v1 = lg; e1 = e; } }
                const float ga = 1.0f / (1.0f + __expf(v1 - v0)), gb = 1.0f - ga;
                if (lane == 0) { sel[m] = (unsigned)e0 | ((unsigned)e1 << 8); gts[2 * m] = ga; gts[2 * m + 1] = gb; }
                if (lane == e0 || lane == e1) ++mycnt;
            }
        }
    }
    if (rt && lane < 8 && mycnt) __hip_atomic_fetch_add(totals + 64 * lane, mycnt, RLX_AGENT);
}

DI int moe_offsets(unsigned* totals, int lane, int& mytot) {
    int off = 0; mytot = 0;
#pragma unroll
    for (int e = 0; e < 8; ++e) { const int t = (int)__hip_atomic_load(totals + 64 * e, RLX_AGENT); if (e < lane) off += (t + 255) & ~255; if (e == lane) mytot = t; }
    return off;
}

DI void phase_moe_sort(const unsigned* sel, const float* gts, unsigned* totals, unsigned* cursor, unsigned* pos, float* gsort, const unsigned char* hn, unsigned char* hs, int gw, int NGW, int lane) {
    int mytot; const int myoff = moe_offsets(totals, lane, mytot);
    unsigned mycnt = 0;
    for (int m = gw; m < M; m += NGW) { const unsigned s = __hip_atomic_load(sel + m, RLX_AGENT); const int e0 = s & 255, e1 = (s >> 8) & 255; if (lane == e0 || lane == e1) ++mycnt; }
    unsigned mybase = 0;
    if (lane < 8 && mycnt) mybase = __hip_atomic_fetch_add(cursor + 64 * lane, mycnt, RLX_AGENT);
    unsigned mypos = (unsigned)myoff + mybase;
    for (int m = gw; m < M; m += NGW) {
        const unsigned s = __hip_atomic_load(sel + m, RLX_AGENT); const int e0 = s & 255, e1 = (s >> 8) & 255;
        const unsigned p0 = (unsigned)shi((int)mypos, e0), p1 = (unsigned)shi((int)mypos, e1);
        if (lane == e0 || lane == e1) ++mypos;
        if (lane == 0) { pos[2 * m] = p0; pos[2 * m + 1] = p1; gsort[p0] = __hip_atomic_load(gts + 2 * m, RLX_AGENT); gsort[p1] = __hip_atomic_load(gts + 2 * m + 1, RLX_AGENT); }
        const v4u a = *(const GAS v4u*)(hn + (size_t)m * D + 16 * lane);
        *(GAS v4u*)(hs + (size_t)p0 * D + 16 * lane) = a; *(GAS v4u*)(hs + (size_t)p1 * D + 16 * lane) = a;
    }
#pragma unroll 1
    for (int e = 0; e < 8; ++e) {
        const int r0 = shi(myoff + mytot, e), r1 = shi(myoff + ((mytot + 255) & ~255), e);
        for (int r = r0 + gw; r < r1; r += NGW) { *(GAS v4u*)(hs + (size_t)r * D + 16 * lane) = (v4u){0u, 0u, 0u, 0u}; if (lane == 0) gsort[r] = 0.f; }
    }
}
constexpr int SB_VP = 40;
DI void sb_wave(const bf16* PB, bf16* ymix, const float* sb_g, int b, int h, int q0, LAS unsigned char* vtb, int lane) {
    const int qi = lane & 31, hh = lane >> 5;
    LAS bf16* vt = (LAS bf16*)vtb;
    const size_t rowb = (size_t)b * SEQ;
    bf16x8 qf[4];
#pragma unroll
    for (int s = 0; s < 4; ++s) qf[s] = *(const GAS bf16x8*)(PB + (rowb + q0 + qi) * NPB + h * 64 + 16 * s + 8 * hh);
    f32x16 o0, o1;
#pragma unroll
    for (int r = 0; r < 16; ++r) { o0[r] = 0.f; o1[r] = 0.f; }
    float carry = 0.f;
    const int q = q0 + qi;
    bf16x8 kf[4], vv[4];
    {   const int kb = q0;
#pragma unroll
        for (int s = 0; s < 4; ++s) kf[s] = *(const GAS bf16x8*)(PB + (rowb + kb + qi) * NPB + 512 + h * 64 + 16 * s + 8 * hh);
#pragma unroll
        for (int i = 0; i < 4; ++i) vv[i] = *(const GAS bf16x8*)(PB + (rowb + kb + qi) * NPB + 1024 + h * 64 + 32 * hh + 8 * i); }
#pragma unroll 1
    for (int kt = q0 / 32; kt >= 0; --kt) {
        const int kb = kt * 32;
        bf16x8 nkf[4], nvv[4];
        {   const int nb = kt > 0 ? kb - 32 : kb;
#pragma unroll
            for (int s = 0; s < 4; ++s) nkf[s] = *(const GAS bf16x8*)(PB + (rowb + nb + qi) * NPB + 512 + h * 64 + 16 * s + 8 * hh);
#pragma unroll
            for (int i = 0; i < 4; ++i) nvv[i] = *(const GAS bf16x8*)(PB + (rowb + nb + qi) * NPB + 1024 + h * 64 + 32 * hh + 8 * i); }
#pragma unroll
        for (int i = 0; i < 4; ++i)
#pragma unroll
            for (int e = 0; e < 8; ++e) vt[(32 * hh + 8 * i + e) * SB_VP + qi] = (bf16)vv[i][e];
        f32x16 sc;
#pragma unroll
        for (int r = 0; r < 16; ++r) sc[r] = 0.f;
#pragma unroll
        for (int s = 0; s < 4; ++s) sc = MFMA32(kf[s], qf[s], sc);
        float c[16], ls[16];
        const bool diag = (kb == q0);
#pragma unroll
        for (int r = 0; r < 16; ++r) {
            const float z = sc[r] * 0.125f;
            const float sp = fmaxf(z, 0.f) + __logf(1.0f + __expf(-fabsf(z)));
            const bool valid = !diag || (kb + crow(r, hh) < q);
            c[r] = valid ? -sp : 0.f;
            ls[r] = valid ? z - sp : -1.0e30f;
        }
        float G[4], PG[4];
#pragma unroll
        for (int g = 0; g < 4; ++g) { G[g] = (c[4 * g] + c[4 * g + 1]) + (c[4 * g + 2] + c[4 * g + 3]); PG[g] = shx(G[g], 32, lane); }
        float att[16];
        float after = carry;
#pragma unroll
        for (int g = 3; g >= 0; --g) {
            float sfx = after + (hh == 0 ? PG[g] : 0.f);
#pragma unroll
            for (int i = 3; i >= 0; --i) { att[4 * g + i] = __expf(ls[4 * g + i] + sfx); sfx += c[4 * g + i]; }
            after += G[g] + PG[g];
        }
        carry = after;
        bf16x8 pf[2];
#pragma unroll
        for (int s = 0; s < 2; ++s) { v4u p; p.x = cvtpk(att[8 * s], att[8 * s + 1]); p.y = cvtpk(att[8 * s + 2], att[8 * s + 3]); p.z = cvtpk(att[8 * s + 4], att[8 * s + 5]); p.w = cvtpk(att[8 * s + 6], att[8 * s + 7]); pf[s] = __builtin_bit_cast(bf16x8, p); }
        LDS_WAIT();
#pragma unroll
        for (int s = 0; s < 2; ++s) {
            const s16x4 a0 = *(const LAS s16x4*)(vt + qi * SB_VP + 16 * s + 4 * hh), a1 = *(const LAS s16x4*)(vt + qi * SB_VP + 16 * s + 8 + 4 * hh);
            const s16x4 b0 = *(const LAS s16x4*)(vt + (32 + qi) * SB_VP + 16 * s + 4 * hh), b1 = *(const LAS s16x4*)(vt + (32 + qi) * SB_VP + 16 * s + 8 + 4 * hh);
            const bf16x8 va = __builtin_shufflevector(a0, a1, 0, 1, 2, 3, 4, 5, 6, 7), vb = __builtin_shufflevector(b0, b1, 0, 1, 2, 3, 4, 5, 6, 7);
            o0 = MFMA32(va, pf[s], o0);
            o1 = MFMA32(vb, pf[s], o1);
        }
        LDS_WAIT();
        if (__all(carry < SB_EXIT)) break;
#pragma unroll
        for (int s = 0; s < 4; ++s) { kf[s] = nkf[s]; vv[s] = nvv[s]; }
    }
    float ss = 0.f;
#pragma unroll
    for (int r = 0; r < 16; ++r) ss += o0[r] * o0[r] + o1[r] * o1[r];
    ss += shx(ss, 32, lane);
    const float scl = rsqrtf(ss * (1.f / 64.f) + NORM_EPS);
    bf16* orow = ymix + (rowb + q) * D + 512 + h * 64;
#pragma unroll
    for (int g = 0; g < 4; ++g) {
        const int d0 = 8 * g + 4 * hh;
        const f32x4 g0 = *(const f32x4*)(sb_g + h * 64 + d0), g1 = *(const f32x4*)(sb_g + h * 64 + 32 + d0);
        v2u w0, w1;
        w0.x = cvtpk(o0[4 * g] * scl * g0.x, o0[4 * g + 1] * scl * g0.y); w0.y = cvtpk(o0[4 * g + 2] * scl * g0.z, o0[4 * g + 3] * scl * g0.w);
        w1.x = cvtpk(o1[4 * g] * scl * g1.x, o1[4 * g + 1] * scl * g1.y); w1.y = cvtpk(o1[4 * g + 2] * scl * g1.z, o1[4 * g + 3] * scl * g1.w);
        *(GAS v2u*)(orow + d0) = w0; *(GAS v2u*)(orow + 32 + d0) = w1;
    }
}
constexpr int RW_L = 32, RW_NCH = SEQ / RW_L;
constexpr size_t RW_UNITS = (size_t)NBATCH * NH * RW_NCH;
struct RwkvC {
    const bf16* PAT; const bf16* PAS; const float* mu; const float *decay0, *iclr0, *vres0, *k_k, *k_a, *r_k, *lnx_g, *lnx_b;
    const bf16* upT;
    unsigned* VFf;
    bf16* ZH; bf16* RH;
    unsigned* BF;
    unsigned* U0F; unsigned* YF;
    unsigned* GTF;
    unsigned* GF;
    float* PLF;
    float* BON;
    bf16* ymix;
    int has_vres;
};
DI bf16x8 pk8(const f32x16& x, int s) { v4u p; p.x = cvtpk(x[8 * s], x[8 * s + 1]); p.y = cvtpk(x[8 * s + 2], x[8 * s + 3]); p.z = cvtpk(x[8 * s + 4], x[8 * s + 5]); p.w = cvtpk(x[8 * s + 6], x[8 * s + 7]); return __builtin_bit_cast(bf16x8, p); }
DI void st_frag(unsigned* p, const f32x16& x) {
    v4u a, b; a.x = cvtpk(x[0], x[1]); a.y = cvtpk(x[2], x[3]); a.z = cvtpk(x[4], x[5]); a.w = cvtpk(x[6], x[7]);
    b.x = cvtpk(x[8], x[9]); b.y = cvtpk(x[10], x[11]); b.z = cvtpk(x[12], x[13]); b.w = cvtpk(x[14], x[15]);
    *(GAS v4u*)p = a; *(GAS v4u*)(p + 4) = b;
}
DI f32x16 ld_frag(const unsigned* p) {
    const v4u a = *(const GAS v4u*)p, b = *(const GAS v4u*)(p + 4); f32x16 x;
    x[0] = bflo(a.x); x[1] = bfhi(a.x); x[2] = bflo(a.y); x[3] = bfhi(a.y); x[4] = bflo(a.z); x[5] = bfhi(a.z); x[6] = bflo(a.w); x[7] = bfhi(a.w);
    x[8] = bflo(b.x); x[9] = bfhi(b.x); x[10] = bflo(b.y); x[11] = bfhi(b.y); x[12] = bflo(b.z); x[13] = bfhi(b.z); x[14] = bflo(b.w); x[15] = bfhi(b.w);
    return x;
}
DI f32x16 zero16() { f32x16 z;
#pragma unroll
    for (int i = 0; i < 16; ++i) z[i] = 0.f;
    return z; }
DI float half_sum(float v, int lane) {
#pragma unroll
    for (int o = 1; o < 32; o <<= 1) v += shx(v, o, lane);
    return v;
}
constexpr int RW_SP = 72;
DI void stage_n(LAS bf16* img, const f32x16& x0, const f32x16& x1, int cl, int hi) {
#pragma unroll
    for (int r = 0; r < 16; ++r) { img[crow(r, hi) * RW_SP + cl] = f2bf(x0[r]); img[crow(r, hi) * RW_SP + 32 + cl] = f2bf(x1[r]); }
}
DI bf16x8 frag_nat(const LAS bf16* img, int pitch, int row, int S, int hh) { return *(const LAS bf16x8*)(img + row * pitch + 16 * S + 8 * hh); }
DI bf16x8 frag_perm(const LAS bf16* img, int pitch, int row, int S, int hh) {
    const s16x4 a = *(const LAS s16x4*)(img + row * pitch + 16 * S + 4 * hh), b = *(const LAS s16x4*)(img + row * pitch + 16 * S + 8 + 4 * hh);
    return __builtin_shufflevector(a, b, 0, 1, 2, 3, 4, 5, 6, 7);
}

DI void ld_col(const bf16* PAT, unsigned cg, unsigned n, int hi, bool first_chunk, f32x16& cur, f32x16& prv) {
    const unsigned base = ((cg * 1536u + n) << 5) + 4u * (unsigned)hi;
    const unsigned pbase = (((cg - 1u) * 1536u + n) << 5) + 31u;
#pragma unroll
    for (int g = 0; g < 4; ++g) {
        const v2u w = *(const GAS v2u*)(PAT + base + 8 * g);
        cur[4 * g] = bflo(w.x); cur[4 * g + 1] = bfhi(w.x); cur[4 * g + 2] = bflo(w.y); cur[4 * g + 3] = bfhi(w.y);
        float p0;
        if (g == 0) { const bool wrap = (hi == 0); const unsigned off = wrap ? (first_chunk ? base : pbase) : base - 1u; const float pv = bf2f(*(const GAS bf16*)(PAT + off)); p0 = (wrap && first_chunk) ? 0.f : pv; }
        else p0 = bf2f(*(const GAS bf16*)(PAT + base + 8 * g - 1));
        prv[4 * g] = p0; prv[4 * g + 1] = cur[4 * g]; prv[4 * g + 2] = cur[4 * g + 1]; prv[4 * g + 3] = cur[4 * g + 2];
    }
}
constexpr int RW_WAVE_LDS = 19456;
DI unsigned pk2f(float a, float b) { return cvtpk(a, b); }
DI bf16x8 pkq(const unsigned (&p)[8], int s) { v4u q; q.x = p[4 * s]; q.y = p[4 * s + 1]; q.z = p[4 * s + 2]; q.w = p[4 * s + 3]; return __builtin_bit_cast(bf16x8, q); }
DI void rwkv_pre_unit(const RwkvC& P, int b, int h, int ch, LAS unsigned char* lw_, int lane) {
    const int cl = lane & 31, hi = lane >> 5;
    const unsigned unit = (unsigned)((b * NH + h) * RW_NCH + ch);
    const unsigned row0 = (unsigned)(b * SEQ + ch * RW_L);
    const unsigned cg = (unsigned)(b * RW_NCH + ch);
    LAS bf16* Ri = (LAS bf16*)lw_; LAS bf16* Bi = (LAS bf16*)(lw_ + 4608); LAS bf16* Ki = (LAS bf16*)(lw_ + 9216); LAS bf16* Zi = (LAS bf16*)(lw_ + 13824);
    LAS float* Af = (LAS float*)lw_;
    LAS bf16* Tn = (LAS bf16*)lw_; LAS bf16* Tt = (LAS bf16*)(lw_ + 2048);
    LAS bf16* BmL = (LAS bf16*)(lw_ + 4096); LAS bf16* AbL = (LAS bf16*)(lw_ + 6144); LAS bf16* AkL = (LAS bf16*)(lw_ + 8192);
    const bf16* upT = P.upT + (size_t)h * 12288;
    const unsigned rowt = row0 + cl; const bool first_tok = (ch == 0 && cl == 0);
    bf16x8 smw[2], sma[2], smv[2];
    {
        bf16x8 smg[6];
        const bf16* pr = P.PAS + rowt * 256 + 8 * hi; const bf16* pp = pr - 256;
        v4u cu[12], pv[12];
#pragma unroll
        for (int s = 0; s < 12; ++s) { cu[s] = (v4u){0u, 0u, 0u, 0u}; pv[s] = (v4u){0u, 0u, 0u, 0u}; }
#pragma unroll
        for (int s = 0; s < 12; ++s) if (s < 10 || P.has_vres) { cu[s] = *(const GAS v4u*)(pr + 16 * s); if (!first_tok) pv[s] = *(const GAS v4u*)(pp + 16 * s); }
#pragma unroll
        for (int s = 0; s < 12; ++s) {
            f32x4 m0 = (f32x4){0.f, 0.f, 0.f, 0.f}, m1 = m0;
            if (s < 10 || P.has_vres) { m0 = *(const f32x4*)(P.mu + 1536 + 16 * s + 8 * hi); m1 = *(const f32x4*)(P.mu + 1536 + 16 * s + 8 * hi + 4); }
            float xs[8];
            xs[0] = bflo(cu[s].x) + m0.x * (bflo(pv[s].x) - bflo(cu[s].x)); xs[1] = bfhi(cu[s].x) + m0.y * (bfhi(pv[s].x) - bfhi(cu[s].x));
            xs[2] = bflo(cu[s].y) + m0.z * (bflo(pv[s].y) - bflo(cu[s].y)); xs[3] = bfhi(cu[s].y) + m0.w * (bfhi(pv[s].y) - bfhi(cu[s].y));
            xs[4] = bflo(cu[s].z) + m1.x * (bflo(pv[s].z) - bflo(cu[s].z)); xs[5] = bfhi(cu[s].z) + m1.y * (bfhi(pv[s].z) - bfhi(cu[s].z));
            xs[6] = bflo(cu[s].w) + m1.z * (bflo(pv[s].w) - bflo(cu[s].w)); xs[7] = bfhi(cu[s].w) + m1.w * (bfhi(pv[s].w) - bfhi(cu[s].w));
            if (s < 2) {
#pragma unroll
                for (int j = 0; j < 8; ++j) { const float e = __expf(2.0f * xs[j]); xs[j] = 1.0f - 2.0f * __builtin_amdgcn_rcpf(e + 1.0f); }
            } else if (s >= 4 && s < 10) {
#pragma unroll
                for (int j = 0; j < 8; ++j) xs[j] = sigmoidf_(xs[j]);
            }
            v4u p; p.x = cvtpk(xs[0], xs[1]); p.y = cvtpk(xs[2], xs[3]); p.z = cvtpk(xs[4], xs[5]); p.w = cvtpk(xs[6], xs[7]);
            const bf16x8 f = __builtin_bit_cast(bf16x8, p);
            if (s < 2) smw[s] = f; else if (s < 4) sma[s - 2] = f; else if (s < 10) smg[s - 4] = f; else smv[s - 10] = f;
        }
#pragma unroll
        for (int ct = 0; ct < 2; ++ct) {
            f32x16 g = zero16();
#pragma unroll
            for (int s = 0; s < 6; ++s) { const bf16x8 wg = *(const GAS bf16x8*)(upT + 6144 + (32 * ct + cl) * 96 + 16 * s + 8 * hi); g = MFMA32(smg[s], wg, g); }
            st_frag(P.GTF + ((unit * 2 + ct) * 64 + lane) * 8, g);
        }
    }
    float rn[16];
    {
        float nn[16];
#pragma unroll
        for (int r = 0; r < 16; ++r) nn[r] = 0.f;
#pragma unroll
        for (int ct = 0; ct < 2; ++ct) {
            const int hc = h * 64 + 32 * ct + cl; const float mk = P.mu[512 + hc], kkc = P.k_k[hc];
            f32x16 kc, kp; ld_col(P.PAT, cg, 512u + (unsigned)hc, hi, ch == 0, kc, kp);
#pragma unroll
            for (int r = 0; r < 16; ++r) { const float kq = (kc[r] + mk * (kp[r] - kc[r])) * kkc; nn[r] += kq * kq; }
        }
#pragma unroll
        for (int r = 0; r < 16; ++r) rn[r] = rsqrtf(fmaxf(half_sum(nn[r], lane), 1e-12f));
    }
    unsigned Khp0[8];
    float bon[16];
#pragma unroll
    for (int r = 0; r < 16; ++r) bon[r] = 0.f;
#pragma unroll
    for (int ct = 0; ct < 2; ++ct) {
        const int hc = h * 64 + 32 * ct + cl;
        f32x16 lwv, av;
        {
            f32x16 d = zero16(), ic = zero16();
#pragma unroll
            for (int s = 0; s < 2; ++s) {
                const bf16x8 wd = *(const GAS bf16x8*)(upT + (32 * ct + cl) * 32 + 16 * s + 8 * hi);
                const bf16x8 wi = *(const GAS bf16x8*)(upT + 2048 + (32 * ct + cl) * 32 + 16 * s + 8 * hi);
                d = MFMA32(smw[s], wd, d); ic = MFMA32(sma[s], wi, ic);
            }
            const float d0 = P.decay0[hc], i0 = P.iclr0[hc];
#pragma unroll
            for (int r = 0; r < 16; ++r) { lwv[r] = -DECAY_SCALE * sigmoidf_(d[r] + d0); av[r] = sigmoidf_(ic[r] + i0); }
        }
        f32x16 cum; float cumL;
        {
            float Gs[4], PGs[4];
#pragma unroll
            for (int g = 0; g < 4; ++g) { Gs[g] = (lwv[4 * g] + lwv[4 * g + 1]) + (lwv[4 * g + 2] + lwv[4 * g + 3]); PGs[g] = shx(Gs[g], 32, lane); }
            float before = 0.f;
#pragma unroll
            for (int g = 0; g < 4; ++g) {
                float run = before + (hi ? PGs[g] : 0.f);
#pragma unroll
                for (int i = 0; i < 4; ++i) { run += lwv[4 * g + i]; cum[4 * g + i] = run; }
                before += Gs[g] + PGs[g];
            }
            cumL = before;
        }
        if (hi == ct) P.PLF[unit * 64 + 32 * ct + cl] = __expf(cumL);
        f32x16 rv, kv, vv;
        {
            const float mr = P.mu[hc], mk = P.mu[512 + hc], mv = P.mu[1024 + hc];
            f32x16 c0, p0, c1, p1, c2, p2;
            ld_col(P.PAT, cg, (unsigned)hc, hi, ch == 0, c0, p0); ld_col(P.PAT, cg, 512u + (unsigned)hc, hi, ch == 0, c1, p1); ld_col(P.PAT, cg, 1024u + (unsigned)hc, hi, ch == 0, c2, p2);
#pragma unroll
            for (int r = 0; r < 16; ++r) { rv[r] = c0[r] + mr * (p0[r] - c0[r]); kv[r] = c1[r] + mk * (p1[r] - c1[r]); vv[r] = c2[r] + mv * (p2[r] - c2[r]); }
        }
        if (P.has_vres) {
            f32x16 vp = zero16();
#pragma unroll
            for (int s = 0; s < 2; ++s) { const bf16x8 wv = *(const GAS bf16x8*)(upT + 4096 + (32 * ct + cl) * 32 + 16 * s + 8 * hi); vp = MFMA32(smv[s], wv, vp); }
            const float v0 = P.vres0[hc];
            const f32x16 vf = ld_frag(P.VFf + ((unit * 2 + ct) * 64 + lane) * 8);
#pragma unroll
            for (int r = 0; r < 16; ++r) vv[r] = vv[r] + (vf[r] - vv[r]) * sigmoidf_(vp[r] + v0);
        }
        st_frag(P.VFf + ((unit * 2 + ct) * 64 + lane) * 8, vv);
        const float kkc = P.k_k[hc], kac = P.k_a[hc], rkc = P.r_k[hc];
        f32x16 Bh;
#pragma unroll
        for (int r = 0; r < 16; ++r) {
            const int t = crow(r, hi);
            const float kk = kv[r] * kkc * rn[r];
            const float km = kv[r] * (1.0f + (av[r] - 1.0f) * kac);
            bon[r] += rv[r] * km * rkc;
            const float c = cum[r], e1 = __expf(c), e2 = __expf(c - lwv[r]), e3 = __expf(-c), e4 = __expf(cumL - c);
            const float bb = kk * av[r];
            const float zt = -kk * e2;
            Zi[t * RW_SP + 32 * ct + cl] = f2bf(zt); Ri[t * RW_SP + 32 * ct + cl] = f2bf(rv[r] * e1); Bi[t * RW_SP + 32 * ct + cl] = f2bf(bb * e3); Ki[t * RW_SP + 32 * ct + cl] = f2bf(km * e3);
            Bh[r] = bb * e4;
            kv[r] = km * e4;
        }
        st_frag(P.BF + ((unit * 2 + ct) * 64 + lane) * 8, Bh);
        unsigned Khc[8], vvc[8];
#pragma unroll
        for (int q = 0; q < 8; ++q) { Khc[q] = pk2f(kv[2 * q], kv[2 * q + 1]); vvc[q] = pk2f(vv[2 * q], vv[2 * q + 1]); }
        if (ct == 0) {
#pragma unroll
            for (int q = 0; q < 8; ++q) Khp0[q] = Khc[q];
            f32x16 g = zero16();
            g = MFMA32(pkq(Khc, 0), pkq(vvc, 0), g); g = MFMA32(pkq(Khc, 1), pkq(vvc, 1), g);
            st_frag(P.GF + (((unit * 2 + 0) * 2 + 0) * 64 + lane) * 8, g);
        } else {
            unsigned vv0[8];
            { const v4u a = *(const GAS v4u*)(P.VFf + ((unit * 2 + 0) * 64 + lane) * 8), b2 = *(const GAS v4u*)(P.VFf + ((unit * 2 + 0) * 64 + lane) * 8 + 4);
              vv0[0] = a.x; vv0[1] = a.y; vv0[2] = a.z; vv0[3] = a.w; vv0[4] = b2.x; vv0[5] = b2.y; vv0[6] = b2.z; vv0[7] = b2.w; }
            f32x16 g01 = zero16(), g10 = zero16(), g11 = zero16();
#pragma unroll
            for (int s2 = 0; s2 < 2; ++s2) { g01 = MFMA32(pkq(Khp0, s2), pkq(vvc, s2), g01); g10 = MFMA32(pkq(Khc, s2), pkq(vv0, s2), g10); g11 = MFMA32(pkq(Khc, s2), pkq(vvc, s2), g11); }
            st_frag(P.GF + (((unit * 2 + 0) * 2 + 1) * 64 + lane) * 8, g01);
            st_frag(P.GF + (((unit * 2 + 1) * 2 + 0) * 64 + lane) * 8, g10);
            st_frag(P.GF + (((unit * 2 + 1) * 2 + 1) * 64 + lane) * 8, g11);
        }
        asm volatile("" ::: "memory"); __builtin_amdgcn_sched_barrier(0);
    }
#pragma unroll
    for (int r = 0; r < 16; ++r) { const float bo = half_sum(bon[r], lane); if (cl == 0) P.BON[(row0 + crow(r, hi)) * 8 + h] = bo; }
    LDS_WAIT();
    bf16x8 zf[4], rf[4], bfr[4], kf[4];
    unsigned rtT[16];
#pragma unroll
    for (int S = 0; S < 4; ++S) { zf[S] = frag_nat(Zi, RW_SP, cl, S, hi); rf[S] = frag_nat(Ri, RW_SP, cl, S, hi); bfr[S] = frag_nat(Bi, RW_SP, cl, S, hi); kf[S] = frag_nat(Ki, RW_SP, cl, S, hi); }
#pragma unroll
    for (int ct = 0; ct < 2; ++ct)
#pragma unroll
        for (int g = 0; g < 4; ++g) { const v2u w = *(const LAS v2u*)(Ri + cl * RW_SP + 32 * ct + 8 * g + 4 * hi); rtT[ct * 8 + g * 2] = w.x; rtT[ct * 8 + g * 2 + 1] = w.y; }
    LDS_WAIT();
    {
        f32x16 Aa = zero16(), Bm = zero16(), Ab = zero16(), Ak = zero16();
#pragma unroll
        for (int S = 0; S < 4; ++S) { Aa = MFMA32(zf[S], bfr[S], Aa); Bm = MFMA32(zf[S], kf[S], Bm); Ab = MFMA32(rf[S], bfr[S], Ab); Ak = MFMA32(rf[S], kf[S], Ak); }
#pragma unroll
        for (int r = 0; r < 16; ++r) {
            const int t = crow(r, hi); const bool lo = cl < t, le = cl <= t;
            Af[t * 32 + cl] = lo ? Aa[r] : 0.f;
            BmL[t * 32 + cl] = f2bf(lo ? Bm[r] : 0.f); AbL[t * 32 + cl] = f2bf(le ? Ab[r] : 0.f); AkL[t * 32 + cl] = f2bf(le ? Ak[r] : 0.f);
        }
    }
    LDS_WAIT();
    {
        float tc[32];
#pragma unroll
        for (int t = 0; t < 32; ++t) {
            float acc = (t == cl) ? 1.0f : 0.f;
#pragma unroll
            for (int s4 = 0; s4 < t; s4 += 4) {
                const f32x4 a4 = *(const LAS f32x4*)(Af + t * 32 + s4);
                acc += a4.x * tc[s4];
                if (s4 + 1 < t) acc += a4.y * tc[s4 + 1];
                if (s4 + 2 < t) acc += a4.z * tc[s4 + 2];
                if (s4 + 3 < t) acc += a4.w * tc[s4 + 3];
            }
            asm volatile("" : "+v"(acc) :: "memory");
            tc[t] = acc;
        }
        LDS_WAIT();
#pragma unroll
        for (int t = 0; t < 32; ++t) if (hi == 0) Tn[t * 32 + cl] = f2bf(tc[t]);
        if (hi == 0) {
#pragma unroll
            for (int q = 0; q < 4; ++q) { v4u p; p.x = cvtpk(tc[8 * q], tc[8 * q + 1]); p.y = cvtpk(tc[8 * q + 2], tc[8 * q + 3]); p.z = cvtpk(tc[8 * q + 4], tc[8 * q + 5]); p.w = cvtpk(tc[8 * q + 6], tc[8 * q + 7]); *(LAS v4u*)(Tt + cl * 32 + 8 * q) = p; }
        }
    }
    LDS_WAIT();
    bf16x8 tp[2];
    {
        bf16x8 bmp[2], abp[2], akp[2];
#pragma unroll
        for (int s = 0; s < 2; ++s) { bmp[s] = frag_perm(BmL, 32, cl, s, hi); tp[s] = frag_perm(Tn, 32, cl, s, hi); abp[s] = frag_perm(AbL, 32, cl, s, hi); akp[s] = frag_perm(AkL, 32, cl, s, hi); }
#pragma unroll
        for (int vt = 0; vt < 2; ++vt) {
            unsigned vvq[8];
            { const v4u a = *(const GAS v4u*)(P.VFf + ((unit * 2 + vt) * 64 + lane) * 8), b2 = *(const GAS v4u*)(P.VFf + ((unit * 2 + vt) * 64 + lane) * 8 + 4);
              vvq[0] = a.x; vvq[1] = a.y; vvq[2] = a.z; vvq[3] = a.w; vvq[4] = b2.x; vvq[5] = b2.y; vvq[6] = b2.z; vvq[7] = b2.w; }
            f32x16 w0 = zero16(), u0 = zero16(), y0 = zero16();
#pragma unroll
            for (int s = 0; s < 2; ++s) w0 = MFMA32(bmp[s], pkq(vvq, s), w0);
#pragma unroll
            for (int s = 0; s < 2; ++s) u0 = MFMA32(tp[s], pk8(w0, s), u0);
#pragma unroll
            for (int s = 0; s < 2; ++s) { y0 = MFMA32(abp[s], pk8(u0, s), y0); y0 = MFMA32(akp[s], pkq(vvq, s), y0); }
            st_frag(P.U0F + ((unit * 2 + vt) * 64 + lane) * 8, u0);
            st_frag(P.YF + ((unit * 2 + vt) * 64 + lane) * 8, y0);
        }
    }
    f32x16 qT = zero16();
#pragma unroll
    for (int s = 0; s < 2; ++s) qT = MFMA32(frag_nat(Tt, 32, cl, s, hi), frag_nat(AbL, 32, cl, s, hi), qT);
    const bf16x8 qp0 = pk8(qT, 0), qp1 = pk8(qT, 1);
#pragma unroll
    for (int ct = 0; ct < 2; ++ct) {
        f32x16 zh = zero16(), rh;
#pragma unroll
        for (int r = 0; r < 16; ++r) { const unsigned w = rtT[ct * 8 + (r >> 1)]; rh[r] = (r & 1) ? bfhi(w) : bflo(w); }
        unsigned zq[8];
#pragma unroll
        for (int q = 0; q < 8; ++q) { const unsigned lo_ = Zi[crow(2 * q, hi) * RW_SP + 32 * ct + cl], hi_ = Zi[crow(2 * q + 1, hi) * RW_SP + 32 * ct + cl]; zq[q] = lo_ | (hi_ << 16); }
        zh = MFMA32(pkq(zq, 0), tp[0], zh); zh = MFMA32(pkq(zq, 1), tp[1], zh);
        rh = MFMA32(pkq(zq, 0), qp0, rh); rh = MFMA32(pkq(zq, 1), qp1, rh);
        bf16* zrow = P.ZH + (unit * 32 + cl) * 64; bf16* rrow = P.RH + (unit * 32 + cl) * 64;
#pragma unroll
        for (int g = 0; g < 4; ++g) {
            const int pos = 16 * (2 * ct + (g >> 1)) + 8 * hi + 4 * (g & 1);
            v2u a, c2; a.x = cvtpk(zh[4 * g], zh[4 * g + 1]); a.y = cvtpk(zh[4 * g + 2], zh[4 * g + 3]); c2.x = cvtpk(rh[4 * g], rh[4 * g + 1]); c2.y = cvtpk(rh[4 * g + 2], rh[4 * g + 3]);
            *(GAS v2u*)(zrow + pos) = a; *(GAS v2u*)(rrow + pos) = c2;
        }
    }
    LDS_WAIT();
}

constexpr int SC_SLOTS = 5, SC_LOADERS = 7, SC_PIECES = 28, SC_SLOT_BYTES = SC_PIECES * 1024, SC_FLAGS = SC_SLOTS * SC_SLOT_BYTES;
DI void rwkv_scan_wg(const RwkvC& P, int b, int h, int vt, LAS unsigned char* lds, int wave, int lane) {
    const int cl = lane & 31, hi = lane >> 5; (void)cl;
    volatile LAS unsigned* flg = (volatile LAS unsigned*)(lds + SC_FLAGS);
    if (wave == 0 && lane < 8) flg[lane] = 0u;
    __syncthreads();
    const unsigned unit0 = (unsigned)((b * NH + h) * RW_NCH);
    if (wave >= 1 && wave <= SC_LOADERS) {
#pragma unroll 1
        for (int ch = wave - 1; ch < RW_NCH; ch += SC_LOADERS) {
            LAS unsigned char* slot = lds + (ch % SC_SLOTS) * SC_SLOT_BYTES + lane * 16;
            const unsigned unit = unit0 + ch;
            v4u pc[SC_PIECES];
            const bf16* zrow = P.ZH + (unit * 32 + (lane & 31)) * 64 + 8 * hi; const bf16* rrow = P.RH + (unit * 32 + (lane & 31)) * 64 + 8 * hi;
#pragma unroll
            for (int S = 0; S < 4; ++S) { pc[S] = *(const GAS v4u*)(zrow + 16 * S); pc[4 + S] = *(const GAS v4u*)(rrow + 16 * S); }
#pragma unroll
            for (int ct = 0; ct < 2; ++ct)
#pragma unroll
                for (int s2 = 0; s2 < 2; ++s2) pc[8 + ct * 2 + s2] = *(const GAS v4u*)(P.BF + ((unit * 2 + ct) * 64 + lane) * 8 + 4 * s2);
#pragma unroll
            for (int s2 = 0; s2 < 2; ++s2) { pc[12 + s2] = *(const GAS v4u*)(P.U0F + ((unit * 2 + vt) * 64 + lane) * 8 + 4 * s2); pc[14 + s2] = *(const GAS v4u*)(P.YF + ((unit * 2 + vt) * 64 + lane) * 8 + 4 * s2); }
#pragma unroll
            for (int ct = 0; ct < 2; ++ct)
#pragma unroll
                for (int s2 = 0; s2 < 2; ++s2) pc[16 + ct * 2 + s2] = *(const GAS v4u*)(P.GF + (((unit * 2 + ct) * 2 + vt) * 64 + lane) * 8 + 4 * s2);
#pragma unroll
            for (int ct = 0; ct < 2; ++ct)
#pragma unroll
                for (int g = 0; g < 4; ++g) pc[20 + ct * 4 + g] = *(const GAS v4u*)(P.PLF + unit * 64 + 32 * ct + 8 * g + 4 * hi);
            while ((int)flg[SC_SLOTS] < ch - SC_SLOTS + 1) __builtin_amdgcn_s_sleep(1);
#pragma unroll
            for (int p = 0; p < SC_PIECES; ++p) *(LAS v4u*)(slot + p * 1024) = pc[p];
            LDS_WAIT();
            if (lane == 0) flg[ch % SC_SLOTS] = (unsigned)(ch + 1);
        }
    } else if (wave == 0) {
        f32x16 st[2] = {zero16(), zero16()};
#define SC_EARLY(E, CH) do { const int sl_ = (CH) % SC_SLOTS; const LAS unsigned char* sp_ = lds + sl_ * SC_SLOT_BYTES + lane * 16; \
            while (flg[sl_] != (unsigned)((CH) + 1)) __builtin_amdgcn_s_sleep(1); \
            _Pragma("unroll") for (int p_ = 0; p_ < 8; ++p_) E[p_] = *(const LAS v4u*)(sp_ + p_ * 1024); \
            _Pragma("unroll") for (int p_ = 0; p_ < 4; ++p_) E[8 + p_] = *(const LAS v4u*)(sp_ + (12 + p_) * 1024); } while (0)
#define SC_CHUNK(E, CH) do { const unsigned unit = unit0 + (CH); const LAS unsigned char* sp_ = lds + ((CH) % SC_SLOTS) * SC_SLOT_BYTES + lane * 16; \
            v4u lt[16]; \
            _Pragma("unroll") for (int p_ = 0; p_ < 4; ++p_) lt[p_] = *(const LAS v4u*)(sp_ + (8 + p_) * 1024); \
            _Pragma("unroll") for (int p_ = 0; p_ < 12; ++p_) lt[4 + p_] = *(const LAS v4u*)(sp_ + (16 + p_) * 1024); \
            f32x16 U, Y; \
            _Pragma("unroll") for (int q = 0; q < 4; ++q) { U[2 * q] = bflo(E[8][q]); U[2 * q + 1] = bfhi(E[8][q]); U[8 + 2 * q] = bflo(E[9][q]); U[8 + 2 * q + 1] = bfhi(E[9][q]); \
                                          Y[2 * q] = bflo(E[10][q]); Y[2 * q + 1] = bfhi(E[10][q]); Y[8 + 2 * q] = bflo(E[11][q]); Y[8 + 2 * q + 1] = bfhi(E[11][q]); } \
            _Pragma("unroll") for (int ct = 0; ct < 2; ++ct) _Pragma("unroll") for (int s2 = 0; s2 < 2; ++s2) { const bf16x8 sb = pk8(st[ct], s2); \
                U = MFMA32(__builtin_bit_cast(bf16x8, E[2 * ct + s2]), sb, U); Y = MFMA32(__builtin_bit_cast(bf16x8, E[4 + 2 * ct + s2]), sb, Y); } \
            st_frag(P.YF + ((unit * 2 + vt) * 64 + lane) * 8, Y); \
            const bf16x8 ub0 = pk8(U, 0), ub1 = pk8(U, 1); \
            _Pragma("unroll") for (int ct = 0; ct < 2; ++ct) { f32x16 ns; \
                _Pragma("unroll") for (int g = 0; g < 4; ++g) { const v4u pw = lt[8 + ct * 4 + g]; const v4u ga = lt[4 + 2 * ct + (g >> 1)]; \
                    const unsigned g0 = (g & 1) ? ga.z : ga.x, g1 = (g & 1) ? ga.w : ga.y; \
                    ns[4 * g] = __uint_as_float(pw.x) * st[ct][4 * g] + bflo(g0); ns[4 * g + 1] = __uint_as_float(pw.y) * st[ct][4 * g + 1] + bfhi(g0); \
                    ns[4 * g + 2] = __uint_as_float(pw.z) * st[ct][4 * g + 2] + bflo(g1); ns[4 * g + 3] = __uint_as_float(pw.w) * st[ct][4 * g + 3] + bfhi(g1); } \
                ns = MFMA32(__builtin_bit_cast(bf16x8, lt[2 * ct]), ub0, ns); ns = MFMA32(__builtin_bit_cast(bf16x8, lt[2 * ct + 1]), ub1, ns); \
                st[ct] = ns; } \
            LDS_WAIT(); if (lane == 0) flg[SC_SLOTS] = (unsigned)((CH) + 1); } while (0)
        v4u ea[12], eb[12];
        SC_EARLY(ea, 0);
#pragma unroll 1
        for (int ch = 0; ch < RW_NCH; ch += 2) {
            SC_EARLY(eb, ch + 1);
            SC_CHUNK(ea, ch);
            if (ch + 2 < RW_NCH) SC_EARLY(ea, ch + 2);
            SC_CHUNK(eb, ch + 1);
        }
#undef SC_EARLY
#undef SC_CHUNK
    }
    __syncthreads();
}

DI void rwkv_post_unit(const RwkvC& P, int b, int h, int ch, LAS unsigned char* lw_, int lane) {
    const int cl = lane & 31, hi = lane >> 5;
    const unsigned unit = (unsigned)((b * NH + h) * RW_NCH + ch);
    const unsigned row0 = (unsigned)(b * SEQ + ch * RW_L);
    LAS bf16* X1 = (LAS bf16*)lw_;
    f32x16 y[2], gt[2], vv[2];
#pragma unroll
    for (int vt = 0; vt < 2; ++vt) { y[vt] = ld_frag(P.YF + ((unit * 2 + vt) * 64 + lane) * 8); gt[vt] = ld_frag(P.GTF + ((unit * 2 + vt) * 64 + lane) * 8); vv[vt] = ld_frag(P.VFf + ((unit * 2 + vt) * 64 + lane) * 8); }
    const float lg0 = P.lnx_g[h * 64 + cl], lg1 = P.lnx_g[h * 64 + 32 + cl], lb0 = P.lnx_b[h * 64 + cl], lb1 = P.lnx_b[h * 64 + 32 + cl];
    f32x16 o0, o1;
#pragma unroll
    for (int r = 0; r < 16; ++r) {
        const float mean = half_sum(y[0][r] + y[1][r], lane) * (1.f / 64.f);
        const float d0 = y[0][r] - mean, d1 = y[1][r] - mean;
        const float var = half_sum(d0 * d0 + d1 * d1, lane) * (1.f / 64.f);
        const float rs = rsqrtf(var + LNX_EPS);
        const float bo = P.BON[(row0 + crow(r, hi)) * 8 + h];
        o0[r] = (d0 * rs * lg0 + lb0 + bo * vv[0][r]) * gt[0][r];
        o1[r] = (d1 * rs * lg1 + lb1 + bo * vv[1][r]) * gt[1][r];
    }
    stage_n(X1, o0, o1, cl, hi); LDS_WAIT();
#pragma unroll
    for (int i = 0; i < 4; ++i) { const int pc = lane + 64 * i, t = pc >> 3, q = pc & 7;
        const v4u w = *(const LAS v4u*)(X1 + t * RW_SP + 8 * q);
        *(GAS v4u*)(P.ymix + (row0 + t) * D + h * 64 + 8 * q) = w; }
    LDS_WAIT();
}
constexpr int NPHASE = 24;
#ifndef FP8_L0
#define FP8_L0 0
#endif
constexpr bool F8L0 = FP8_L0;
#ifndef MK_SINGLE
#define MK_SINGLE 1
#endif
struct Args { const float* in[46]; float* out; unsigned char* ws; int ph_lo, ph_hi; };

DI unsigned char* opq(unsigned char* p) { GAS unsigned char* g = (GAS unsigned char*)p; asm volatile("" : "+s"(g)); return (unsigned char*)g; }
DI int opqs(int v) { asm volatile("" : "+s"(v)); return v; }
DI int opqv(int v) { asm volatile("" : "+v"(v)); return v; }
DI const float* inp(int i) { typedef const GAS float* gfp; const __attribute__((address_space(4))) gfp* t = (const __attribute__((address_space(4))) gfp*)__builtin_amdgcn_kernarg_segment_ptr(); asm volatile("" : "+s"(t)); return (const float*)t[i]; }

__global__ void __launch_bounds__(NWAVES * 64, 2) fwd_kernel(Args args) {
    extern __shared__ __attribute__((aligned(16))) unsigned char lds_raw[];
    LAS unsigned char* lds = (LAS unsigned char*)lds_raw;
    volatile LAS unsigned* MISC = (volatile LAS unsigned*)(lds + MISC_OFF);
    const int wave0 = __builtin_amdgcn_readfirstlane((int)threadIdx.x >> 6);
    const int G0 = gridDim.x, blk0 = blockIdx.x;
#define PHV const int lane = opqv(lane_id()), blk = opqs(blk0), G = opqs(G0), wave = opqs(wave0), tid = wave * 64 + lane, gw = blk * NWAVES + wave, NGW = G * NWAVES; (void)tid; (void)lane; (void)gw; (void)NGW; (void)wave
    unsigned char* ws0 = args.ws;
#define ws opq(ws0)
#define ctl ((unsigned*)(ws + WS_CTL))
    for (int u = wave0 * 64 + lane_id(); u < (LDS_BYTES - MISC_OFF) / 4; u += NWAVES * 64) ((LAS unsigned*)(lds + MISC_OFF))[u] = 0u;
    __syncthreads();
#if MK_SINGLE
    constexpr int lo = 0, hi = NPHASE;
#else
    const int lo = args.ph_lo, hi = args.ph_hi;
#endif
    if (hi - lo > 1) (void)xcd_barrier_post(ctl + CW_BAR, MISC + 8, wave0 * 64 + lane_id());
#ifndef PHMASK
#define PHMASK 0xFFFFFFF
#endif
#define IN(k) (((PHMASK >> (k)) & 1) && lo <= (k) && (k) < hi)
#ifndef GEMM_REP
#define GEMM_REP 1
#endif
#define GRID_BAR() do { XcdBarrier bb_; bb_.bar = ctl + CW_BAR; bb_.x = xb_xcc_id(); bb_.st = MISC + 8; xcd_barrier(bb_, opqs(wave0) * 64 + opqv(lane_id())); } while (0)
#define GEMM_RUN(...) do { __VA_ARGS__; if (GEMM_REP > 1) { GRID_BAR(); __VA_ARGS__; } } while (0)
#ifndef PROBE_MASK
#define PROBE_MASK 0u
#endif
    unsigned long long tph_ = PROBE_MASK ? __builtin_amdgcn_s_memrealtime() : 0ull;
#define SEAM(k) do { if (IN(k) && IN((k) + 1)) { XcdBarrier bb_; bb_.bar = ctl + CW_BAR; bb_.x = xb_xcc_id(); bb_.st = MISC + 8; xcd_barrier(bb_, opqs(wave0) * 64 + opqv(lane_id())); \
        if (PROBE_MASK) { const unsigned long long t1_ = __builtin_amdgcn_s_memrealtime(); if ((PROBE_MASK >> (k)) & 1u) { while (__builtin_amdgcn_s_memrealtime() - t1_ < t1_ - tph_) __builtin_amdgcn_s_sleep(8); } tph_ = __builtin_amdgcn_s_memrealtime(); } } } while (0)

#define B_HN ((bf16*)(ws + WS_HN))
#define B_YMIX ((bf16*)(ws + WS_YMIX))
#define B_VF ((bf16*)(ws + WS_VF))
#define B_PA ((bf16*)(ws + WS_PA))
#define B_PB ((bf16*)(ws + WS_PB))
#define B_Y ((bf16*)(ws + WS_Y))
    float* xo = args.out;
#define x_in inp(0)

    if (IN(0)) { PHV;
        LAS float* scr = (LAS float*)(lds + wave * 16384);
        conv_matrix<1>(inp(2), D, 3232, (bf16*)(ws + WS_WIN0), 1696, scr, gw, NGW, lane);
        conv_matrix<1>(inp(23), D, 3264, (bf16*)(ws + WS_WIN1), 1728, scr, gw, NGW, lane);
        zero_rows((bf16*)(ws + WS_WIN0), D, 1696, NA, gw, NGW, lane);
        zero_rows((bf16*)(ws + WS_WIN1), D, 1728, NA, gw, NGW, lane);
        conv_matrix<0>(inp(15), D, D, (bf16*)(ws + WS_WOUT0), 0, scr, gw, NGW, lane);
        conv_matrix<0>(inp(38), D, D, (bf16*)(ws + WS_WOUT1), 0, scr, gw, NGW, lane);
        if (F8L0) { conv_matrix8<2>(inp(18), D, FF, ws + WS_WGU0, scr, gw, NGW, lane); conv_matrix8<3>(inp(19), D, FF, ws + WS_WGU0, scr, gw, NGW, lane); conv_matrix8<0>(inp(20), FF, D, ws + WS_WDN0, scr, gw, NGW, lane); }
        else { conv_matrix<2>(inp(18), D, FF, (bf16*)(ws + WS_WGU0), 0, scr, gw, NGW, lane); conv_matrix<3>(inp(19), D, FF, (bf16*)(ws + WS_WGU0), 0, scr, gw, NGW, lane); conv_matrix<0>(inp(20), FF, D, (bf16*)(ws + WS_WDN0), 0, scr, gw, NGW, lane); }
        phase_norm0(x_in, inp(1), B_HN, gw, NGW, lane);
        {
            bf16* upt = (bf16*)(ws + WS_UPT);
            for (int i = gw * 64 + lane; i < 2 * 8 * 12288; i += NGW * 64) {
                const int l2 = i / (8 * 12288), rem = i % (8 * 12288), hh = rem / 12288, e = rem % 12288;
                float val = 0.f;
                if (e < 2048) { const int c = e >> 5, k = e & 31; val = inp(l2 ? 26 : 5)[k * 512 + hh * 64 + c]; }
                else if (e < 4096) { const int c = (e - 2048) >> 5, k = e & 31; val = inp(l2 ? 28 : 7)[k * 512 + hh * 64 + c]; }
                else if (e < 6144) { const int c = (e - 4096) >> 5, k = e & 31; if (l2) val = inp(31)[k * 512 + hh * 64 + c]; }
                else { const int c = (e - 6144) / 96, k = (e - 6144) % 96; val = inp(l2 ? 29 : 8)[k * 512 + hh * 64 + c]; }
                upt[i] = f2bf(val);
            }
        }
    }
    SEAM(0);

#pragma unroll
    for (int l = 0; l < 2; ++l) {
        const int pb = l ? 10 : 1;
        if (IN(pb)) { PHV;
            {
                pg8::Gemm g{B_HN, (const bf16*)(ws + (l ? WS_WIN1 : WS_WIN0)), M, 1536, D}; pg8::StaticOrder S; S.init(M, 1536, G, blk);
                pg8::EpiProjT E{B_PA};
                GEMM_RUN(pg8::gemm_phase<pg8::EpiProjT, pg8::StaticOrder, true, true, true>(lds, g, S, E, tid));
            }
            {
                pg8::Gemm g{B_HN, (const bf16*)(ws + (l ? WS_WIN1 : WS_WIN0)) + (size_t)1536 * D, M, 1792, D}; pg8::StaticOrder S; S.init(M, 1792, G, blk);
                pg8::EpiProj E{(bf16*)(ws + WS_PAS), B_PB};
                GEMM_RUN(pg8::gemm_phase<pg8::EpiProj, pg8::StaticOrder, true, true>(lds, g, S, E, tid));
            }
        }
        SEAM(pb);
#define RWKV_SETUP \
            RwkvC P; { const int o = l ? 21 : 0, o2 = l ? 23 : 0; unsigned char* w_ = ws; \
            P.PAT = (const bf16*)(w_ + WS_PA); P.PAS = (const bf16*)(w_ + WS_PAS); P.mu = inp(3 + o); P.decay0 = inp(4 + o); P.iclr0 = inp(6 + o); P.vres0 = inp(30); \
            P.k_k = inp(9 + o2); P.k_a = inp(10 + o2); P.r_k = inp(11 + o2); P.lnx_g = inp(12 + o2); P.lnx_b = inp(13 + o2); \
            P.upT = (const bf16*)(w_ + WS_UPT) + (size_t)l * 8 * 12288; P.VFf = (unsigned*)(w_ + WS_VF); P.ZH = (bf16*)(w_ + WS_ZH); P.RH = (bf16*)(w_ + WS_RH); \
            P.BF = (unsigned*)(w_ + WS_BF); P.U0F = (unsigned*)(w_ + WS_U0F); P.YF = (unsigned*)(w_ + WS_YF); P.GTF = (unsigned*)(w_ + WS_GTF); P.GF = (unsigned*)(w_ + WS_GF); \
            P.PLF = (float*)(w_ + WS_PLF); P.BON = (float*)(w_ + WS_BON); P.ymix = (bf16*)(w_ + WS_YMIX); P.has_vres = l; }
        if (IN(pb + 1)) { PHV;
            RWKV_SETUP
            for (int u = blk; u < NBATCH * RW_NCH; u += G) rwkv_pre_unit(P, u / RW_NCH, wave, u % RW_NCH, lds + wave * RW_WAVE_LDS, lane_id());
        }
        SEAM(pb + 1);
        if (IN(pb + 2)) { PHV;
            const bool split = G >= 128;
            if (!split || blk < 64) {
                { RWKV_SETUP
                    for (int cid = blk; cid < 64; cid += G) rwkv_scan_wg(P, cid >> 4, (cid >> 1) & 7, cid & 1, lds, wave, lane); }
            }
            if (!split || blk >= 64) {
                const float* sbg = inp(14 + (l ? 23 : 0));
                const int sbw = split ? G - 64 : G, sbi = split ? blk - 64 : blk;
#ifndef SB_REP
#define SB_REP 1
#endif
                for (int rep_ = 0; rep_ < SB_REP; ++rep_)
                for (int u = sbi; u < NBATCH * NH * (SEQ / 256); u += sbw) {
                    const int qb = u & 31, bh = u >> 5;
                    sb_wave(B_PB, B_YMIX, sbg, bh >> 3, bh & 7, qb * 256 + wave * 32, lds + wave * 8192, lane_id());
                }
            }
        }
        SEAM(pb + 2);
        if (IN(pb + 3)) { PHV;
            RWKV_SETUP
            for (int u = blk; u < NBATCH * RW_NCH; u += G) rwkv_post_unit(P, u / RW_NCH, wave, u % RW_NCH, lds + wave * RW_WAVE_LDS, lane_id());
        }
        SEAM(pb + 3);
        if (IN(pb + 4)) { PHV;
            pg8::Gemm g{B_YMIX, (const bf16*)(ws + (l ? WS_WOUT1 : WS_WOUT0)), M, D, D}; pg8::StaticOrder S; S.init(M, D, G, blk);
            pg8::EpiBf16Plain E{B_Y, D};
            GEMM_RUN(pg8::gemm_phase<pg8::EpiBf16Plain, pg8::StaticOrder, true, true>(lds, g, S, E, tid));
        }
        SEAM(pb + 4);
        if (IN(pb + 5)) { PHV;
            if (l == 0) phase_resnorm<false, F8L0>(x_in, B_Y, nullptr, inp(16), inp(17), xo, (bf16*)(ws + WS_HNF0), nullptr, nullptr, nullptr, nullptr, gw, NGW, lane);
            else phase_resnorm<false, true>(xo, B_Y, nullptr, inp(39), inp(40), xo, (bf16*)(ws + WS_HNF1), inp(41), (unsigned*)(ws + WS_SEL), (float*)(ws + WS_GTS), ctl + CW_TOT, gw, NGW, lane);
        }
        SEAM(pb + 5);
    if (l == 0) {
        if (IN(7)) { PHV;
            pg8::Gemm g{(const bf16*)(ws + WS_HNF0), (const bf16*)(ws + WS_WGU0), M, 2 * FF, F8L0 ? D / 2 : D, E8_HN, E8_W}; pg8::StaticOrder S; S.init(M, 2 * FF, G, blk);
            pg8::EpiSwiglu<F8L0> E{ws + WS_H0, FF, 0};
            GEMM_RUN(pg8::gemm_phase<pg8::EpiSwiglu<F8L0>, pg8::StaticOrder, true, true, false, F8L0>(lds, g, S, E, tid));
        }
        SEAM(7);
        if (IN(8)) { PHV;
            pg8::Gemm g{(const bf16*)(ws + WS_H0), (const bf16*)(ws + WS_WDN0), M, D, F8L0 ? FF / 2 : FF, E8_H, E8_W}; pg8::StaticOrder S; S.init(M, D, G, blk);
            pg8::EpiBf16Plain E{(bf16*)(ws + WS_F), D};
            GEMM_RUN(pg8::gemm_phase<pg8::EpiBf16Plain, pg8::StaticOrder, true, true, false, F8L0>(lds, g, S, E, tid));
        }
        SEAM(8);
        if (IN(9)) { PHV; phase_resnorm<false, false>(xo, (const bf16*)(ws + WS_F), nullptr, inp(21), inp(22), xo, B_HN, nullptr, nullptr, nullptr, nullptr, gw, NGW, lane); }
        SEAM(9);
    } else {
        if (IN(16)) { PHV;
            LAS float* scr = (LAS float*)(lds + wave * 16384);
#pragma unroll 1
            for (int e = 0; e < NE; ++e) {
                conv_matrix8<2>(inp(42) + (size_t)e * D * FF, D, FF, ws + WS_WMGU + (size_t)e * 2 * FF * D, scr, gw, NGW, lane);
                conv_matrix8<3>(inp(43) + (size_t)e * D * FF, D, FF, ws + WS_WMGU + (size_t)e * 2 * FF * D, scr, gw, NGW, lane);
                conv_matrix8<0>(inp(44) + (size_t)e * D * FF, FF, D, ws + WS_WMDN + (size_t)e * D * FF, scr, gw, NGW, lane);
            }
            phase_moe_sort((const unsigned*)(ws + WS_SEL), (const float*)(ws + WS_GTS), ctl + CW_TOT, ctl + CW_CUR, (unsigned*)(ws + WS_POS), (float*)(ws + WS_GSORT), ws + WS_HNF1, ws + WS_HS, gw, NGW, lane);
        }
        SEAM(16);
#pragma unroll 1
        for (int p = 0; p < MOE_PARTS; ++p) {
            const int phg = 17 + 2 * p;
            if (IN(phg) || IN(phg + 1)) {
                PHV;
                int mytot; const int myoff = moe_offsets(ctl + CW_TOT, lane, mytot);
                pg8::MoeOrder S;
                const int nTiles = __builtin_amdgcn_readfirstlane(shi(myoff, 8)) >> 8;
                S.ts1 = __builtin_amdgcn_readfirstlane(shi(myoff, 1)) >> 8; S.ts2 = __builtin_amdgcn_readfirstlane(shi(myoff, 2)) >> 8; S.ts3 = __builtin_amdgcn_readfirstlane(shi(myoff, 3)) >> 8;
                S.ts4 = __builtin_amdgcn_readfirstlane(shi(myoff, 4)) >> 8; S.ts5 = __builtin_amdgcn_readfirstlane(shi(myoff, 5)) >> 8; S.ts6 = __builtin_amdgcn_readfirstlane(shi(myoff, 6)) >> 8;
                S.ts7 = __builtin_amdgcn_readfirstlane(shi(myoff, 7)) >> 8;
                const int t0 = p * MOE_PART_TILES; int nT = nTiles - t0; nT = nT < 0 ? 0 : (nT > MOE_PART_TILES ? MOE_PART_TILES : nT);
                S.t0 = t0; S.nT = nT; S.G = G; S.c = blk;
                if (IN(phg)) { PHV;
                    S.nN = 2 * FF / 256; S.nwg = nT * S.nN; S.nNe = 2 * FF / 256; S.arel = 0;
                    pg8::Gemm g{(const bf16*)(ws + WS_HS), (const bf16*)(ws + WS_WMGU), 0, 0, D / 2, E8_HN, E8_W};
                    pg8::EpiSwiglu<true> E{ws + WS_HP, FF, -(long)t0 * 256};
                    GEMM_RUN(pg8::gemm_phase<pg8::EpiSwiglu<true>, pg8::MoeOrder, true, true, false, true>(lds, g, S, E, tid));
                }
                SEAM(phg);
                if (IN(phg + 1)) { PHV;
                    S.nN = D / 256; S.nwg = nT * S.nN; S.nNe = D / 256; S.arel = 1;
                    pg8::Gemm g{(const bf16*)(ws + WS_HP), (const bf16*)(ws + WS_WMDN), 0, 0, FF / 2, E8_H, E8_W};
                    pg8::EpiMoeDown E{(bf16*)(ws + WS_FS), D, (const float*)(ws + WS_GSORT)};
                    GEMM_RUN(pg8::gemm_phase<pg8::EpiMoeDown, pg8::MoeOrder, true, true, false, true>(lds, g, S, E, tid));
                }
                SEAM(phg + 1);
            }
        }
        if (IN(23)) { PHV; phase_resnorm<true, false>(xo, (const bf16*)(ws + WS_FS), (const unsigned*)(ws + WS_POS), inp(45), nullptr, xo, nullptr, nullptr, nullptr, nullptr, nullptr, gw, NGW, lane); }
    }
    }
#undef IN
#undef SEAM
#undef x_in
#undef PHV
#undef ws
#undef ctl
#undef B_HN
#undef B_YMIX
#undef B_VF
#undef B_PA
#undef B_PB
#undef B_Y
}

extern "C" void kernel_launch(void* const* d_in, const int* in_sizes, int n_in, void* d_out, int out_size, void* d_ws, size_t ws_size, hipStream_t stream) {
    static int grid = 0;
    if (grid == 0) {
        if (n_in != 46 || in_sizes[0] != M * D || out_size != M * D || ws_size < WS_END) { fprintf(stderr, "kernel_launch: unexpected problem: n_in %d in0 %d out %d ws %zu (need %zu)\n", n_in, n_in > 0 ? in_sizes[0] : -1, out_size, ws_size, (size_t)WS_END); grid = -1; return; }
        int dev = 0, cus = 0, per_cu = 0;
        if (hipGetDevice(&dev) != hipSuccess || hipDeviceGetAttribute(&cus, hipDeviceAttributeMultiprocessorCount, dev) != hipSuccess) { grid = -1; return; }
        if (hipFuncSetAttribute((const void*)fwd_kernel, hipFuncAttributeMaxDynamicSharedMemorySize, LDS_BYTES) != hipSuccess) { fprintf(stderr, "kernel_launch: hipFuncSetAttribute failed\n"); grid = -1; return; }
        if (hipOccupancyMaxActiveBlocksPerMultiprocessor(&per_cu, (const void*)fwd_kernel, NWAVES * 64, LDS_BYTES) != hipSuccess || per_cu < 1) { fprintf(stderr, "kernel_launch: occupancy query says %d\n", per_cu); }
        (void)hipGetLastError();
        grid = cus;
    }
    if (grid < 0) return;
    (void)hipMemsetAsync((char*)d_ws + WS_CTL, 0, CTL_ZERO_BYTES, stream);
    Args a{};
    for (int i = 0; i < 46; ++i) a.in[i] = (const float*)d_in[i];
    a.out = (float*)d_out; a.ws = (unsigned char*)d_ws;
#if MK_SINGLE
    a.ph_lo = 0; a.ph_hi = NPHASE;
    hipLaunchKernelGGL(fwd_kernel, dim3(grid), dim3(NWAVES * 64), LDS_BYTES, stream, a);
#else
    for (int p = 0; p < NPHASE; ++p) { a.ph_lo = p; a.ph_hi = p + 1; hipLaunchKernelGGL(fwd_kernel, dim3(grid), dim3(NWAVES * 64), LDS_BYTES, stream, a); }
#endif
}
```
